# Optimizing an MI355X kernel written in HIP

```python
import jax, jax.numpy as jnp
from jax import lax
import numpy as np

D_MODEL = 1024
BATCH = 8
SEQ = 4096
DEPTH = 2
DEC_BATCH = 16
DEC_SEQ = 4096
PAST_LEN = 128

A_HEADS = 16
A_KV_HEADS = 4
A_HEAD_DIM = D_MODEL // A_HEADS
A_WIDTH = A_HEADS * A_HEAD_DIM
A_KV_WIDTH = A_KV_HEADS * A_HEAD_DIM
WINDOW = 128
BLOCK = 128
A_SPLITS = (A_WIDTH, A_KV_WIDTH, A_KV_WIDTH, A_WIDTH)

G_HEADS = 4
G_KEY_WIDTH = D_MODEL // 2
G_VAL_WIDTH = D_MODEL
G_KEY_DIM = G_KEY_WIDTH // G_HEADS
G_VAL_DIM = G_VAL_WIDTH // G_HEADS
G_GATE_RANK = 16
G_GATE_TAU = 16.0
G_CHUNK = 64
G_SPLITS = (G_KEY_WIDTH, G_KEY_WIDTH, G_VAL_WIDTH, G_VAL_WIDTH, G_GATE_RANK, G_GATE_RANK)

LN_EPS = 1e-5
RMS_EPS = 1e-6
DN_ALPHA = (2 * DEPTH) ** 0.25
DN_BETA = (8 * DEPTH) ** -0.25

kernel_name = "hybrid_swa_gla_deepnorm_encoder"


def _split(h, sizes):
    idx = [int(i) for i in np.cumsum(sizes)[:-1]]
    return jnp.split(h, idx, axis=-1)


def layer_norm(x, g, b):
    xf = x.astype(jnp.float32)
    mu = jnp.mean(xf, axis=-1, keepdims=True)
    var = jnp.mean(jnp.square(xf - mu), axis=-1, keepdims=True)
    y = (xf - mu) * lax.rsqrt(var + LN_EPS) * g.astype(jnp.float32) + b.astype(jnp.float32)
    return y.astype(x.dtype)


def alibi_slopes(n_heads):
    return jnp.asarray(2.0 ** (-8.0 * np.arange(1, n_heads + 1) / n_heads), dtype=jnp.float32)


def window_attention(q, k, v, sink):
    B, S, H, dh = q.shape
    KV = k.shape[2]
    rep = H // KV
    nb = S // BLOCK
    qb = (q * dh ** -0.5).reshape(B, nb, BLOCK, KV, rep, dh)
    pad = ((0, 0), (BLOCK, BLOCK), (0, 0), (0, 0))
    kp = jnp.pad(k, pad).reshape(B, nb + 2, BLOCK, KV, dh)
    vp = jnp.pad(v, pad).reshape(B, nb + 2, BLOCK, KV, dh)
    kw = jnp.concatenate([kp[:, :-2], kp[:, 1:-1], kp[:, 2:]], axis=2)
    vw = jnp.concatenate([vp[:, :-2], vp[:, 1:-1], vp[:, 2:]], axis=2)
    qi = jnp.arange(BLOCK)[:, None] + BLOCK
    kj = jnp.arange(3 * BLOCK)[None, :]
    dist = jnp.abs(qi - kj).astype(jnp.float32)
    in_win = dist <= WINDOW
    kpos = (jnp.arange(nb)[:, None] - 1) * BLOCK + jnp.arange(3 * BLOCK)[None, :]
    kvalid = (kpos >= 0) & (kpos < S)
    slopes = alibi_slopes(H).reshape(KV, rep)
    bias = -slopes[:, :, None, None] * dist
    sink_l = sink.astype(jnp.float32).reshape(KV, rep)

    def one_block(args):
        qn, kn, vn, valid = args
        s = jnp.einsum('bqgrd,bkgd->bgrqk', qn, kn).astype(jnp.float32) + bias
        s = jnp.where(in_win & valid[None, :], s, -1e30)
        sk = jnp.broadcast_to(sink_l[None, :, :, None, None], s.shape[:-1] + (1,))
        p = jax.nn.softmax(jnp.concatenate([s, sk], axis=-1), axis=-1)[..., :-1]
        return jnp.einsum('bgrqk,bkgd->bqgrd', p.astype(vn.dtype), vn)

    out = lax.map(one_block, (jnp.moveaxis(qb, 1, 0), jnp.moveaxis(kw, 1, 0),
                              jnp.moveaxis(vw, 1, 0), kvalid))
    return jnp.moveaxis(out, 0, 1).reshape(B, S, H * dh)


def gla_direction(q, k, v, log_a, inclusive):
    B, S, H, dk = q.shape
    dv = v.shape[-1]
    nc = S // G_CHUNK

    def chunks(t):
        return jnp.moveaxis(t.reshape(B, nc, G_CHUNK, H, t.shape[-1]), 1, 0)

    qc, kc, vc = chunks(q), chunks(k), chunks(v)
    cum = jnp.cumsum(chunks(log_a.astype(jnp.float32)), axis=2)
    idx = jnp.arange(G_CHUNK)
    mask = (idx[:, None] >= idx[None, :]) if inclusive else (idx[:, None] > idx[None, :])

    def step(state, xs):
        qn, kn, vn, bn = xs
        qf, kf, vf = qn.astype(jnp.float32), kn.astype(jnp.float32), vn.astype(jnp.float32)
        b_last = bn[:, -1]
        q_dec = qf * jnp.exp(bn)
        k_inv = kf * jnp.exp(-bn)
        k_tail = kf * jnp.exp(b_last[:, None] - bn)
        inter = jnp.einsum('bthk,bhkv->bthv', q_dec, state)
        att = jnp.where(mask, jnp.einsum('bthk,bshk->bhts', q_dec, k_inv), 0.0)
        intra = jnp.einsum('bhts,bshv->bthv', att, vf)
        new_state = jnp.exp(b_last)[..., None] * state + jnp.einsum('bshk,bshv->bhkv', k_tail, vf)
        return new_state, inter + intra

    state0 = jnp.zeros((B, H, dk, dv), jnp.float32)
    _, out = lax.scan(step, state0, (qc, kc, vc, cum))
    return jnp.moveaxis(out, 0, 1).reshape(B, S, H, dv)


def attn_mixer(x, w_in, sink, w_out):
    B, S, _ = x.shape
    q, k, v, gate = _split(x @ w_in, A_SPLITS)
    o = window_attention(q.reshape(B, S, A_HEADS, A_HEAD_DIM),
                         k.reshape(B, S, A_KV_HEADS, A_HEAD_DIM),
                         v.reshape(B, S, A_KV_HEADS, A_HEAD_DIM), sink)
    return (o * jax.nn.silu(gate)) @ w_out


def gla_mixer(x, w_in, w_gate_f, b_gate_f, w_gate_b, b_gate_b, head_norm, w_out):
    B, S, _ = x.shape
    q, k, v, gate, lr_f, lr_b = _split(x @ w_in, G_SPLITS)
    q = q.reshape(B, S, G_HEADS, G_KEY_DIM) * G_KEY_DIM ** -0.5
    k = k.reshape(B, S, G_HEADS, G_KEY_DIM)
    v = v.reshape(B, S, G_HEADS, G_VAL_DIM)
    log_f = (jax.nn.log_sigmoid((lr_f @ w_gate_f + b_gate_f).astype(jnp.float32)) / G_GATE_TAU
             ).reshape(B, S, G_HEADS, G_KEY_DIM)
    log_b = (jax.nn.log_sigmoid((lr_b @ w_gate_b + b_gate_b).astype(jnp.float32)) / G_GATE_TAU
             ).reshape(B, S, G_HEADS, G_KEY_DIM)
    o_f = gla_direction(q, k, v, log_f, True)
    flip = lambda t: jnp.flip(t, axis=1)
    o_b = flip(gla_direction(flip(q), flip(k), flip(v), flip(log_b), False))
    of = o_f + o_b
    of = of * lax.rsqrt(jnp.mean(jnp.square(of), axis=-1, keepdims=True) + RMS_EPS)
    o = (of.reshape(B, S, G_VAL_WIDTH) * head_norm.astype(jnp.float32)).astype(x.dtype)
    return (o * jax.nn.silu(gate)) @ w_out


def setup_inputs(seed: int = 0) -> dict:
    key = jax.random.key(seed)
    ks = jax.random.split(key, 20)
    n = lambda k, shape, scale: jax.random.normal(k, shape, jnp.float32) * scale
    D = D_MODEL
    return {
        "x_prompt": n(ks[0], (BATCH, SEQ, D), 1.0),
        "x_sample": n(ks[1], (DEC_BATCH, DEC_SEQ, D), 1.0),
        "l0_w_in": n(ks[2], (D, sum(A_SPLITS)), D ** -0.5),
        "l0_sink": n(ks[3], (A_HEADS,), 0.5),
        "l0_w_out": n(ks[4], (A_WIDTH, D), A_WIDTH ** -0.5 * DN_BETA),
        "l0_ln_g": 1.0 + n(ks[5], (D,), 0.02),
        "l0_ln_b": n(ks[6], (D,), 0.02),
        "l1_w_in": n(ks[7], (D, sum(G_SPLITS)), D ** -0.5),
        "l1_w_gate_f": n(ks[8], (G_GATE_RANK, G_KEY_WIDTH), G_GATE_RANK ** -0.5),
        "l1_b_gate_f": n(ks[9], (G_KEY_WIDTH,), 0.1),
        "l1_w_gate_b": n(ks[10], (G_GATE_RANK, G_KEY_WIDTH), G_GATE_RANK ** -0.5),
        "l1_b_gate_b": n(ks[11], (G_KEY_WIDTH,), 0.1),
        "l1_head_norm": 1.0 + n(ks[12], (G_VAL_WIDTH,), 0.02),
        "l1_w_out": n(ks[13], (G_VAL_WIDTH, D), G_VAL_WIDTH ** -0.5 * DN_BETA),
        "l1_ln_g": 1.0 + n(ks[14], (D,), 0.02),
        "l1_ln_b": n(ks[15], (D,), 0.02),
    }


def reference(x_prompt, x_sample, l0_w_in, l0_sink, l0_w_out, l0_ln_g, l0_ln_b,
              l1_w_in, l1_w_gate_f, l1_b_gate_f, l1_w_gate_b, l1_b_gate_b, l1_head_norm,
              l1_w_out, l1_ln_g, l1_ln_b):
    mixers = (attn_mixer, gla_mixer)
    layer_params = (
        ((l0_w_in, l0_sink, l0_w_out), l0_ln_g, l0_ln_b),
        ((l1_w_in, l1_w_gate_f, l1_b_gate_f, l1_w_gate_b, l1_b_gate_b, l1_head_norm, l1_w_out),
         l1_ln_g, l1_ln_b),
    )

    def trunk(x):
        for i in range(DEPTH):
            p, g, b = layer_params[i]
            x = layer_norm(DN_ALPHA * x + mixers[i % len(mixers)](x, *p), g, b)
        return x

    y_prompt = trunk(x_prompt)
    y_sample = trunk(x_sample)
    return (y_prompt, y_sample)
```

```cpp
#include <hip/hip_runtime.h>
#include <hip/hip_cooperative_groups.h>
#include <cstdio>
namespace cg = cooperative_groups;

typedef unsigned short bf16_t;
typedef short bf16x8 __attribute__((ext_vector_type(8)));
typedef short s16x4 __attribute__((ext_vector_type(4)));
typedef float f32x16 __attribute__((ext_vector_type(16)));
typedef float f32x4 __attribute__((ext_vector_type(4)));
typedef float f32x2 __attribute__((ext_vector_type(2)));
typedef unsigned u32x4 __attribute__((ext_vector_type(4)));
typedef unsigned u32x2 __attribute__((ext_vector_type(2)));
typedef __bf16 bfv2 __attribute__((ext_vector_type(2)));
#define DI __device__ __forceinline__
#define MFMA32(a, b, c) __builtin_amdgcn_mfma_f32_32x32x16_bf16((a), (b), (c), 0, 0, 0)

constexpr int T_TOK = 98304, TP = 32768, SEQ = 4096, NSEQ = 24, D = 1024;
constexpr int NTHR = 512;
constexpr size_t MiB = 1048576;
constexpr size_t RB = 192 * MiB;
constexpr int LDS_BYTES = 147456;
constexpr float LOG2E = 1.4426950408889634f;
constexpr float DN_ALPHA = 1.4142135623730951f;

struct Params {
    const float *xp, *xs, *w0in, *sink, *w0out, *ln0g, *ln0b, *w1in, *wgf, *bgf, *wgb, *bgb, *hnorm, *w1out, *ln1g, *ln1b;
    float* out;
    unsigned char* ws;
};

DI unsigned pk2(float a, float b) { f32x2 v = {a, b}; bfv2 r = __builtin_convertvector(v, bfv2); return __builtin_bit_cast(unsigned, r); }
DI float bf_lo(unsigned u) { return __uint_as_float(u << 16); }
DI float bf_hi(unsigned u) { return __uint_as_float(u & 0xffff0000u); }
DI float bf2f(bf16_t v) { return __uint_as_float(((unsigned)v) << 16); }
DI bf16_t f2bf(float a) { return (bf16_t)(pk2(a, 0.f) & 0xffffu); }
DI bf16x8 pack8(const f32x16& x, int s) {
    u32x4 p = {pk2(x[8 * s], x[8 * s + 1]), pk2(x[8 * s + 2], x[8 * s + 3]), pk2(x[8 * s + 4], x[8 * s + 5]), pk2(x[8 * s + 6], x[8 * s + 7])};
    return __builtin_bit_cast(bf16x8, p);
}
DI bf16x8 cat44(s16x4 lo, s16x4 hi) { return __builtin_shufflevector(lo, hi, 0, 1, 2, 3, 4, 5, 6, 7); }
DI int opq_tid() { int t = threadIdx.x; asm volatile("" : "+v"(t)); return t; }
DI float silu(float x) { return x / (1.0f + __expf(-x)); }
DI const float* xrow(const Params& p, int t) { return t < TP ? p.xp + (size_t)t * D : p.xs + (size_t)(t - TP) * D; }

constexpr size_t WS_WT0IN = 0, WS_WT0OUT = WS_WT0IN + 2560 * 1024 * 2, WS_WT1IN = WS_WT0OUT + 1024 * 1024 * 2, WS_WT1OUT = WS_WT1IN + 3104 * 1024 * 2;
constexpr size_t WS_A0 = 16 * MiB, WS_A1 = WS_A0 + RB, WS_A2 = WS_A1 + RB, WS_A3 = WS_A2 + RB, WS_A4 = WS_A3 + RB, WS_A5 = WS_A4 + RB;
constexpr size_t WS_K0 = WS_A3, WS_V0T = WS_A3 + 48 * MiB;
constexpr size_t WS_ELF = WS_A5, WS_ELB = WS_A5 + 1536 * 512 * 4;

DI void phase_convert(const Params& p, unsigned char* smem) {
    bf16_t* xb = (bf16_t*)(p.ws + WS_A0);
    const int tid = opq_tid();
    const size_t n8 = (size_t)T_TOK * D / 8;
    for (size_t i = (size_t)blockIdx.x * NTHR + tid; i < n8; i += (size_t)gridDim.x * NTHR) {
        const size_t e = i * 8; const int t = (int)(e >> 10);
        const float* src = xrow(p, t) + (e & 1023);
        const f32x4 a = *(const f32x4*)src, b = *(const f32x4*)(src + 4);
        u32x4 o = {pk2(a[0], a[1]), pk2(a[2], a[3]), pk2(b[0], b[1]), pk2(b[2], b[3])};
        *(u32x4*)(xb + e) = o;
    }
    float* tile = (float*)smem;
    for (int u = blockIdx.x; u < 3856; u += gridDim.x) {
        int v = u; const float* W; bf16_t* Wt; int N;
        if (v < 1280) { W = p.w0in; Wt = (bf16_t*)(p.ws + WS_WT0IN); N = 2560; }
        else if ((v -= 1280) < 512) { W = p.w0out; Wt = (bf16_t*)(p.ws + WS_WT0OUT); N = 1024; }
        else if ((v -= 512) < 1552) { W = p.w1in; Wt = (bf16_t*)(p.ws + WS_WT1IN); N = 3104; }
        else { v -= 1552; W = p.w1out; Wt = (bf16_t*)(p.ws + WS_WT1OUT); N = 1024; }
        const int nn32 = N / 32, nt = v % nn32, kt = v / nn32;
#pragma unroll
        for (int q = 0; q < 4; ++q) { const int e = tid + NTHR * q, kk = e >> 5, nn = e & 31; tile[kk * 33 + nn] = W[(size_t)(kt * 64 + kk) * N + nt * 32 + nn]; }
        __syncthreads();
#pragma unroll
        for (int q = 0; q < 2; ++q) { const int e = tid + NTHR * q, nn = e >> 5, kp = e & 31;
            *(unsigned*)(Wt + (size_t)(nt * 32 + nn) * 1024 + kt * 64 + 2 * kp) = pk2(tile[(2 * kp) * 33 + nn], tile[(2 * kp + 1) * 33 + nn]); }
        __syncthreads();
    }
}

template <class Epi> DI void gemm_tile(const bf16_t* __restrict__ P, const bf16_t* __restrict__ Q, unsigned char* smem, Epi epi) {
    const int tid = opq_tid(), lane = tid & 63, wid = tid >> 6, wi = wid >> 2, wj = wid & 3, r = lane & 31, h = lane >> 5;
    const int crow = tid >> 3, ccol = (tid & 7) * 8;
    f32x16 acc[4][2];
#pragma unroll
    for (int a = 0; a < 4; ++a)
#pragma unroll
        for (int b = 0; b < 2; ++b)
#pragma unroll
            for (int i = 0; i < 16; ++i) acc[a][b][i] = 0.f;
    u32x4 rp[4], rq[4];
    const bf16_t* gp = P + (size_t)crow * 1024 + ccol;
    const bf16_t* gq = Q + (size_t)crow * 1024 + ccol;
    unsigned char* sw = smem + (crow * 72 + ccol) * 2;
#pragma unroll
    for (int u = 0; u < 4; ++u) { rp[u] = *(const u32x4*)(gp + (size_t)u * 64 * 1024); rq[u] = *(const u32x4*)(gq + (size_t)u * 64 * 1024); }
#pragma unroll
    for (int u = 0; u < 4; ++u) { *(u32x4*)(sw + u * 64 * 144) = rp[u]; *(u32x4*)(sw + 36864 + u * 64 * 144) = rq[u]; }
    __syncthreads();
    const unsigned char* fpb = smem + ((wi * 128 + r) * 72 + h * 8) * 2;
    const unsigned char* fqb = smem + 36864 + ((wj * 64 + r) * 72 + h * 8) * 2;
    for (int kt = 0; kt < 16; ++kt) {
        const int cur = kt & 1;
        if (kt + 1 < 16) {
#pragma unroll
            for (int u = 0; u < 4; ++u) { rp[u] = *(const u32x4*)(gp + (size_t)u * 64 * 1024 + (kt + 1) * 64); rq[u] = *(const u32x4*)(gq + (size_t)u * 64 * 1024 + (kt + 1) * 64); }
        }
        const unsigned char* bp = fpb + cur * 73728;
        const unsigned char* bq = fqb + cur * 73728;
#pragma unroll
        for (int s = 0; s < 4; ++s) {
            bf16x8 fp[4], fq[2];
#pragma unroll
            for (int a = 0; a < 4; ++a) fp[a] = *(const bf16x8*)(bp + a * 32 * 144 + s * 32);
#pragma unroll
            for (int b = 0; b < 2; ++b) fq[b] = *(const bf16x8*)(bq + b * 32 * 144 + s * 32);
#pragma unroll
            for (int a = 0; a < 4; ++a)
#pragma unroll
                for (int b = 0; b < 2; ++b) acc[a][b] = MFMA32(fp[a], fq[b], acc[a][b]);
        }
        if (kt + 1 < 16) {
            unsigned char* d = sw + (cur ^ 1) * 73728;
#pragma unroll
            for (int u = 0; u < 4; ++u) { *(u32x4*)(d + u * 64 * 144) = rp[u]; *(u32x4*)(d + 36864 + u * 64 * 144) = rq[u]; }
        }
        __syncthreads();
    }
#pragma unroll
    for (int a = 0; a < 4; ++a)
#pragma unroll
        for (int b = 0; b < 2; ++b)
#pragma unroll
            for (int g = 0; g < 4; ++g) {
                f32x4 v = {acc[a][b][4 * g], acc[a][b][4 * g + 1], acc[a][b][4 * g + 2], acc[a][b][4 * g + 3]};
                epi(wi * 128 + a * 32 + 8 * g + 4 * h, wj * 64 + b * 32 + r, v);
            }
}

DI bool gemm_unit(int it, int nN, int& pm, int& nt) {
    const int G = gridDim.x;
    if ((G & 7) == 0) {
        const int xcd = blockIdx.x & 7, l = blockIdx.x >> 3, per = G >> 3;
        const int u = it * per + l;
        if (u >= 48 * nN) return false;
        pm = (u / nN) * 8 + xcd; nt = u % nN; return true;
    } else {
        const int u = it * G + blockIdx.x;
        if (u >= 384 * nN) return false;
        pm = u / nN; nt = u % nN; return true;
    }
}

DI void st_bf4(bf16_t* dst, f32x4 v) { u32x2 o = {pk2(v[0], v[1]), pk2(v[2], v[3])}; *(u32x2*)dst = o; }

DI void phase_in0(const Params& p, unsigned char* smem) {
    const bf16_t* xb = (const bf16_t*)(p.ws + WS_A0);
    const bf16_t* wt = (const bf16_t*)(p.ws + WS_WT0IN);
    bf16_t* Q0 = (bf16_t*)(p.ws + WS_A1); bf16_t* G0 = (bf16_t*)(p.ws + WS_A2); bf16_t* K0 = (bf16_t*)(p.ws + WS_K0); bf16_t* V0t = (bf16_t*)(p.ws + WS_V0T);
    int pm, nt;
    for (int it = 0; gemm_unit(it, 10, pm, nt); ++it) {
        const bf16_t* A = xb + (size_t)pm * 256 * 1024;
        const bf16_t* B = wt + (size_t)nt * 256 * 1024;
        const int t0 = pm * 256;
        if (nt == 5) {
            const int sq = t0 >> 12, tl = t0 & 4095;
            gemm_tile(A, B, smem, [&](int i0, int j, f32x4 v) { st_bf4(V0t + ((size_t)(sq * 256 + j)) * 4096 + tl + i0, v); });
        } else if (nt < 4) {
            gemm_tile(B, A, smem, [&](int i0, int j, f32x4 v) { st_bf4(Q0 + (size_t)(t0 + j) * 1024 + nt * 256 + i0, v); });
        } else if (nt == 4) {
            gemm_tile(B, A, smem, [&](int i0, int j, f32x4 v) { st_bf4(K0 + (size_t)(t0 + j) * 256 + i0, v); });
        } else {
            gemm_tile(B, A, smem, [&](int i0, int j, f32x4 v) { f32x4 s = {silu(v[0]), silu(v[1]), silu(v[2]), silu(v[3])}; st_bf4(G0 + (size_t)(t0 + j) * 1024 + (nt - 6) * 256 + i0, s); });
        }
    }
}

DI void phase_attn(const Params& p, unsigned char* smem) {
    const bf16_t* Q0 = (const bf16_t*)(p.ws + WS_A1); const bf16_t* G0 = (const bf16_t*)(p.ws + WS_A2);
    const bf16_t* K0 = (const bf16_t*)(p.ws + WS_K0); const bf16_t* V0t = (const bf16_t*)(p.ws + WS_V0T);
    bf16_t* og = (bf16_t*)(p.ws + WS_A0);
    bf16_t* sK = (bf16_t*)smem;
    bf16_t* sVt = (bf16_t*)(smem + 55296);
    const int tid = opq_tid(), lane = tid & 63, wid = tid >> 6, r = lane & 31, h = lane >> 5;
    for (int u = blockIdx.x; u < NSEQ * 32 * 4; u += gridDim.x) {
        const int g = u & 3, n = (u >> 2) & 31, sq = u >> 7;
        const int kbase = (n - 1) * 128;
        __syncthreads();
#pragma unroll
        for (int q = 0; q < 6; ++q) {
            const int c = tid + NTHR * q, row = c >> 3, cc = c & 7, kpos = kbase + row;
            if (kpos >= 0 && kpos < SEQ) *(u32x4*)(sK + row * 72 + cc * 8) = *(const u32x4*)(K0 + ((size_t)sq * SEQ + kpos) * 256 + g * 64 + cc * 8);
        }
#pragma unroll
        for (int q = 0; q < 6; ++q) {
            const int c = tid + NTHR * q, row = c / 48, cc = c % 48, kpos = kbase + cc * 8;
            if (kpos >= 0 && kpos < SEQ) *(u32x4*)(sVt + row * 392 + cc * 8) = *(const u32x4*)(V0t + ((size_t)(sq * 256 + g * 64 + row)) * 4096 + kpos);
        }
        __syncthreads();
        const int head = wid >> 1, hq = g * 4 + head;
        const float slope2 = exp2f(-0.5f * (float)(hq + 1)) * LOG2E;
        const float sink2 = p.sink[hq] * LOG2E;
        for (int e = 0; e < 2; ++e) {
            const int sub = (wid & 1) * 2 + e;
            const int t0 = n * 128 + sub * 32;
            const size_t trow = (size_t)sq * SEQ + t0 + r;
            bf16x8 qf[4];
#pragma unroll
            for (int s = 0; s < 4; ++s) qf[s] = *(const bf16x8*)(Q0 + trow * 1024 + hq * 64 + s * 16 + h * 8);
            f32x16 o0, o1;
#pragma unroll
            for (int i = 0; i < 16; ++i) { o0[i] = 0.f; o1[i] = 0.f; }
            float mrun = sink2, lsum = (h == 0) ? 1.0f : 0.0f;
            for (int m = -4; m <= 4; ++m) {
                const int kb = t0 + 32 * m;
                if (kb < 0 || kb >= SEQ) continue;
                const int kl = kb - kbase;
                f32x16 st;
#pragma unroll
                for (int i = 0; i < 16; ++i) st[i] = 0.f;
#pragma unroll
                for (int s = 0; s < 4; ++s) { const bf16x8 kf = *(const bf16x8*)(sK + (kl + r) * 72 + s * 16 + h * 8); st = MFMA32(kf, qf[s], st); }
                const float fd0 = (float)(r - 32 * m - 4 * h);
                float mx = -3.0e38f;
#pragma unroll
                for (int i = 0; i < 16; ++i) {
                    const float fd = fabsf(fd0 - (float)((i & 3) + 8 * (i >> 2)));
                    float sc = st[i] * (0.125f * LOG2E) - slope2 * fd;
                    sc = (fd <= 128.0f) ? sc : -3.0e38f;
                    st[i] = sc; mx = fmaxf(mx, sc);
                }
                mx = fmaxf(mx, __shfl_xor(mx, 32));
                const float mnew = fmaxf(mrun, mx);
                const float al = exp2f(mrun - mnew);
                mrun = mnew;
                float ps = 0.f;
#pragma unroll
                for (int i = 0; i < 16; ++i) { const float pe = exp2f(st[i] - mnew); st[i] = pe; ps += pe; }
                lsum = lsum * al + ps;
#pragma unroll
                for (int i = 0; i < 16; ++i) { o0[i] *= al; o1[i] *= al; }
#pragma unroll
                for (int s2 = 0; s2 < 2; ++s2) {
                    const bf16x8 pf = pack8(st, s2);
                    const bf16_t* vb = sVt + r * 392 + kl + 16 * s2 + 4 * h;
                    const bf16x8 v0 = cat44(*(const s16x4*)vb, *(const s16x4*)(vb + 8));
                    const bf16x8 v1 = cat44(*(const s16x4*)(vb + 32 * 392), *(const s16x4*)(vb + 32 * 392 + 8));
                    o0 = MFMA32(v0, pf, o0);
                    o1 = MFMA32(v1, pf, o1);
                }
            }
            const float inv = 1.0f / (lsum + __shfl_xor(lsum, 32));
#pragma unroll
            for (int dt = 0; dt < 2; ++dt)
#pragma unroll
                for (int gq = 0; gq < 4; ++gq) {
                    const int col = hq * 64 + dt * 32 + 8 * gq + 4 * h;
                    const u32x2 gt = *(const u32x2*)(G0 + trow * 1024 + col);
                    const f32x16& oo = dt ? o1 : o0;
                    f32x4 v = {oo[4 * gq] * inv * bf_lo(gt[0]), oo[4 * gq + 1] * inv * bf_hi(gt[0]), oo[4 * gq + 2] * inv * bf_lo(gt[1]), oo[4 * gq + 3] * inv * bf_hi(gt[1])};
                    st_bf4(og + trow * 1024 + col, v);
                }
        }
    }
}

template <bool L1> DI void phase_out(const Params& p, unsigned char* smem) {
    const bf16_t* A0 = (const bf16_t*)(p.ws + (L1 ? WS_A2 : WS_A0));
    const bf16_t* wt = (const bf16_t*)(p.ws + (L1 ? WS_WT1OUT : WS_WT0OUT));
    const bf16_t* x1b = (const bf16_t*)(p.ws + WS_A0);
    int pm, nt;
    for (int it = 0; gemm_unit(it, 4, pm, nt); ++it) {
        const bf16_t* A = A0 + (size_t)pm * 256 * 1024;
        const bf16_t* B = wt + (size_t)nt * 256 * 1024;
        const int t0 = pm * 256;
        gemm_tile(B, A, smem, [&](int i0, int j, f32x4 v) {
            const int t = t0 + j, c = nt * 256 + i0;
            f32x4 xr;
            if (L1) { const u32x2 xv = *(const u32x2*)(x1b + (size_t)t * 1024 + c); xr = (f32x4){bf_lo(xv[0]), bf_hi(xv[0]), bf_lo(xv[1]), bf_hi(xv[1])}; }
            else xr = *(const f32x4*)(xrow(p, t) + c);
            *(f32x4*)(p.out + (size_t)t * 1024 + c) = xr * DN_ALPHA + v;
        });
    }
}

template <bool FINAL> DI void phase_ln(const Params& p) {
    const float* gw = FINAL ? p.ln1g : p.ln0g; const float* bw = FINAL ? p.ln1b : p.ln0b;
    bf16_t* x1b = (bf16_t*)(p.ws + WS_A0);
    const int tid = opq_tid(), lane = tid & 63, wid = tid >> 6;
    for (int row = blockIdx.x * 8 + wid; row < T_TOK; row += gridDim.x * 8) {
        float* src = p.out + (size_t)row * 1024;
        f32x4 v[4]; float s = 0.f;
#pragma unroll
        for (int u = 0; u < 4; ++u) { v[u] = *(const f32x4*)(src + u * 256 + lane * 4); s += (v[u][0] + v[u][1]) + (v[u][2] + v[u][3]); }
#pragma unroll
        for (int o = 1; o < 64; o <<= 1) s += __shfl_xor(s, o);
        const float mu = s * (1.0f / 1024.0f);
        float q = 0.f;
#pragma unroll
        for (int u = 0; u < 4; ++u) { v[u] -= mu; q += (v[u][0] * v[u][0] + v[u][1] * v[u][1]) + (v[u][2] * v[u][2] + v[u][3] * v[u][3]); }
#pragma unroll
        for (int o = 1; o < 64; o <<= 1) q += __shfl_xor(q, o);
        const float rstd = rsqrtf(q * (1.0f / 1024.0f) + 1e-5f);
#pragma unroll
        for (int u = 0; u < 4; ++u) {
            const f32x4 gg = *(const f32x4*)(gw + u * 256 + lane * 4), bb = *(const f32x4*)(bw + u * 256 + lane * 4);
            const f32x4 y = v[u] * rstd * gg + bb;
            if (FINAL) *(f32x4*)(src + u * 256 + lane * 4) = y;
            else st_bf4(x1b + (size_t)row * 1024 + u * 256 + lane * 4, y);
        }
    }
}

DI void phase_in1(const Params& p, unsigned char* smem) {
    const bf16_t* x1b = (const bf16_t*)(p.ws + WS_A0);
    const bf16_t* wt = (const bf16_t*)(p.ws + WS_WT1IN);
    bf16_t* QK1 = (bf16_t*)(p.ws + WS_A1); bf16_t* V1t = (bf16_t*)(p.ws + WS_A2); bf16_t* G1 = (bf16_t*)(p.ws + WS_A3);
    int pm, nt;
    for (int it = 0; gemm_unit(it, 12, pm, nt); ++it) {
        const bf16_t* A = x1b + (size_t)pm * 256 * 1024;
        const bf16_t* B = wt + (size_t)nt * 256 * 1024;
        const int t0 = pm * 256;
        if (nt >= 4 && nt < 8) {
            const int sq = t0 >> 12, tl = t0 & 4095;
            gemm_tile(A, B, smem, [&](int i0, int j, f32x4 v) { st_bf4(V1t + ((size_t)(sq * 1024 + (nt - 4) * 256 + j)) * 4096 + tl + i0, v); });
        } else if (nt < 4) {
            const float sc = nt < 2 ? 0.08838834764831845f : 1.0f;
            gemm_tile(B, A, smem, [&](int i0, int j, f32x4 v) { st_bf4(QK1 + (size_t)(t0 + j) * 1024 + nt * 256 + i0, v * sc); });
        } else {
            gemm_tile(B, A, smem, [&](int i0, int j, f32x4 v) { f32x4 s = {silu(v[0]), silu(v[1]), silu(v[2]), silu(v[3])}; st_bf4(G1 + (size_t)(t0 + j) * 1024 + (nt - 8) * 256 + i0, s); });
        }
    }
}

DI void phase_gates(const Params& p, unsigned char* smem) {
    const bf16_t* x1b = (const bf16_t*)(p.ws + WS_A0);
    const bf16_t* wlr = (const bf16_t*)(p.ws + WS_WT1IN) + (size_t)3072 * 1024;
    bf16_t* QK1 = (bf16_t*)(p.ws + WS_A1);
    bf16_t* QKf = (bf16_t*)(p.ws + WS_A4);
    float* part = (float*)smem;
    float* gl = (float*)smem;
    float* lr = (float*)(smem + 131072);
    const int tid = opq_tid(), lane = tid & 63, wid = tid >> 6, r = lane & 31, h = lane >> 5;
    for (int ch = blockIdx.x; ch < T_TOK / 64; ch += gridDim.x) {
        const int tb = ch * 64;
        {
            f32x16 a0, a1;
#pragma unroll
            for (int i = 0; i < 16; ++i) { a0[i] = 0.f; a1[i] = 0.f; }
#pragma unroll
            for (int s = 0; s < 8; ++s) {
                const int k = wid * 128 + s * 16 + h * 8;
                const bf16x8 bq = *(const bf16x8*)(wlr + (size_t)r * 1024 + k);
                const bf16x8 x0 = *(const bf16x8*)(x1b + (size_t)(tb + r) * 1024 + k);
                const bf16x8 x1 = *(const bf16x8*)(x1b + (size_t)(tb + 32 + r) * 1024 + k);
                a0 = MFMA32(x0, bq, a0); a1 = MFMA32(x1, bq, a1);
            }
            __syncthreads();
#pragma unroll
            for (int i = 0; i < 16; ++i) {
                const int t = (i & 3) + 8 * (i >> 2) + 4 * h;
                part[wid * 2048 + t * 32 + r] = a0[i];
                part[wid * 2048 + (t + 32) * 32 + r] = a1[i];
            }
            __syncthreads();
#pragma unroll
            for (int q = 0; q < 4; ++q) { const int e = tid + NTHR * q; float s = 0.f;
#pragma unroll
                for (int w = 0; w < 8; ++w) s += part[w * 2048 + e];
                lr[e] = s; }
            __syncthreads();
        }
        const int c = tid;
#pragma unroll 1
        for (int dir = 0; dir < 2; ++dir) {
            const float* wg = dir ? p.wgb : p.wgf;
            float w[16];
#pragma unroll
            for (int q = 0; q < 16; ++q) w[q] = wg[q * 512 + c];
            const float bg = (dir ? p.bgb : p.bgf)[c];
            float tot = 0.f;
#pragma unroll 4
            for (int t = 0; t < 64; ++t) {
                const f32x4* lp = (const f32x4*)(lr + t * 32 + dir * 16);
                const f32x4 l0 = lp[0], l1 = lp[1], l2 = lp[2], l3 = lp[3];
                float z = bg;
                z += l0[0] * w[0]; z += l0[1] * w[1]; z += l0[2] * w[2]; z += l0[3] * w[3];
                z += l1[0] * w[4]; z += l1[1] * w[5]; z += l1[2] * w[6]; z += l1[3] * w[7];
                z += l2[0] * w[8]; z += l2[1] * w[9]; z += l2[2] * w[10]; z += l2[3] * w[11];
                z += l3[0] * w[12]; z += l3[1] * w[13]; z += l3[2] * w[14]; z += l3[3] * w[15];
                const float gv = (fminf(z, 0.f) - __logf(1.0f + __expf(-fabsf(z)))) * (1.0f / 16.0f);
                gl[t * 512 + c] = gv; tot += gv;
            }
            bf16_t* dst = dir ? QK1 : QKf;
            float pre = 0.f;
#pragma unroll 4
            for (int t = 0; t < 64; ++t) {
                const size_t off = (size_t)(tb + t) * 1024 + c;
                const float qv = bf2f(QK1[off]), kv = bf2f(QK1[off + 512]);
                const float gv = gl[t * 512 + c];
                float b;
                if (dir == 0) { pre += gv; b = pre; } else { b = tot - pre; pre += gv; }
                dst[off] = f2bf(qv * __expf(b));
                dst[off + 512] = f2bf(kv * __expf(-b));
            }
            ((float*)(p.ws + (dir ? WS_ELB : WS_ELF)))[(size_t)ch * 512 + c] = __expf(tot);
        }
    }
}

DI void phase_gla(const Params& p, unsigned char* smem) {
    const bf16_t* V1t = (const bf16_t*)(p.ws + WS_A2);
    bf16_t* sQD = (bf16_t*)smem;
    bf16_t* sKI = (bf16_t*)(smem + 17408);
    bf16_t* sKIt = (bf16_t*)(smem + 34816);
    bf16_t* sVt = (bf16_t*)(smem + 53248);
    float* sEL = (float*)(smem + 90112);
    const int tid = opq_tid(), lane = tid & 63, wid = tid >> 6, r = lane & 31, h = lane >> 5;
    const int dvs = wid * 32;
    for (int u = blockIdx.x; u < NSEQ * 8; u += gridDim.x) {
        const int dir = u & 1, hd = (u >> 1) & 3, sq = u >> 3;
        const bf16_t* QK = (const bf16_t*)(p.ws + (dir ? WS_A1 : WS_A4));
        const float* EL = (const float*)(p.ws + (dir ? WS_ELB : WS_ELF));
        bf16_t* od = (bf16_t*)p.out + (dir ? (size_t)T_TOK * 1024 : 0);
        f32x16 S[4];
#pragma unroll
        for (int d4 = 0; d4 < 4; ++d4)
#pragma unroll
            for (int i = 0; i < 16; ++i) S[d4][i] = 0.f;
        u32x4 rqd[2], rki[2], rv[4];
        auto gload = [&](int ch) {
            const size_t tb = (size_t)sq * SEQ + ch * 64;
#pragma unroll
            for (int q = 0; q < 2; ++q) { const int c2 = tid + NTHR * q, row = c2 >> 4, cc = c2 & 15;
                rqd[q] = *(const u32x4*)(QK + (tb + row) * 1024 + hd * 128 + cc * 8);
                rki[q] = *(const u32x4*)(QK + (tb + row) * 1024 + 512 + hd * 128 + cc * 8); }
#pragma unroll
            for (int q = 0; q < 4; ++q) { const int c2 = tid + NTHR * q, row = c2 >> 3, cc = c2 & 7;
                rv[q] = *(const u32x4*)(V1t + ((size_t)(sq * 1024 + hd * 256 + row)) * 4096 + ch * 64 + cc * 8); }
        };
        auto swrite = [&]() {
#pragma unroll
            for (int q = 0; q < 2; ++q) { const int c2 = tid + NTHR * q, row = c2 >> 4, cc = c2 & 15;
                *(u32x4*)(sQD + row * 136 + cc * 8) = rqd[q];
                *(u32x4*)(sKI + row * 136 + cc * 8) = rki[q];
#pragma unroll
                for (int j = 0; j < 4; ++j) { sKIt[(cc * 8 + 2 * j) * 72 + row] = (bf16_t)(rki[q][j] & 0xffffu); sKIt[(cc * 8 + 2 * j + 1) * 72 + row] = (bf16_t)(rki[q][j] >> 16); } }
#pragma unroll
            for (int q = 0; q < 4; ++q) { const int c2 = tid + NTHR * q, row = c2 >> 3, cc = c2 & 7; *(u32x4*)(sVt + row * 72 + cc * 8) = rv[q]; }
        };
        gload(dir ? 63 : 0);
        __syncthreads();
#pragma unroll 2
        for (int q = 0; q < 16; ++q) { const int e = tid + NTHR * q; sEL[e] = EL[((size_t)sq * 64 + (e >> 7)) * 512 + hd * 128 + (e & 127)]; }
        swrite();
        __syncthreads();
        for (int stp = 0; stp < 64; ++stp) {
            const int ch = dir ? 63 - stp : stp;
            if (stp + 1 < 64) gload(dir ? ch - 1 : ch + 1);
            const size_t tbase = (size_t)sq * SEQ + ch * 64;
#pragma unroll 1
            for (int b = 0; b < 2; ++b) {
                f32x16 o;
#pragma unroll
                for (int i = 0; i < 16; ++i) o[i] = 0.f;
                const bf16_t* qrow = sQD + (32 * b + r) * 136;
#pragma unroll 1
                for (int a = 0; a < 2; ++a) {
                    f32x16 at;
#pragma unroll
                    for (int i = 0; i < 16; ++i) at[i] = 0.f;
#pragma unroll
                    for (int s8 = 0; s8 < 8; ++s8) {
                        const bf16x8 kf = *(const bf16x8*)(sKI + (32 * a + r) * 136 + 16 * s8 + 8 * h);
                        const bf16x8 qf = *(const bf16x8*)(qrow + 16 * s8 + 8 * h);
                        at = MFMA32(kf, qf, at);
                    }
                    const int t = 32 * b + r;
#pragma unroll
                    for (int i = 0; i < 16; ++i) {
                        const int s = 32 * a + (i & 3) + 8 * (i >> 2) + 4 * h;
                        const bool keep = dir ? (s > t) : (s <= t);
                        at[i] = keep ? at[i] : 0.f;
                    }
#pragma unroll
                    for (int s2 = 0; s2 < 2; ++s2) {
                        const bf16x8 pf = pack8(at, s2);
                        const bf16_t* vb = sVt + (dvs + r) * 72 + 32 * a + 16 * s2 + 4 * h;
                        const bf16x8 va = cat44(*(const s16x4*)vb, *(const s16x4*)(vb + 8));
                        o = MFMA32(va, pf, o);
                    }
                }
#pragma unroll
                for (int d4 = 0; d4 < 4; ++d4)
#pragma unroll
                    for (int s2 = 0; s2 < 2; ++s2) {
                        const bf16x8 ps = pack8(S[d4], s2);
                        const bf16_t* qb = qrow + 32 * d4 + 16 * s2 + 4 * h;
                        const bf16x8 qB = cat44(*(const s16x4*)qb, *(const s16x4*)(qb + 8));
                        o = MFMA32(ps, qB, o);
                    }
#pragma unroll
                for (int g = 0; g < 4; ++g) {
                    f32x4 v = {o[4 * g], o[4 * g + 1], o[4 * g + 2], o[4 * g + 3]};
                    st_bf4(od + (tbase + 32 * b + r) * 1024 + hd * 256 + dvs + 8 * g + 4 * h, v);
                }
            }
#pragma unroll
            for (int d4 = 0; d4 < 4; ++d4) {
    #pragma unroll
                for (int s4 = 0; s4 < 4; ++s4) {
                    const bf16x8 ka = *(const bf16x8*)(sKIt + (32 * d4 + r) * 72 + 16 * s4 + 8 * h);
                    const bf16x8 vb = *(const bf16x8*)(sVt + (dvs + r) * 72 + 16 * s4 + 8 * h);
                    S[d4] = MFMA32(ka, vb, S[d4]);
                }
#pragma unroll
                for (int g = 0; g < 4; ++g) {
                    const f32x4 e4 = *(const f32x4*)(sEL + ch * 128 + 32 * d4 + 8 * g + 4 * h);
                    S[d4][4 * g] *= e4[0]; S[d4][4 * g + 1] *= e4[1]; S[d4][4 * g + 2] *= e4[2]; S[d4][4 * g + 3] *= e4[3];
                }
            }
            __syncthreads();
            if (stp + 1 < 64) swrite();
            __syncthreads();
        }
    }
}

DI void phase_combine(const Params& p) {
    const bf16_t* of = (const bf16_t*)p.out; const bf16_t* ob = of + (size_t)T_TOK * 1024;
    const bf16_t* G1 = (const bf16_t*)(p.ws + WS_A3);
    bf16_t* og = (bf16_t*)(p.ws + WS_A2);
    const int tid = opq_tid(), lane = tid & 63, wid = tid >> 6;
    for (int row = blockIdx.x * 8 + wid; row < T_TOK; row += gridDim.x * 8) {
        const size_t base = (size_t)row * 1024 + lane * 16;
        float v[16]; float ss = 0.f;
#pragma unroll
        for (int q = 0; q < 2; ++q) {
            const u32x4 a = *(const u32x4*)(of + base + q * 8), b = *(const u32x4*)(ob + base + q * 8);
#pragma unroll
            for (int j = 0; j < 4; ++j) { v[q * 8 + 2 * j] = bf_lo(a[j]) + bf_lo(b[j]); v[q * 8 + 2 * j + 1] = bf_hi(a[j]) + bf_hi(b[j]); }
        }
#pragma unroll
        for (int j = 0; j < 16; ++j) ss += v[j] * v[j];
#pragma unroll
        for (int o = 1; o < 16; o <<= 1) ss += __shfl_xor(ss, o);
        const float rstd = rsqrtf(ss * (1.0f / 256.0f) + 1e-6f);
#pragma unroll
        for (int q = 0; q < 2; ++q) {
            const u32x4 gt = *(const u32x4*)(G1 + base + q * 8);
            const f32x4 h0 = *(const f32x4*)(p.hnorm + lane * 16 + q * 8), h1 = *(const f32x4*)(p.hnorm + lane * 16 + q * 8 + 4);
            u32x4 o;
            o[0] = pk2(v[q * 8 + 0] * rstd * h0[0] * bf_lo(gt[0]), v[q * 8 + 1] * rstd * h0[1] * bf_hi(gt[0]));
            o[1] = pk2(v[q * 8 + 2] * rstd * h0[2] * bf_lo(gt[1]), v[q * 8 + 3] * rstd * h0[3] * bf_hi(gt[1]));
            o[2] = pk2(v[q * 8 + 4] * rstd * h1[0] * bf_lo(gt[2]), v[q * 8 + 5] * rstd * h1[1] * bf_hi(gt[2]));
            o[3] = pk2(v[q * 8 + 6] * rstd * h1[2] * bf_lo(gt[3]), v[q * 8 + 7] * rstd * h1[3] * bf_hi(gt[3]));
            *(u32x4*)(og + base + q * 8) = o;
        }
    }
}

__global__ void __launch_bounds__(NTHR) fwd_megakernel(Params p) {
    extern __shared__ __attribute__((aligned(16))) unsigned char smem[];
    cg::grid_group grid = cg::this_grid();
    phase_convert(p, smem);      grid.sync();
    phase_in0(p, smem);          grid.sync();
    phase_attn(p, smem);         grid.sync();
    phase_out<false>(p, smem);   grid.sync();
    phase_ln<false>(p);          grid.sync();
    phase_in1(p, smem);          grid.sync();
    phase_gates(p, smem);        grid.sync();
    phase_gla(p, smem);          grid.sync();
    phase_combine(p);            grid.sync();
    phase_out<true>(p, smem);    grid.sync();
    phase_ln<true>(p);
}

extern "C" void kernel_launch(void* const* d_in, const int* in_sizes, int n_in, void* d_out, int out_size, void* d_ws, size_t ws_size, hipStream_t stream) {
    static int grid_blocks = 0;
    if (!grid_blocks) {
        int dev = 0, cus = 0, per_cu = 0;
        hipGetDevice(&dev);
        hipDeviceGetAttribute(&cus, hipDeviceAttributeMultiprocessorCount, dev);
        hipFuncSetAttribute((const void*)fwd_megakernel, hipFuncAttributeMaxDynamicSharedMemorySize, LDS_BYTES);
        hipOccupancyMaxActiveBlocksPerMultiprocessor(&per_cu, (const void*)fwd_megakernel, NTHR, LDS_BYTES);
        if (per_cu < 1) { fprintf(stderr, "occupancy query says %d blocks/CU\n", per_cu); per_cu = 1; }
        grid_blocks = cus * per_cu;
        if (ws_size < WS_A5 + 8 * MiB) fprintf(stderr, "workspace too small: %zu\n", ws_size);
    }
    Params p{};
    p.xp = (const float*)d_in[0]; p.xs = (const float*)d_in[1]; p.w0in = (const float*)d_in[2]; p.sink = (const float*)d_in[3];
    p.w0out = (const float*)d_in[4]; p.ln0g = (const float*)d_in[5]; p.ln0b = (const float*)d_in[6]; p.w1in = (const float*)d_in[7];
    p.wgf = (const float*)d_in[8]; p.bgf = (const float*)d_in[9]; p.wgb = (const float*)d_in[10]; p.bgb = (const float*)d_in[11];
    p.hnorm = (const float*)d_in[12]; p.w1out = (const float*)d_in[13]; p.ln1g = (const float*)d_in[14]; p.ln1b = (const float*)d_in[15];
    p.out = (float*)d_out; p.ws = (unsigned char*)d_ws;
    void* args[] = {&p};
    hipError_t e = hipLaunchCooperativeKernel((const void*)fwd_megakernel, dim3(grid_blocks), dim3(NTHR), args, LDS_BYTES, stream);
    if (e != hipSuccess) fprintf(stderr, "cooperative launch failed: %s (grid %d)\n", hipGetErrorString(e), grid_blocks);
}
```

```cpp
#include <hip/hip_runtime.h>
#include <hip/hip_cooperative_groups.h>
#include <cstdio>
namespace cg = cooperative_groups;

typedef unsigned short bf16_t;
typedef short bf16x8 __attribute__((ext_vector_type(8)));
typedef short s16x4 __attribute__((ext_vector_type(4)));
typedef float f32x16 __attribute__((ext_vector_type(16)));
typedef float f32x4 __attribute__((ext_vector_type(4)));
typedef float f32x2 __attribute__((ext_vector_type(2)));
typedef unsigned u32x4 __attribute__((ext_vector_type(4)));
typedef unsigned u32x2 __attribute__((ext_vector_type(2)));
typedef __bf16 bfv2 __attribute__((ext_vector_type(2)));
#define DI __device__ __forceinline__
#define MFMA32(a, b, c) __builtin_amdgcn_mfma_f32_32x32x16_bf16((a), (b), (c), 0, 0, 0)

constexpr int T_TOK = 98304, TP = 32768, SEQ = 4096, NSEQ = 24, D = 1024;
constexpr int NTHR = 512;
constexpr size_t MiB = 1048576;
constexpr size_t RB = 192 * MiB;
constexpr int LDS_BYTES = 147456;
constexpr float LOG2E = 1.4426950408889634f;
constexpr float DN_ALPHA = 1.4142135623730951f;

struct Params {
    const float *xp, *xs, *w0in, *sink, *w0out, *ln0g, *ln0b, *w1in, *wgf, *bgf, *wgb, *bgb, *hnorm, *w1out, *ln1g, *ln1b;
    float* out;
    unsigned char* ws;
};

DI unsigned pk2(float a, float b) { f32x2 v = {a, b}; bfv2 r = __builtin_convertvector(v, bfv2); return __builtin_bit_cast(unsigned, r); }
DI float bf_lo(unsigned u) { return __uint_as_float(u << 16); }
DI float bf_hi(unsigned u) { return __uint_as_float(u & 0xffff0000u); }
DI float bf2f(bf16_t v) { return __uint_as_float(((unsigned)v) << 16); }
DI bf16_t f2bf(float a) { return (bf16_t)(pk2(a, 0.f) & 0xffffu); }
DI bf16x8 pack8(const f32x16& x, int s) {
    u32x4 p = {pk2(x[8 * s], x[8 * s + 1]), pk2(x[8 * s + 2], x[8 * s + 3]), pk2(x[8 * s + 4], x[8 * s + 5]), pk2(x[8 * s + 6], x[8 * s + 7])};
    return __builtin_bit_cast(bf16x8, p);
}
DI bf16x8 cat44(s16x4 lo, s16x4 hi) { return __builtin_shufflevector(lo, hi, 0, 1, 2, 3, 4, 5, 6, 7); }
DI int opq_tid() { int t = threadIdx.x; asm volatile("" : "+v"(t)); return t; }
DI float silu(float x) { return x / (1.0f + __expf(-x)); }
DI const float* xrow(const Params& p, int t) { return t < TP ? p.xp + (size_t)t * D : p.xs + (size_t)(t - TP) * D; }

constexpr size_t WS_WT0IN = 0, WS_WT0OUT = WS_WT0IN + 2560 * 1024 * 2, WS_WT1IN = WS_WT0OUT + 1024 * 1024 * 2, WS_WT1OUT = WS_WT1IN + 3104 * 1024 * 2;
constexpr size_t WS_A0 = 16 * MiB, WS_A1 = WS_A0 + RB, WS_A2 = WS_A1 + RB, WS_A3 = WS_A2 + RB, WS_A4 = WS_A3 + RB, WS_A5 = WS_A4 + RB;
constexpr size_t WS_K0 = WS_A3, WS_V0T = WS_A3 + 48 * MiB;
constexpr size_t WS_ELF = WS_A5, WS_ELB = WS_A5 + 1536 * 512 * 4;

DI void phase_convert(const Params& p, unsigned char* smem) {
    bf16_t* xb = (bf16_t*)(p.ws + WS_A0);
    const int tid = opq_tid();
    const size_t n8 = (size_t)T_TOK * D / 8;
    for (size_t i = (size_t)blockIdx.x * NTHR + tid; i < n8; i += (size_t)gridDim.x * NTHR) {
        const size_t e = i * 8; const int t = (int)(e >> 10);
        const float* src = xrow(p, t) + (e & 1023);
        const f32x4 a = *(const f32x4*)src, b = *(const f32x4*)(src + 4);
        u32x4 o = {pk2(a[0], a[1]), pk2(a[2], a[3]), pk2(b[0], b[1]), pk2(b[2], b[3])};
        *(u32x4*)(xb + e) = o;
    }
    float* tile = (float*)smem;
    for (int u = blockIdx.x; u < 3856; u += gridDim.x) {
        int v = u; const float* W; bf16_t* Wt; int N;
        if (v < 1280) { W = p.w0in; Wt = (bf16_t*)(p.ws + WS_WT0IN); N = 2560; }
        else if ((v -= 1280) < 512) { W = p.w0out; Wt = (bf16_t*)(p.ws + WS_WT0OUT); N = 1024; }
        else if ((v -= 512) < 1552) { W = p.w1in; Wt = (bf16_t*)(p.ws + WS_WT1IN); N = 3104; }
        else { v -= 1552; W = p.w1out; Wt = (bf16_t*)(p.ws + WS_WT1OUT); N = 1024; }
        const int nn32 = N / 32, nt = v % nn32, kt = v / nn32;
#pragma unroll
        for (int q = 0; q < 4; ++q) { const int e = tid + NTHR * q, kk = e >> 5, nn = e & 31; tile[kk * 33 + nn] = W[(size_t)(kt * 64 + kk) * N + nt * 32 + nn]; }
        __syncthreads();
#pragma unroll
        for (int q = 0; q < 2; ++q) { const int e = tid + NTHR * q, nn = e >> 5, kp = e & 31;
            *(unsigned*)(Wt + (size_t)(nt * 32 + nn) * 1024 + kt * 64 + 2 * kp) = pk2(tile[(2 * kp) * 33 + nn], tile[(2 * kp + 1) * 33 + nn]); }
        __syncthreads();
    }
}

DI void gemm_kloop(const bf16_t* __restrict__ P, const bf16_t* __restrict__ Q, unsigned char* smem, f32x16 (&acc)[4][2], int tid) {
    const int lane = tid & 63, wid = tid >> 6, wi = wid >> 2, wj = wid & 3, r = lane & 31, h = lane >> 5;
    const int crow = tid >> 3, ccol = (tid & 7) * 8;
#pragma unroll
    for (int a = 0; a < 4; ++a)
#pragma unroll
        for (int b = 0; b < 2; ++b)
#pragma unroll
            for (int i = 0; i < 16; ++i) acc[a][b][i] = 0.f;
    u32x4 rp[4], rq[4];
    const bf16_t* gp = P + (size_t)crow * 1024 + ccol;
    const bf16_t* gq = Q + (size_t)crow * 1024 + ccol;
    unsigned char* sw = smem + (crow * 72 + ccol) * 2;
#pragma unroll
    for (int u = 0; u < 4; ++u) { rp[u] = *(const u32x4*)(gp + (size_t)u * 64 * 1024); rq[u] = *(const u32x4*)(gq + (size_t)u * 64 * 1024); }
#pragma unroll
    for (int u = 0; u < 4; ++u) { *(u32x4*)(sw + u * 64 * 144) = rp[u]; *(u32x4*)(sw + 36864 + u * 64 * 144) = rq[u]; }
#pragma unroll
    for (int u = 0; u < 4; ++u) { rp[u] = *(const u32x4*)(gp + (size_t)u * 64 * 1024 + 64); rq[u] = *(const u32x4*)(gq + (size_t)u * 64 * 1024 + 64); }
    __syncthreads();
    const unsigned char* fpb = smem + ((wi * 128 + r) * 72 + h * 8) * 2;
    const unsigned char* fqb = smem + 36864 + ((wj * 64 + r) * 72 + h * 8) * 2;
    for (int kt = 0; kt < 16; ++kt) {
        const int cur = kt & 1;
        if (kt + 1 < 16) {
            unsigned char* d = sw + (cur ^ 1) * 73728;
#pragma unroll
            for (int u = 0; u < 4; ++u) { *(u32x4*)(d + u * 64 * 144) = rp[u]; *(u32x4*)(d + 36864 + u * 64 * 144) = rq[u]; }
            if (kt + 2 < 16) {
#pragma unroll
                for (int u = 0; u < 4; ++u) { rp[u] = *(const u32x4*)(gp + (size_t)u * 64 * 1024 + (kt + 2) * 64); rq[u] = *(const u32x4*)(gq + (size_t)u * 64 * 1024 + (kt + 2) * 64); }
            }
        }
        __builtin_amdgcn_sched_barrier(0);
        const unsigned char* bp = fpb + cur * 73728;
        const unsigned char* bq = fqb + cur * 73728;
#pragma unroll
        for (int s = 0; s < 4; ++s) {
            bf16x8 fp[4], fq[2];
#pragma unroll
            for (int a = 0; a < 4; ++a) fp[a] = *(const bf16x8*)(bp + a * 32 * 144 + s * 32);
#pragma unroll
            for (int b = 0; b < 2; ++b) fq[b] = *(const bf16x8*)(bq + b * 32 * 144 + s * 32);
#pragma unroll
            for (int a = 0; a < 4; ++a)
#pragma unroll
                for (int b = 0; b < 2; ++b) acc[a][b] = MFMA32(fp[a], fq[b], acc[a][b]);
        }
        __syncthreads();
    }
}

template <class TF, class ST> DI void gemm_tile_bf16(const bf16_t* __restrict__ P, const bf16_t* __restrict__ Q, unsigned char* smem, TF tf, ST st) {
    const int tid = opq_tid(), lane = tid & 63, wid = tid >> 6, wi = wid >> 2, wj = wid & 3, r = lane & 31, h = lane >> 5;
    f32x16 acc[4][2];
    gemm_kloop(P, Q, smem, acc, tid);
#pragma unroll
    for (int a = 0; a < 4; ++a)
#pragma unroll
        for (int b = 0; b < 2; ++b)
#pragma unroll
            for (int g = 0; g < 4; ++g) {
                const int i0 = wi * 128 + a * 32 + 8 * g + 4 * h, j = wj * 64 + b * 32 + r;
                f32x4 v = {acc[a][b][4 * g], acc[a][b][4 * g + 1], acc[a][b][4 * g + 2], acc[a][b][4 * g + 3]};
                v = tf(v, i0, j);
                u32x2 o = {pk2(v[0], v[1]), pk2(v[2], v[3])};
                *(u32x2*)(smem + j * 528 + i0 * 2) = o;
            }
    __syncthreads();
#pragma unroll 4
    for (int q = 0; q < 16; ++q) {
        const int c = tid + NTHR * q, j = c >> 5, ch = c & 31;
        const u32x4 w = *(const u32x4*)(smem + j * 528 + ch * 16);
        st(j, ch * 8, w);
    }
    __syncthreads();
}

template <class EP> DI void gemm_tile_f32(const bf16_t* __restrict__ P, const bf16_t* __restrict__ Q, unsigned char* smem, EP ep) {
    const int tid = opq_tid(), lane = tid & 63, wid = tid >> 6, wi = wid >> 2, wj = wid & 3, r = lane & 31, h = lane >> 5;
    f32x16 acc[4][2];
    gemm_kloop(P, Q, smem, acc, tid);
#pragma unroll
    for (int pass = 0; pass < 2; ++pass) {
        if ((wj >> 1) == pass) {
#pragma unroll
            for (int a = 0; a < 4; ++a)
#pragma unroll
                for (int b = 0; b < 2; ++b)
#pragma unroll
                    for (int g = 0; g < 4; ++g) {
                        const int i0 = wi * 128 + a * 32 + 8 * g + 4 * h, jl = (wj & 1) * 64 + b * 32 + r;
                        f32x4 v = {acc[a][b][4 * g], acc[a][b][4 * g + 1], acc[a][b][4 * g + 2], acc[a][b][4 * g + 3]};
                        *(f32x4*)(smem + (jl * 260 + i0) * 4) = v;
                    }
        }
        __syncthreads();
#pragma unroll 4
        for (int q = 0; q < 16; ++q) {
            const int c = tid + NTHR * q, jl = c >> 6, ch = c & 63;
            const f32x4 v = *(const f32x4*)(smem + (jl * 260 + ch * 4) * 4);
            ep(pass * 128 + jl, ch * 4, v);
        }
        __syncthreads();
    }
}

DI bool gemm_unit(int it, int nN, int& pm, int& nt) {
    const int G = gridDim.x;
    if ((G & 7) == 0) {
        const int xcd = blockIdx.x & 7, l = blockIdx.x >> 3, per = G >> 3;
        const int u = it * per + l;
        if (u >= 48 * nN) return false;
        pm = (u / nN) * 8 + xcd; nt = u % nN; return true;
    } else {
        const int u = it * G + blockIdx.x;
        if (u >= 384 * nN) return false;
        pm = u / nN; nt = u % nN; return true;
    }
}

DI size_t qk_off(int sq, int hd, int ch) { return ((size_t)((sq * 4 + hd) * 64 + ch)) * 16384; }
DI size_t v1_off(int sq, int hd, int ch) { return ((size_t)((sq * 4 + hd) * 64 + ch)) * 16384; }
DI void st_bf4(bf16_t* dst, f32x4 v) { u32x2 o = {pk2(v[0], v[1]), pk2(v[2], v[3])}; *(u32x2*)dst = o; }

DI void phase_in0(const Params& p, unsigned char* smem) {
    const bf16_t* xb = (const bf16_t*)(p.ws + WS_A0);
    const bf16_t* wt = (const bf16_t*)(p.ws + WS_WT0IN);
    bf16_t* Q0 = (bf16_t*)(p.ws + WS_A1); bf16_t* G0 = (bf16_t*)(p.ws + WS_A2); bf16_t* K0 = (bf16_t*)(p.ws + WS_K0); bf16_t* V0t = (bf16_t*)(p.ws + WS_V0T);
    int pm, nt;
    auto ident = [](f32x4 v, int, int) { return v; };
    for (int it = 0; gemm_unit(it, 10, pm, nt); ++it) {
        const bf16_t* A = xb + (size_t)pm * 256 * 1024;
        const bf16_t* B = wt + (size_t)nt * 256 * 1024;
        const int t0 = pm * 256;
        if (nt == 5) {
            const int sq = t0 >> 12, tl = t0 & 4095;
            gemm_tile_bf16(A, B, smem, ident, [&](int j, int i, u32x4 w) { *(u32x4*)(V0t + ((size_t)(sq * 256 + j)) * 4096 + tl + i) = w; });
        } else if (nt < 4) {
            gemm_tile_bf16(B, A, smem, ident, [&](int j, int i, u32x4 w) { *(u32x4*)(Q0 + (size_t)(t0 + j) * 1024 + nt * 256 + i) = w; });
        } else if (nt == 4) {
            gemm_tile_bf16(B, A, smem, ident, [&](int j, int i, u32x4 w) { *(u32x4*)(K0 + (size_t)(t0 + j) * 256 + i) = w; });
        } else {
            gemm_tile_bf16(B, A, smem, [](f32x4 v, int, int) { return (f32x4){silu(v[0]), silu(v[1]), silu(v[2]), silu(v[3])}; },
                           [&](int j, int i, u32x4 w) { *(u32x4*)(G0 + (size_t)(t0 + j) * 1024 + (nt - 6) * 256 + i) = w; });
        }
    }
}

DI void phase_attn(const Params& p, unsigned char* smem) {
    const bf16_t* Q0 = (const bf16_t*)(p.ws + WS_A1); const bf16_t* G0 = (const bf16_t*)(p.ws + WS_A2);
    const bf16_t* K0 = (const bf16_t*)(p.ws + WS_K0); const bf16_t* V0t = (const bf16_t*)(p.ws + WS_V0T);
    bf16_t* og = (bf16_t*)(p.ws + WS_A0);
    bf16_t* sK = (bf16_t*)smem;
    bf16_t* sVt = (bf16_t*)(smem + 55296);
    const int tid = opq_tid(), lane = tid & 63, wid = tid >> 6, r = lane & 31, h = lane >> 5;
    for (int u = blockIdx.x; u < NSEQ * 32 * 4; u += gridDim.x) {
        const int g = u & 3, n = (u >> 2) & 31, sq = u >> 7;
        const int kbase = (n - 1) * 128;
        __syncthreads();
#pragma unroll
        for (int q = 0; q < 6; ++q) {
            const int c = tid + NTHR * q, row = c >> 3, cc = c & 7, kpos = kbase + row;
            if (kpos >= 0 && kpos < SEQ) *(u32x4*)(sK + row * 72 + cc * 8) = *(const u32x4*)(K0 + ((size_t)sq * SEQ + kpos) * 256 + g * 64 + cc * 8);
        }
#pragma unroll
        for (int q = 0; q < 6; ++q) {
            const int c = tid + NTHR * q, row = c / 48, cc = c % 48, kpos = kbase + cc * 8;
            if (kpos >= 0 && kpos < SEQ) *(u32x4*)(sVt + row * 392 + cc * 8) = *(const u32x4*)(V0t + ((size_t)(sq * 256 + g * 64 + row)) * 4096 + kpos);
        }
        __syncthreads();
        const int head = wid >> 1, hq = g * 4 + head;
        const float slope2 = exp2f(-0.5f * (float)(hq + 1)) * LOG2E;
        const float sink2 = p.sink[hq] * LOG2E;
        for (int e = 0; e < 2; ++e) {
            const int sub = (wid & 1) * 2 + e;
            const int t0 = n * 128 + sub * 32;
            const size_t trow = (size_t)sq * SEQ + t0 + r;
            bf16x8 qf[4];
#pragma unroll
            for (int s = 0; s < 4; ++s) qf[s] = *(const bf16x8*)(Q0 + trow * 1024 + hq * 64 + s * 16 + h * 8);
            f32x16 o0, o1;
#pragma unroll
            for (int i = 0; i < 16; ++i) { o0[i] = 0.f; o1[i] = 0.f; }
            float mrun = sink2, lsum = (h == 0) ? 1.0f : 0.0f;
            for (int m = -4; m <= 4; ++m) {
                const int kb = t0 + 32 * m;
                if (kb < 0 || kb >= SEQ) continue;
                const int kl = kb - kbase;
                f32x16 st;
#pragma unroll
                for (int i = 0; i < 16; ++i) st[i] = 0.f;
#pragma unroll
                for (int s = 0; s < 4; ++s) { const bf16x8 kf = *(const bf16x8*)(sK + (kl + r) * 72 + s * 16 + h * 8); st = MFMA32(kf, qf[s], st); }
                const float fd0 = (float)(r - 32 * m - 4 * h);
                float mx = -3.0e38f;
#pragma unroll
                for (int i = 0; i < 16; ++i) {
                    const float fd = fabsf(fd0 - (float)((i & 3) + 8 * (i >> 2)));
                    float sc = st[i] * (0.125f * LOG2E) - slope2 * fd;
                    sc = (fd <= 128.0f) ? sc : -3.0e38f;
                    st[i] = sc; mx = fmaxf(mx, sc);
                }
                mx = fmaxf(mx, __shfl_xor(mx, 32));
                const float mnew = fmaxf(mrun, mx);
                const float al = exp2f(mrun - mnew);
                mrun = mnew;
                float ps = 0.f;
#pragma unroll
                for (int i = 0; i < 16; ++i) { const float pe = exp2f(st[i] - mnew); st[i] = pe; ps += pe; }
                lsum = lsum * al + ps;
#pragma unroll
                for (int i = 0; i < 16; ++i) { o0[i] *= al; o1[i] *= al; }
#pragma unroll
                for (int s2 = 0; s2 < 2; ++s2) {
                    const bf16x8 pf = pack8(st, s2);
                    const bf16_t* vb = sVt + r * 392 + kl + 16 * s2 + 4 * h;
                    const bf16x8 v0 = cat44(*(const s16x4*)vb, *(const s16x4*)(vb + 8));
                    const bf16x8 v1 = cat44(*(const s16x4*)(vb + 32 * 392), *(const s16x4*)(vb + 32 * 392 + 8));
                    o0 = MFMA32(v0, pf, o0);
                    o1 = MFMA32(v1, pf, o1);
                }
            }
            const float inv = 1.0f / (lsum + __shfl_xor(lsum, 32));
#pragma unroll
            for (int dt = 0; dt < 2; ++dt)
#pragma unroll
                for (int gq = 0; gq < 4; ++gq) {
                    const int col = hq * 64 + dt * 32 + 8 * gq + 4 * h;
                    const u32x2 gt = *(const u32x2*)(G0 + trow * 1024 + col);
                    const f32x16& oo = dt ? o1 : o0;
                    f32x4 v = {oo[4 * gq] * inv * bf_lo(gt[0]), oo[4 * gq + 1] * inv * bf_hi(gt[0]), oo[4 * gq + 2] * inv * bf_lo(gt[1]), oo[4 * gq + 3] * inv * bf_hi(gt[1])};
                    st_bf4(og + trow * 1024 + col, v);
                }
        }
    }
}

template <bool L1> DI void phase_out(const Params& p, unsigned char* smem) {
    const bf16_t* A0 = (const bf16_t*)(p.ws + (L1 ? WS_A2 : WS_A0));
    const bf16_t* wt = (const bf16_t*)(p.ws + (L1 ? WS_WT1OUT : WS_WT0OUT));
    const bf16_t* x1b = (const bf16_t*)(p.ws + WS_A0);
    int pm, nt;
    for (int it = 0; gemm_unit(it, 4, pm, nt); ++it) {
        const bf16_t* A = A0 + (size_t)pm * 256 * 1024;
        const bf16_t* B = wt + (size_t)nt * 256 * 1024;
        const int t0 = pm * 256;
        gemm_tile_f32(B, A, smem, [&](int j, int i, f32x4 v) {
            const int t = t0 + j, c = nt * 256 + i;
            f32x4 xr;
            if (L1) { const u32x2 xv = *(const u32x2*)(x1b + (size_t)t * 1024 + c); xr = (f32x4){bf_lo(xv[0]), bf_hi(xv[0]), bf_lo(xv[1]), bf_hi(xv[1])}; }
            else xr = *(const f32x4*)(xrow(p, t) + c);
            *(f32x4*)(p.out + (size_t)t * 1024 + c) = xr * DN_ALPHA + v;
        });
    }
}

template <bool FINAL> DI void phase_ln(const Params& p) {
    const float* gw = FINAL ? p.ln1g : p.ln0g; const float* bw = FINAL ? p.ln1b : p.ln0b;
    bf16_t* x1b = (bf16_t*)(p.ws + WS_A0);
    const int tid = opq_tid(), lane = tid & 63, wid = tid >> 6;
    for (int row = blockIdx.x * 8 + wid; row < T_TOK; row += gridDim.x * 8) {
        float* src = p.out + (size_t)row * 1024;
        f32x4 v[4]; float s = 0.f;
#pragma unroll
        for (int u = 0; u < 4; ++u) { v[u] = *(const f32x4*)(src + u * 256 + lane * 4); s += (v[u][0] + v[u][1]) + (v[u][2] + v[u][3]); }
#pragma unroll
        for (int o = 1; o < 64; o <<= 1) s += __shfl_xor(s, o);
        const float mu = s * (1.0f / 1024.0f);
        float q = 0.f;
#pragma unroll
        for (int u = 0; u < 4; ++u) { v[u] -= mu; q += (v[u][0] * v[u][0] + v[u][1] * v[u][1]) + (v[u][2] * v[u][2] + v[u][3] * v[u][3]); }
#pragma unroll
        for (int o = 1; o < 64; o <<= 1) q += __shfl_xor(q, o);
        const float rstd = rsqrtf(q * (1.0f / 1024.0f) + 1e-5f);
#pragma unroll
        for (int u = 0; u < 4; ++u) {
            const f32x4 gg = *(const f32x4*)(gw + u * 256 + lane * 4), bb = *(const f32x4*)(bw + u * 256 + lane * 4);
            const f32x4 y = v[u] * rstd * gg + bb;
            if (FINAL) *(f32x4*)(src + u * 256 + lane * 4) = y;
            else st_bf4(x1b + (size_t)row * 1024 + u * 256 + lane * 4, y);
        }
    }
}

DI void phase_in1(const Params& p, unsigned char* smem) {
    const bf16_t* x1b = (const bf16_t*)(p.ws + WS_A0);
    const bf16_t* wt = (const bf16_t*)(p.ws + WS_WT1IN);
    bf16_t* QK1 = (bf16_t*)(p.ws + WS_A1); bf16_t* V1t = (bf16_t*)(p.ws + WS_A2); bf16_t* G1 = (bf16_t*)(p.ws + WS_A3);
    int pm, nt;
    for (int it = 0; gemm_unit(it, 12, pm, nt); ++it) {
        const bf16_t* A = x1b + (size_t)pm * 256 * 1024;
        const bf16_t* B = wt + (size_t)nt * 256 * 1024;
        const int t0 = pm * 256;
        if (nt >= 4 && nt < 8) {
            const int sq = t0 >> 12, tl = t0 & 4095;
            gemm_tile_bf16(A, B, smem, [](f32x4 v, int, int) { return v; },
                           [&](int j, int i, u32x4 w) { *(u32x4*)(V1t + v1_off(sq, nt - 4, (tl + i) >> 6) + j * 64 + (i & 63)) = w; });
        } else if (nt < 4) {
            const float sc = nt < 2 ? 0.08838834764831845f : 1.0f;
            gemm_tile_bf16(B, A, smem, [&](f32x4 v, int, int) { return v * sc; },
                           [&](int j, int i, u32x4 w) { const int t = t0 + j, f = (nt & 1) * 256 + i;
                               *(u32x4*)(QK1 + qk_off(t >> 12, f >> 7, (t >> 6) & 63) + (nt >> 1) * 8192 + (t & 63) * 128 + (f & 127)) = w; });
        } else {
            gemm_tile_bf16(B, A, smem, [](f32x4 v, int, int) { return (f32x4){silu(v[0]), silu(v[1]), silu(v[2]), silu(v[3])}; },
                           [&](int j, int i, u32x4 w) { *(u32x4*)(G1 + (size_t)(t0 + j) * 1024 + (nt - 8) * 256 + i) = w; });
        }
    }
}

DI void phase_gates(const Params& p, unsigned char* smem) {
    const bf16_t* x1b = (const bf16_t*)(p.ws + WS_A0);
    const bf16_t* wlr = (const bf16_t*)(p.ws + WS_WT1IN) + (size_t)3072 * 1024;
    bf16_t* QK1 = (bf16_t*)(p.ws + WS_A1);
    bf16_t* QKf = (bf16_t*)(p.ws + WS_A4);
    float* part = (float*)smem;
    bf16_t* sIn = (bf16_t*)smem;
    bf16_t* sOut = (bf16_t*)(smem + 32768);
    float* sTot = (float*)(smem + 98304);
    float* lr = (float*)(smem + 102400);
    const int tid = opq_tid(), lane = tid & 63, wid = tid >> 6, r = lane & 31, h = lane >> 5;
    const int c = tid & 127, grp = tid >> 7;
    for (int cg = blockIdx.x; cg < T_TOK / 64; cg += gridDim.x) {
        const int tb = cg * 64, sq = cg >> 6, ch = cg & 63;
        {
            f32x16 a0, a1;
#pragma unroll
            for (int i = 0; i < 16; ++i) { a0[i] = 0.f; a1[i] = 0.f; }
#pragma unroll
            for (int s = 0; s < 8; ++s) {
                const int k = wid * 128 + s * 16 + h * 8;
                const bf16x8 bq = *(const bf16x8*)(wlr + (size_t)r * 1024 + k);
                const bf16x8 x0 = *(const bf16x8*)(x1b + (size_t)(tb + r) * 1024 + k);
                const bf16x8 x1 = *(const bf16x8*)(x1b + (size_t)(tb + 32 + r) * 1024 + k);
                a0 = MFMA32(x0, bq, a0); a1 = MFMA32(x1, bq, a1);
            }
            __syncthreads();
#pragma unroll
            for (int i = 0; i < 16; ++i) {
                const int t = (i & 3) + 8 * (i >> 2) + 4 * h;
                part[wid * 2048 + t * 32 + r] = a0[i];
                part[wid * 2048 + (t + 32) * 32 + r] = a1[i];
            }
            __syncthreads();
#pragma unroll
            for (int q = 0; q < 4; ++q) { const int e = tid + NTHR * q; float s = 0.f;
#pragma unroll
                for (int w = 0; w < 8; ++w) s += part[w * 2048 + e];
                lr[e] = s; }
            __syncthreads();
        }
#pragma unroll 1
        for (int hd = 0; hd < 4; ++hd) {
            bf16_t* gin = QK1 + qk_off(sq, hd, ch);
            bf16_t* gf = QKf + qk_off(sq, hd, ch);
#pragma unroll
            for (int q = 0; q < 4; ++q) *(u32x4*)(sIn + (tid + NTHR * q) * 8) = *(const u32x4*)(gin + (tid + NTHR * q) * 8);
            float pl[2][16];
#pragma unroll
            for (int dir = 0; dir < 2; ++dir) {
                const float* wg = (dir ? p.wgb : p.wgf) + hd * 128 + c;
                float w[16];
#pragma unroll
                for (int q = 0; q < 16; ++q) w[q] = wg[q * 512];
                const float bg = (dir ? p.bgb : p.bgf)[hd * 128 + c];
                float run = 0.f;
#pragma unroll
                for (int i = 0; i < 16; ++i) {
                    const f32x4* lp = (const f32x4*)(lr + (grp * 16 + i) * 32 + dir * 16);
                    const f32x4 l0 = lp[0], l1 = lp[1], l2 = lp[2], l3 = lp[3];
                    float z = bg;
                    z += l0[0] * w[0]; z += l0[1] * w[1]; z += l0[2] * w[2]; z += l0[3] * w[3];
                    z += l1[0] * w[4]; z += l1[1] * w[5]; z += l1[2] * w[6]; z += l1[3] * w[7];
                    z += l2[0] * w[8]; z += l2[1] * w[9]; z += l2[2] * w[10]; z += l2[3] * w[11];
                    z += l3[0] * w[12]; z += l3[1] * w[13]; z += l3[2] * w[14]; z += l3[3] * w[15];
                    run += (fminf(z, 0.f) - __logf(1.0f + __expf(-fabsf(z)))) * (1.0f / 16.0f);
                    pl[dir][i] = run;
                }
                sTot[(dir * 4 + grp) * 128 + c] = run;
            }
            __syncthreads();
#pragma unroll
            for (int dir = 0; dir < 2; ++dir) {
                const float t0 = sTot[(dir * 4 + 0) * 128 + c], t1 = sTot[(dir * 4 + 1) * 128 + c], t2 = sTot[(dir * 4 + 2) * 128 + c], t3 = sTot[(dir * 4 + 3) * 128 + c];
                const float tot = (t0 + t1) + (t2 + t3);
                const float base = (grp > 0 ? t0 : 0.f) + (grp > 1 ? t1 : 0.f) + (grp > 2 ? t2 : 0.f);
                if (grp == 0) ((float*)(p.ws + (dir ? WS_ELB : WS_ELF)))[(size_t)cg * 512 + hd * 128 + c] = __expf(tot);
#pragma unroll
                for (int i = 0; i < 16; ++i) {
                    const int t = grp * 16 + i;
                    const float qv = bf2f(sIn[t * 128 + c]), kv = bf2f(sIn[8192 + t * 128 + c]);
                    const float incl = base + pl[dir][i];
                    const float b = dir ? (tot - (base + (i ? pl[dir][i - 1] : 0.f))) : incl;
                    sOut[dir * 16384 + t * 128 + c] = f2bf(qv * __expf(b));
                    sOut[dir * 16384 + 8192 + t * 128 + c] = f2bf(kv * __expf(-b));
                }
            }
            __syncthreads();
#pragma unroll
            for (int q = 0; q < 4; ++q) {
                *(u32x4*)(gf + (tid + NTHR * q) * 8) = *(const u32x4*)(sOut + (tid + NTHR * q) * 8);
                *(u32x4*)(gin + (tid + NTHR * q) * 8) = *(const u32x4*)(sOut + 16384 + (tid + NTHR * q) * 8);
            }
        }
    }
}

#define LDS3 __attribute__((address_space(3)))
DI s16x4 tr_read(const bf16_t* p) { return __builtin_amdgcn_ds_read_tr16_b64_v4i16((LDS3 s16x4*)p); }
DI void phase_gla(const Params& p, unsigned char* smem) {
    const bf16_t* V1t = (const bf16_t*)(p.ws + WS_A2);
    bf16_t* sQD = (bf16_t*)smem;
    bf16_t* sKI = (bf16_t*)(smem + 17408);
    bf16_t* sVt = (bf16_t*)(smem + 34816);
    float* sEL = (float*)(smem + 71680);
    bf16_t* sAtt = (bf16_t*)(smem + 104448);
    const int tid = opq_tid(), lane = tid & 63, wid = tid >> 6, r = lane & 31, h = lane >> 5;
    const int dvs = wid * 32;
    const bf16_t* trb = sKI + (8 * h + ((lane & 15) >> 2)) * 136 + 16 * ((lane >> 4) & 1) + 4 * (lane & 3);
    for (int u = blockIdx.x; u < NSEQ * 8; u += gridDim.x) {
        const int dir = u & 1, hd = (u >> 1) & 3, sq = u >> 3;
        const bf16_t* QK = (const bf16_t*)(p.ws + (dir ? WS_A1 : WS_A4));
        const float* EL = (const float*)(p.ws + (dir ? WS_ELB : WS_ELF));
        bf16_t* od = (bf16_t*)p.out + (dir ? (size_t)T_TOK * 1024 : 0);
        f32x16 S[4];
#pragma unroll
        for (int d4 = 0; d4 < 4; ++d4)
#pragma unroll
            for (int i = 0; i < 16; ++i) S[d4][i] = 0.f;
        u32x4 rqd[2], rki[2], rv[4];
        auto gload = [&](int ch) {
            const bf16_t* gq = QK + qk_off(sq, hd, ch);
            const bf16_t* gv = V1t + v1_off(sq, hd, ch);
#pragma unroll
            for (int q = 0; q < 2; ++q) { rqd[q] = *(const u32x4*)(gq + (tid + NTHR * q) * 8); rki[q] = *(const u32x4*)(gq + 8192 + (tid + NTHR * q) * 8); }
#pragma unroll
            for (int q = 0; q < 4; ++q) rv[q] = *(const u32x4*)(gv + (tid + NTHR * q) * 8);
        };
        auto swrite = [&]() {
#pragma unroll
            for (int q = 0; q < 2; ++q) { const int c2 = tid + NTHR * q, row = c2 >> 4, cc = c2 & 15;
                *(u32x4*)(sQD + row * 136 + cc * 8) = rqd[q];
                *(u32x4*)(sKI + row * 136 + cc * 8) = rki[q]; }
#pragma unroll
            for (int q = 0; q < 4; ++q) { const int c2 = tid + NTHR * q, row = c2 >> 3, cc = c2 & 7; *(u32x4*)(sVt + row * 72 + cc * 8) = rv[q]; }
        };
        gload(dir ? 63 : 0);
        __syncthreads();
#pragma unroll 2
        for (int q = 0; q < 16; ++q) { const int e = tid + NTHR * q; sEL[e] = EL[((size_t)sq * 64 + (e >> 7)) * 512 + hd * 128 + (e & 127)]; }
        swrite();
        __syncthreads();
        for (int stp = 0; stp < 64; ++stp) {
            const int ch = dir ? 63 - stp : stp;
            if (stp + 1 < 64) gload(dir ? ch - 1 : ch + 1);
            __builtin_amdgcn_sched_barrier(0);
            if (wid < 4) {
                const int a = wid >> 1, b = wid & 1;
                bf16x8 kf[8], qf[8];
#pragma unroll
                for (int s8 = 0; s8 < 8; ++s8) { kf[s8] = *(const bf16x8*)(sKI + (32 * a + r) * 136 + 16 * s8 + 8 * h); qf[s8] = *(const bf16x8*)(sQD + (32 * b + r) * 136 + 16 * s8 + 8 * h); }
                f32x16 at0, at1;
#pragma unroll
                for (int i = 0; i < 16; ++i) { at0[i] = 0.f; at1[i] = 0.f; }
#pragma unroll
                for (int s8 = 0; s8 < 8; s8 += 2) { at0 = MFMA32(kf[s8], qf[s8], at0); at1 = MFMA32(kf[s8 + 1], qf[s8 + 1], at1); }
                const int t = 32 * b + r;
#pragma unroll
                for (int i = 0; i < 16; ++i) {
                    const int s = 32 * a + (i & 3) + 8 * (i >> 2) + 4 * h;
                    const bool keep = dir ? (s > t) : (s <= t);
                    at0[i] = keep ? (at0[i] + at1[i]) : 0.f;
                }
#pragma unroll
                for (int s2 = 0; s2 < 2; ++s2) *(bf16x8*)(sAtt + ((a * 2 + b) * 2 + s2) * 512 + lane * 8) = pack8(at0, s2);
            }
            __builtin_amdgcn_sched_barrier(0);
            f32x16 o0, o1;
#pragma unroll
            for (int i = 0; i < 16; ++i) { o0[i] = 0.f; o1[i] = 0.f; }
#pragma unroll
            for (int d4 = 0; d4 < 4; ++d4)
#pragma unroll
                for (int s2 = 0; s2 < 2; ++s2) {
                    const bf16x8 ps = pack8(S[d4], s2);
                    const bf16_t* qb = sQD + r * 136 + 32 * d4 + 16 * s2 + 4 * h;
                    const bf16x8 q0 = cat44(*(const s16x4*)qb, *(const s16x4*)(qb + 8));
                    const bf16x8 q1 = cat44(*(const s16x4*)(qb + 32 * 136), *(const s16x4*)(qb + 32 * 136 + 8));
                    o0 = MFMA32(ps, q0, o0);
                    o1 = MFMA32(ps, q1, o1);
                }
            __syncthreads();
#pragma unroll
            for (int a = 0; a < 2; ++a)
#pragma unroll
                for (int s2 = 0; s2 < 2; ++s2) {
                    const bf16_t* vb = sVt + (dvs + r) * 72 + 32 * a + 16 * s2 + 4 * h;
                    const bf16x8 va = cat44(*(const s16x4*)vb, *(const s16x4*)(vb + 8));
                    const bf16x8 p0 = *(const bf16x8*)(sAtt + ((a * 2 + 0) * 2 + s2) * 512 + lane * 8);
                    const bf16x8 p1 = *(const bf16x8*)(sAtt + ((a * 2 + 1) * 2 + s2) * 512 + lane * 8);
                    o0 = MFMA32(va, p0, o0);
                    o1 = MFMA32(va, p1, o1);
                }
            {
                const size_t tbase = (size_t)sq * SEQ + ch * 64;
#pragma unroll
                for (int g = 0; g < 4; ++g) {
                    f32x4 v0 = {o0[4 * g], o0[4 * g + 1], o0[4 * g + 2], o0[4 * g + 3]};
                    f32x4 v1 = {o1[4 * g], o1[4 * g + 1], o1[4 * g + 2], o1[4 * g + 3]};
                    st_bf4(od + (tbase + r) * 1024 + hd * 256 + dvs + 8 * g + 4 * h, v0);
                    st_bf4(od + (tbase + 32 + r) * 1024 + hd * 256 + dvs + 8 * g + 4 * h, v1);
                }
            }
            __builtin_amdgcn_sched_barrier(0);
#pragma unroll
            for (int d4 = 0; d4 < 4; ++d4) {
#pragma unroll
                for (int s4 = 0; s4 < 4; ++s4) {
                    const bf16x8 ka = cat44(tr_read(trb + (16 * s4) * 136 + 32 * d4), tr_read(trb + (16 * s4 + 4) * 136 + 32 * d4));
                    const bf16x8 vb = *(const bf16x8*)(sVt + (dvs + r) * 72 + 16 * s4 + 8 * h);
                    S[d4] = MFMA32(ka, vb, S[d4]);
                }
            }
#pragma unroll
            for (int d4 = 0; d4 < 4; ++d4)
#pragma unroll
                for (int g = 0; g < 4; ++g) {
                    const f32x4 e4 = *(const f32x4*)(sEL + ch * 128 + 32 * d4 + 8 * g + 4 * h);
                    S[d4][4 * g] *= e4[0]; S[d4][4 * g + 1] *= e4[1]; S[d4][4 * g + 2] *= e4[2]; S[d4][4 * g + 3] *= e4[3];
                }
            __syncthreads();
            if (stp + 1 < 64) swrite();
            __syncthreads();
        }
    }
}

DI void phase_combine(const Params& p) {
    const bf16_t* of = (const bf16_t*)p.out; const bf16_t* ob = of + (size_t)T_TOK * 1024;
    const bf16_t* G1 = (const bf16_t*)(p.ws + WS_A3);
    bf16_t* og = (bf16_t*)(p.ws + WS_A2);
    const int tid = opq_tid(), lane = tid & 63, wid = tid >> 6;
    for (int row = blockIdx.x * 8 + wid; row < T_TOK; row += gridDim.x * 8) {
        const size_t base = (size_t)row * 1024 + lane * 16;
        float v[16]; float ss = 0.f;
#pragma unroll
        for (int q = 0; q < 2; ++q) {
            const u32x4 a = *(const u32x4*)(of + base + q * 8), b = *(const u32x4*)(ob + base + q * 8);
#pragma unroll
            for (int j = 0; j < 4; ++j) { v[q * 8 + 2 * j] = bf_lo(a[j]) + bf_lo(b[j]); v[q * 8 + 2 * j + 1] = bf_hi(a[j]) + bf_hi(b[j]); }
        }
#pragma unroll
        for (int j = 0; j < 16; ++j) ss += v[j] * v[j];
#pragma unroll
        for (int o = 1; o < 16; o <<= 1) ss += __shfl_xor(ss, o);
        const float rstd = rsqrtf(ss * (1.0f / 256.0f) + 1e-6f);
#pragma unroll
        for (int q = 0; q < 2; ++q) {
            const u32x4 gt = *(const u32x4*)(G1 + base + q * 8);
            const f32x4 h0 = *(const f32x4*)(p.hnorm + lane * 16 + q * 8), h1 = *(const f32x4*)(p.hnorm + lane * 16 + q * 8 + 4);
            u32x4 o;
            o[0] = pk2(v[q * 8 + 0] * rstd * h0[0] * bf_lo(gt[0]), v[q * 8 + 1] * rstd * h0[1] * bf_hi(gt[0]));
            o[1] = pk2(v[q * 8 + 2] * rstd * h0[2] * bf_lo(gt[1]), v[q * 8 + 3] * rstd * h0[3] * bf_hi(gt[1]));
            o[2] = pk2(v[q * 8 + 4] * rstd * h1[0] * bf_lo(gt[2]), v[q * 8 + 5] * rstd * h1[1] * bf_hi(gt[2]));
            o[3] = pk2(v[q * 8 + 6] * rstd * h1[2] * bf_lo(gt[3]), v[q * 8 + 7] * rstd * h1[3] * bf_hi(gt[3]));
            *(u32x4*)(og + base + q * 8) = o;
        }
    }
}

__global__ void __launch_bounds__(NTHR) fwd_megakernel(Params p) {
    extern __shared__ __attribute__((aligned(16))) unsigned char smem[];
    cg::grid_group grid = cg::this_grid();
    phase_convert(p, smem);      grid.sync();
    phase_in0(p, smem);          grid.sync();
    phase_attn(p, smem);         grid.sync();
    phase_out<false>(p, smem);   grid.sync();
    phase_ln<false>(p);          grid.sync();
    phase_in1(p, smem);          grid.sync();
    phase_gates(p, smem);        grid.sync();
    phase_gla(p, smem);          grid.sync();
    phase_combine(p);            grid.sync();
    phase_out<true>(p, smem);    grid.sync();
    phase_ln<true>(p);
}

extern "C" void kernel_launch(void* const* d_in, const int* in_sizes, int n_in, void* d_out, int out_size, void* d_ws, size_t ws_size, hipStream_t stream) {
    static int grid_blocks = 0;
    if (!grid_blocks) {
        int dev = 0, cus = 0, per_cu = 0;
        hipGetDevice(&dev);
        hipDeviceGetAttribute(&cus, hipDeviceAttributeMultiprocessorCount, dev);
        hipFuncSetAttribute((const void*)fwd_megakernel, hipFuncAttributeMaxDynamicSharedMemorySize, LDS_BYTES);
        hipOccupancyMaxActiveBlocksPerMultiprocessor(&per_cu, (const void*)fwd_megakernel, NTHR, LDS_BYTES);
        if (per_cu < 1) { fprintf(stderr, "occupancy query says %d blocks/CU\n", per_cu); per_cu = 1; }
        grid_blocks = cus * per_cu;
        if (ws_size < WS_A5 + 8 * MiB) fprintf(stderr, "workspace too small: %zu\n", ws_size);
    }
    Params p{};
    p.xp = (const float*)d_in[0]; p.xs = (const float*)d_in[1]; p.w0in = (const float*)d_in[2]; p.sink = (const float*)d_in[3];
    p.w0out = (const float*)d_in[4]; p.ln0g = (const float*)d_in[5]; p.ln0b = (const float*)d_in[6]; p.w1in = (const float*)d_in[7];
    p.wgf = (const float*)d_in[8]; p.bgf = (const float*)d_in[9]; p.wgb = (const float*)d_in[10]; p.bgb = (const float*)d_in[11];
    p.hnorm = (const float*)d_in[12]; p.w1out = (const float*)d_in[13]; p.ln1g = (const float*)d_in[14]; p.ln1b = (const float*)d_in[15];
    p.out = (float*)d_out; p.ws = (unsigned char*)d_ws;
    void* args[] = {&p};
    hipError_t e = hipLaunchCooperativeKernel((const void*)fwd_megakernel, dim3(grid_blocks), dim3(NTHR), args, LDS_BYTES, stream);
    if (e != hipSuccess) fprintf(stderr, "cooperative launch failed: %s (grid %d)\n", hipGetErrorString(e), grid_blocks);
}
```

```cpp
#include <hip/hip_runtime.h>
#include <hip/hip_cooperative_groups.h>
#include <cstdio>
namespace cg = cooperative_groups;

typedef unsigned short bf16_t;
typedef short bf16x8 __attribute__((ext_vector_type(8)));
typedef short s16x4 __attribute__((ext_vector_type(4)));
typedef float f32x16 __attribute__((ext_vector_type(16)));
typedef float f32x4 __attribute__((ext_vector_type(4)));
typedef float f32x2 __attribute__((ext_vector_type(2)));
typedef unsigned u32x4 __attribute__((ext_vector_type(4)));
typedef unsigned u32x2 __attribute__((ext_vector_type(2)));
typedef __bf16 bfv2 __attribute__((ext_vector_type(2)));
#define DI __device__ __forceinline__
#define MFMA32(a, b, c) __builtin_amdgcn_mfma_f32_32x32x16_bf16((a), (b), (c), 0, 0, 0)

constexpr int T_TOK = 98304, TP = 32768, SEQ = 4096, NSEQ = 24, D = 1024;
constexpr int NTHR = 512;
constexpr size_t MiB = 1048576;
constexpr size_t RB = 192 * MiB;
constexpr int LDS_BYTES = 147456;
constexpr float LOG2E = 1.4426950408889634f;
constexpr float DN_ALPHA = 1.4142135623730951f;

struct Params {
    const float *xp, *xs, *w0in, *sink, *w0out, *ln0g, *ln0b, *w1in, *wgf, *bgf, *wgb, *bgb, *hnorm, *w1out, *ln1g, *ln1b;
    float* out;
    unsigned char* ws;
};

DI unsigned pk2(float a, float b) { f32x2 v = {a, b}; bfv2 r = __builtin_convertvector(v, bfv2); return __builtin_bit_cast(unsigned, r); }
DI float bf_lo(unsigned u) { return __uint_as_float(u << 16); }
DI float bf_hi(unsigned u) { return __uint_as_float(u & 0xffff0000u); }
DI float bf2f(bf16_t v) { return __uint_as_float(((unsigned)v) << 16); }
DI bf16_t f2bf(float a) { return (bf16_t)(pk2(a, 0.f) & 0xffffu); }
DI bf16x8 pack8(const f32x16& x, int s) {
    u32x4 p = {pk2(x[8 * s], x[8 * s + 1]), pk2(x[8 * s + 2], x[8 * s + 3]), pk2(x[8 * s + 4], x[8 * s + 5]), pk2(x[8 * s + 6], x[8 * s + 7])};
    return __builtin_bit_cast(bf16x8, p);
}
DI bf16x8 cat44(s16x4 lo, s16x4 hi) { return __builtin_shufflevector(lo, hi, 0, 1, 2, 3, 4, 5, 6, 7); }
DI int opq_tid() { int t = threadIdx.x; asm volatile("" : "+v"(t)); return t; }
DI float silu(float x) { return x / (1.0f + __expf(-x)); }
DI const float* xrow(const Params& p, int t) { return t < TP ? p.xp + (size_t)t * D : p.xs + (size_t)(t - TP) * D; }

constexpr size_t WS_WT0IN = 0, WS_WT0OUT = WS_WT0IN + 2560 * 1024 * 2, WS_WT1IN = WS_WT0OUT + 1024 * 1024 * 2, WS_WT1OUT = WS_WT1IN + 3104 * 1024 * 2;
constexpr size_t WS_A0 = 16 * MiB, WS_A1 = WS_A0 + RB, WS_A2 = WS_A1 + RB, WS_A3 = WS_A2 + RB, WS_A4 = WS_A3 + RB, WS_A5 = WS_A4 + RB;
constexpr size_t WS_K0 = WS_A3, WS_V0T = WS_A3 + 48 * MiB;
constexpr size_t WS_ELF = WS_A5, WS_ELB = WS_A5 + 1536 * 512 * 4;
constexpr size_t WS_STAT0 = WS_A5 + 6 * MiB, WS_STAT1 = WS_STAT0 + 3 * MiB, WS_CNT = WS_STAT1 + 3 * MiB;

DI void phase_convert(const Params& p, unsigned char* smem) {
    bf16_t* xb = (bf16_t*)(p.ws + WS_A0);
    const int tid = opq_tid();
    const size_t n8 = (size_t)T_TOK * D / 8;
    for (size_t i = (size_t)blockIdx.x * NTHR + tid; i < n8; i += (size_t)gridDim.x * NTHR) {
        const size_t e = i * 8; const int t = (int)(e >> 10);
        const float* src = xrow(p, t) + (e & 1023);
        const f32x4 a = *(const f32x4*)src, b = *(const f32x4*)(src + 4);
        u32x4 o = {pk2(a[0], a[1]), pk2(a[2], a[3]), pk2(b[0], b[1]), pk2(b[2], b[3])};
        *(u32x4*)(xb + e) = o;
    }
    if (blockIdx.x == 0) for (int i = tid; i < 768; i += NTHR) ((unsigned*)(p.ws + WS_CNT))[i] = 0u;
    float* tile = (float*)smem;
    for (int u = blockIdx.x; u < 3856; u += gridDim.x) {
        int v = u; const float* W; bf16_t* Wt; int N;
        if (v < 1280) { W = p.w0in; Wt = (bf16_t*)(p.ws + WS_WT0IN); N = 2560; }
        else if ((v -= 1280) < 512) { W = p.w0out; Wt = (bf16_t*)(p.ws + WS_WT0OUT); N = 1024; }
        else if ((v -= 512) < 1552) { W = p.w1in; Wt = (bf16_t*)(p.ws + WS_WT1IN); N = 3104; }
        else { v -= 1552; W = p.w1out; Wt = (bf16_t*)(p.ws + WS_WT1OUT); N = 1024; }
        const int nn32 = N / 32, nt = v % nn32, kt = v / nn32;
#pragma unroll
        for (int q = 0; q < 4; ++q) { const int e = tid + NTHR * q, kk = e >> 5, nn = e & 31; tile[kk * 33 + nn] = W[(size_t)(kt * 64 + kk) * N + nt * 32 + nn]; }
        __syncthreads();
#pragma unroll
        for (int q = 0; q < 2; ++q) { const int e = tid + NTHR * q, nn = e >> 5, kp = e & 31;
            *(unsigned*)(Wt + (size_t)(nt * 32 + nn) * 1024 + kt * 64 + 2 * kp) = pk2(tile[(2 * kp) * 33 + nn], tile[(2 * kp + 1) * 33 + nn]); }
        __syncthreads();
    }
}

DI void gemm_kloop(const bf16_t* __restrict__ P, const bf16_t* __restrict__ Q, unsigned char* smem, f32x16 (&acc)[4][2], int tid) {
    const int lane = tid & 63, wid = tid >> 6, wi = wid >> 2, wj = wid & 3, r = lane & 31, h = lane >> 5;
    const int crow = tid >> 3, ccol = (tid & 7) * 8;
#pragma unroll
    for (int a = 0; a < 4; ++a)
#pragma unroll
        for (int b = 0; b < 2; ++b)
#pragma unroll
            for (int i = 0; i < 16; ++i) acc[a][b][i] = 0.f;
    u32x4 rp[4], rq[4];
    const unsigned char* Pb = (const unsigned char*)P;
    const unsigned char* Qb = (const unsigned char*)Q;
    const unsigned voff = (unsigned)(crow * 1024 + ccol) * 2u;
    unsigned char* sw = smem + (crow * 72 + ccol) * 2;
#pragma unroll
    for (int u = 0; u < 4; ++u) { rp[u] = *(const u32x4*)(Pb + (size_t)u * 131072 + voff); rq[u] = *(const u32x4*)(Qb + (size_t)u * 131072 + voff); }
#pragma unroll
    for (int u = 0; u < 4; ++u) { *(u32x4*)(sw + u * 64 * 144) = rp[u]; *(u32x4*)(sw + 36864 + u * 64 * 144) = rq[u]; }
#pragma unroll
    for (int u = 0; u < 4; ++u) { rp[u] = *(const u32x4*)(Pb + (size_t)u * 131072 + 128 + voff); rq[u] = *(const u32x4*)(Qb + (size_t)u * 131072 + 128 + voff); }
    __syncthreads();
    const unsigned char* fpb = smem + ((wi * 128 + r) * 72 + h * 8) * 2;
    const unsigned char* fqb = smem + 36864 + ((wj * 64 + r) * 72 + h * 8) * 2;
    for (int kt = 0; kt < 16; ++kt) {
        const int cur = kt & 1;
        if (kt + 1 < 16) {
            unsigned char* d = sw + (cur ^ 1) * 73728;
#pragma unroll
            for (int u = 0; u < 4; ++u) { *(u32x4*)(d + u * 64 * 144) = rp[u]; *(u32x4*)(d + 36864 + u * 64 * 144) = rq[u]; }
            if (kt + 2 < 16) {
                const unsigned char* Pk = Pb + (kt + 2) * 128;
                const unsigned char* Qk = Qb + (kt + 2) * 128;
#pragma unroll
                for (int u = 0; u < 4; ++u) { rp[u] = *(const u32x4*)(Pk + (size_t)u * 131072 + voff); rq[u] = *(const u32x4*)(Qk + (size_t)u * 131072 + voff); }
            }
        }
        __builtin_amdgcn_sched_barrier(0);
        const unsigned char* bp = fpb + cur * 73728;
        const unsigned char* bq = fqb + cur * 73728;
#pragma unroll
        for (int s = 0; s < 4; ++s) {
            bf16x8 fp[4], fq[2];
#pragma unroll
            for (int a = 0; a < 4; ++a) fp[a] = *(const bf16x8*)(bp + a * 32 * 144 + s * 32);
#pragma unroll
            for (int b = 0; b < 2; ++b) fq[b] = *(const bf16x8*)(bq + b * 32 * 144 + s * 32);
#pragma unroll
            for (int a = 0; a < 4; ++a)
#pragma unroll
                for (int b = 0; b < 2; ++b) acc[a][b] = MFMA32(fp[a], fq[b], acc[a][b]);
        }
        __syncthreads();
    }
}

template <class TF, class ST> DI void gemm_tile_bf16(const bf16_t* __restrict__ P, const bf16_t* __restrict__ Q, unsigned char* smem, TF tf, ST st) {
    const int tid = opq_tid(), lane = tid & 63, wid = tid >> 6, wi = wid >> 2, wj = wid & 3, r = lane & 31, h = lane >> 5;
    f32x16 acc[4][2];
    gemm_kloop(P, Q, smem, acc, tid);
#pragma unroll
    for (int a = 0; a < 4; ++a)
#pragma unroll
        for (int b = 0; b < 2; ++b)
#pragma unroll
            for (int g = 0; g < 4; ++g) {
                const int i0 = wi * 128 + a * 32 + 8 * g + 4 * h, j = wj * 64 + b * 32 + r;
                f32x4 v = {acc[a][b][4 * g], acc[a][b][4 * g + 1], acc[a][b][4 * g + 2], acc[a][b][4 * g + 3]};
                v = tf(v, i0, j);
                u32x2 o = {pk2(v[0], v[1]), pk2(v[2], v[3])};
                *(u32x2*)(smem + j * 528 + i0 * 2) = o;
            }
    __syncthreads();
#pragma unroll 4
    for (int q = 0; q < 16; ++q) {
        const int c = tid + NTHR * q, j = c >> 5, ch = c & 31;
        const u32x4 w = *(const u32x4*)(smem + j * 528 + ch * 16);
        st(j, ch * 8, w);
    }
    __syncthreads();
}

template <class EP> DI void gemm_tile_f32(const bf16_t* __restrict__ P, const bf16_t* __restrict__ Q, unsigned char* smem, EP ep) {
    const int tid = opq_tid(), lane = tid & 63, wid = tid >> 6, wi = wid >> 2, wj = wid & 3, r = lane & 31, h = lane >> 5;
    f32x16 acc[4][2];
    gemm_kloop(P, Q, smem, acc, tid);
#pragma unroll
    for (int pass = 0; pass < 2; ++pass) {
        if ((wj >> 1) == pass) {
#pragma unroll
            for (int a = 0; a < 4; ++a)
#pragma unroll
                for (int b = 0; b < 2; ++b)
#pragma unroll
                    for (int g = 0; g < 4; ++g) {
                        const int i0 = wi * 128 + a * 32 + 8 * g + 4 * h, jl = (wj & 1) * 64 + b * 32 + r;
                        f32x4 v = {acc[a][b][4 * g], acc[a][b][4 * g + 1], acc[a][b][4 * g + 2], acc[a][b][4 * g + 3]};
                        *(f32x4*)(smem + (jl * 260 + i0) * 4) = v;
                    }
        }
        __syncthreads();
#pragma unroll 4
        for (int q = 0; q < 16; ++q) {
            const int c = tid + NTHR * q, jl = c >> 6, ch = c & 63;
            const f32x4 v = *(const f32x4*)(smem + (jl * 260 + ch * 4) * 4);
            ep(pass * 128 + jl, ch * 4, v);
        }
        __syncthreads();
    }
}

DI bool gemm_unit(int it, int nN, int& pm, int& nt) {
    const int G = gridDim.x;
    if ((G & 7) == 0) {
        const int xcd = blockIdx.x & 7, l = blockIdx.x >> 3, per = G >> 3;
        const int u = it * per + l;
        if (u >= 48 * nN) return false;
        pm = (u / nN) * 8 + xcd; nt = u % nN; return true;
    } else {
        const int u = it * G + blockIdx.x;
        if (u >= 384 * nN) return false;
        pm = u / nN; nt = u % nN; return true;
    }
}

DI size_t qk_off(int sq, int hd, int ch) { return ((size_t)((sq * 4 + hd) * 64 + ch)) * 16384; }
DI size_t v1_off(int sq, int hd, int ch) { return ((size_t)((sq * 4 + hd) * 64 + ch)) * 16384; }
DI void st_bf4(bf16_t* dst, f32x4 v) { u32x2 o = {pk2(v[0], v[1]), pk2(v[2], v[3])}; *(u32x2*)dst = o; }

DI void phase_in0(const Params& p, unsigned char* smem) {
    const bf16_t* xb = (const bf16_t*)(p.ws + WS_A0);
    const bf16_t* wt = (const bf16_t*)(p.ws + WS_WT0IN);
    bf16_t* Q0 = (bf16_t*)(p.ws + WS_A1); bf16_t* G0 = (bf16_t*)(p.ws + WS_A2); bf16_t* K0 = (bf16_t*)(p.ws + WS_K0); bf16_t* V0t = (bf16_t*)(p.ws + WS_V0T);
    int pm, nt;
    auto ident = [](f32x4 v, int, int) { return v; };
    for (int it = 0; gemm_unit(it, 10, pm, nt); ++it) {
        const bf16_t* A = xb + (size_t)pm * 256 * 1024;
        const bf16_t* B = wt + (size_t)nt * 256 * 1024;
        const int t0 = pm * 256;
        if (nt == 5) {
            const int sq = t0 >> 12, tl = t0 & 4095;
            gemm_tile_bf16(A, B, smem, ident, [&](int j, int i, u32x4 w) { *(u32x4*)(V0t + ((size_t)(sq * 256 + j)) * 4096 + tl + i) = w; });
        } else if (nt < 4) {
            gemm_tile_bf16(B, A, smem, ident, [&](int j, int i, u32x4 w) { *(u32x4*)(Q0 + (size_t)(t0 + j) * 1024 + nt * 256 + i) = w; });
        } else if (nt == 4) {
            gemm_tile_bf16(B, A, smem, ident, [&](int j, int i, u32x4 w) { *(u32x4*)(K0 + (size_t)(t0 + j) * 256 + i) = w; });
        } else {
            gemm_tile_bf16(B, A, smem, [](f32x4 v, int, int) { return (f32x4){silu(v[0]), silu(v[1]), silu(v[2]), silu(v[3])}; },
                           [&](int j, int i, u32x4 w) { *(u32x4*)(G0 + (size_t)(t0 + j) * 1024 + (nt - 6) * 256 + i) = w; });
        }
    }
}

DI void phase_attn(const Params& p, unsigned char* smem) {
    const bf16_t* Q0 = (const bf16_t*)(p.ws + WS_A1); const bf16_t* G0 = (const bf16_t*)(p.ws + WS_A2);
    const bf16_t* K0 = (const bf16_t*)(p.ws + WS_K0); const bf16_t* V0t = (const bf16_t*)(p.ws + WS_V0T);
    bf16_t* og = (bf16_t*)(p.ws + WS_A4);
    bf16_t* sK = (bf16_t*)smem;
    bf16_t* sVt = (bf16_t*)(smem + 55296);
    const int tid = opq_tid(), lane = tid & 63, wid = tid >> 6, r = lane & 31, h = lane >> 5;
    for (int u = blockIdx.x; u < NSEQ * 32 * 4; u += gridDim.x) {
        const int g = u & 3, n = (u >> 2) & 31, sq = u >> 7;
        const int kbase = (n - 1) * 128;
        __syncthreads();
        const u32x4 zero4 = {0u, 0u, 0u, 0u};
#pragma unroll
        for (int q = 0; q < 6; ++q) {
            const int c = tid + NTHR * q, row = c >> 3, cc = c & 7, kpos = kbase + row;
            *(u32x4*)(sK + row * 72 + cc * 8) = (kpos >= 0 && kpos < SEQ) ? *(const u32x4*)(K0 + ((size_t)sq * SEQ + kpos) * 256 + g * 64 + cc * 8) : zero4;
        }
#pragma unroll
        for (int q = 0; q < 6; ++q) {
            const int c = tid + NTHR * q, row = c / 48, cc = c % 48, kpos = kbase + cc * 8;
            *(u32x4*)(sVt + row * 392 + cc * 8) = (kpos >= 0 && kpos < SEQ) ? *(const u32x4*)(V0t + ((size_t)(sq * 256 + g * 64 + row)) * 4096 + kpos) : zero4;
        }
        __syncthreads();
        const int head = wid >> 1, hq = g * 4 + head;
        const float slope2 = exp2f(-0.5f * (float)(hq + 1)) * LOG2E;
        const float sink2 = p.sink[hq] * LOG2E;
        const int tq0 = n * 128 + (wid & 1) * 64;
        bf16x8 qf[2][4];
        f32x16 o0[2], o1[2];
        float mrun[2], lsum[2];
#pragma unroll
        for (int e = 0; e < 2; ++e) {
            const size_t trow = (size_t)sq * SEQ + tq0 + 32 * e + r;
#pragma unroll
            for (int s = 0; s < 4; ++s) qf[e][s] = *(const bf16x8*)(Q0 + trow * 1024 + hq * 64 + s * 16 + h * 8);
#pragma unroll
            for (int i = 0; i < 16; ++i) { o0[e][i] = 0.f; o1[e][i] = 0.f; }
            mrun[e] = sink2; lsum[e] = (h == 0) ? 1.0f : 0.0f;
        }
        for (int m = -4; m <= 4; ++m) {
            const bool edge = (m == -4) || (m == 4);
            f32x16 st[2];
            int kl[2]; bool ok[2];
#pragma unroll
            for (int e = 0; e < 2; ++e) {
                const int kb = tq0 + 32 * e + 32 * m;
                ok[e] = (kb >= 0) && (kb < SEQ);
                kl[e] = kb - kbase;
#pragma unroll
                for (int i = 0; i < 16; ++i) st[e][i] = 0.f;
#pragma unroll
                for (int s = 0; s < 4; ++s) { const bf16x8 kf = *(const bf16x8*)(sK + (kl[e] + r) * 72 + s * 16 + h * 8); st[e] = MFMA32(kf, qf[e][s], st[e]); }
            }
            const float fd0 = (float)(r - 32 * m - 4 * h);
#pragma unroll
            for (int e = 0; e < 2; ++e) {
                float mx = -3.0e38f;
                const bool msk = edge || !ok[e];
#pragma unroll
                for (int i = 0; i < 16; ++i) {
                    const float fd = fabsf(fd0 - (float)((i & 3) + 8 * (i >> 2)));
                    float sc = st[e][i] * (0.125f * LOG2E) - slope2 * fd;
                    if (msk) sc = (ok[e] && fd <= 128.0f) ? sc : -3.0e38f;
                    st[e][i] = sc; mx = fmaxf(mx, sc);
                }
                mx = fmaxf(mx, __shfl_xor(mx, 32));
                const float mnew = fmaxf(mrun[e], mx);
                const float al = __builtin_amdgcn_exp2f(mrun[e] - mnew);
                mrun[e] = mnew;
                float ps = 0.f;
#pragma unroll
                for (int i = 0; i < 16; ++i) { const float pe = __builtin_amdgcn_exp2f(st[e][i] - mnew); st[e][i] = pe; ps += pe; }
                lsum[e] = lsum[e] * al + ps;
                if (__any(al != 1.0f)) {
#pragma unroll
                    for (int i = 0; i < 16; ++i) { o0[e][i] *= al; o1[e][i] *= al; }
                }
            }
#pragma unroll
            for (int e = 0; e < 2; ++e)
#pragma unroll
                for (int s2 = 0; s2 < 2; ++s2) {
                    const bf16x8 pf = pack8(st[e], s2);
                    const bf16_t* vb = sVt + r * 392 + kl[e] + 16 * s2 + 4 * h;
                    const bf16x8 v0 = cat44(*(const s16x4*)vb, *(const s16x4*)(vb + 8));
                    const bf16x8 v1 = cat44(*(const s16x4*)(vb + 32 * 392), *(const s16x4*)(vb + 32 * 392 + 8));
                    o0[e] = MFMA32(v0, pf, o0[e]);
                    o1[e] = MFMA32(v1, pf, o1[e]);
                }
        }
#pragma unroll
        for (int e = 0; e < 2; ++e) {
            const size_t trow = (size_t)sq * SEQ + tq0 + 32 * e + r;
            const float inv = 1.0f / (lsum[e] + __shfl_xor(lsum[e], 32));
#pragma unroll
            for (int dt = 0; dt < 2; ++dt)
#pragma unroll
                for (int gq = 0; gq < 4; ++gq) {
                    const int col = hq * 64 + dt * 32 + 8 * gq + 4 * h;
                    const u32x2 gt = *(const u32x2*)(G0 + trow * 1024 + col);
                    const f32x16& oo = dt ? o1[e] : o0[e];
                    f32x4 v = {oo[4 * gq] * inv * bf_lo(gt[0]), oo[4 * gq + 1] * inv * bf_hi(gt[0]), oo[4 * gq + 2] * inv * bf_lo(gt[1]), oo[4 * gq + 3] * inv * bf_hi(gt[1])};
                    st_bf4(og + trow * 1024 + col, v);
                }
        }
    }
}

template <bool L1> DI void phase_out_ln(const Params& p, unsigned char* smem) {
    const bf16_t* Ain = (const bf16_t*)(p.ws + (L1 ? WS_A2 : WS_A4));
    const bf16_t* wt = (const bf16_t*)(p.ws + (L1 ? WS_WT1OUT : WS_WT0OUT));
    bf16_t* x1b = (bf16_t*)(p.ws + WS_A0);
    float* stats = (float*)(p.ws + (L1 ? WS_STAT1 : WS_STAT0));
    unsigned* cnt = (unsigned*)(p.ws + WS_CNT) + (L1 ? 384 : 0);
    const float* gw = L1 ? p.ln1g : p.ln0g; const float* bw = L1 ? p.ln1b : p.ln0b;
    int pm, nt;
    for (int it = 0; gemm_unit(it, 4, pm, nt); ++it) {
        const bf16_t* A = Ain + (size_t)pm * 256 * 1024;
        const bf16_t* B = wt + (size_t)nt * 256 * 1024;
        const int t0 = pm * 256;
        const int tid = opq_tid(), lane = tid & 63, wid = tid >> 6, wi = wid >> 2, wj = wid & 3, r = lane & 31, h = lane >> 5;
        {
            f32x16 acc[4][2];
            gemm_kloop(B, A, smem, acc, tid);
#pragma unroll
            for (int a = 0; a < 4; ++a)
#pragma unroll
                for (int b = 0; b < 2; ++b)
#pragma unroll
                    for (int g = 0; g < 4; ++g) {
                        const int i0 = wi * 128 + a * 32 + 8 * g + 4 * h, j = wj * 64 + b * 32 + r;
                        u32x2 o = {pk2(acc[a][b][4 * g], acc[a][b][4 * g + 1]), pk2(acc[a][b][4 * g + 2], acc[a][b][4 * g + 3])};
                        *(u32x2*)(smem + j * 528 + i0 * 2) = o;
                    }
        }
        __builtin_amdgcn_sched_barrier(0);
        __syncthreads();
        __builtin_amdgcn_sched_barrier(0);
        const int col = nt * 256 + lane * 4;
        auto hrow = [&](int row) -> f32x4 {
            const int t = t0 + row;
            const u32x2 mv = *(const u32x2*)(smem + row * 528 + lane * 8);
            f32x4 xr;
            if (L1) { const u32x2 xv = *(const u32x2*)(x1b + (size_t)t * 1024 + col); xr = (f32x4){bf_lo(xv[0]), bf_hi(xv[0]), bf_lo(xv[1]), bf_hi(xv[1])}; }
            else xr = *(const f32x4*)(xrow(p, t) + col);
            return xr * DN_ALPHA + (f32x4){bf_lo(mv[0]), bf_hi(mv[0]), bf_lo(mv[1]), bf_hi(mv[1])};
        };
#pragma unroll 4
        for (int q = 0; q < 32; ++q) {
            const int row = wid + 8 * q, t = t0 + row;
            const f32x4 hv = hrow(row);
            float s1 = (hv[0] + hv[1]) + (hv[2] + hv[3]);
            float s2 = (hv[0] * hv[0] + hv[1] * hv[1]) + (hv[2] * hv[2] + hv[3] * hv[3]);
#pragma unroll
            for (int o = 1; o < 64; o <<= 1) { s1 += __shfl_xor(s1, o); s2 += __shfl_xor(s2, o); }
            if (lane < 2) __hip_atomic_store(stats + ((size_t)t * 4 + nt) * 2 + lane, lane ? s2 : s1, __ATOMIC_RELAXED, __HIP_MEMORY_SCOPE_AGENT);
        }
        asm volatile("s_waitcnt vmcnt(0)" ::: "memory");
        __syncthreads();
        if (tid == 0) {
            __hip_atomic_fetch_add(cnt + pm, 1u, __ATOMIC_RELEASE, __HIP_MEMORY_SCOPE_AGENT);
            int polls = 0;
            while (__hip_atomic_load(cnt + pm, __ATOMIC_RELAXED, __HIP_MEMORY_SCOPE_AGENT) < 4u && polls < (1 << 22)) { __builtin_amdgcn_s_sleep(2); ++polls; }
            __builtin_amdgcn_fence(__ATOMIC_ACQUIRE, "agent");
        }
        __syncthreads();
        const f32x4 gg = *(const f32x4*)(gw + col), bb = *(const f32x4*)(bw + col);
#pragma unroll 4
        for (int q = 0; q < 32; ++q) {
            const int row = wid + 8 * q, t = t0 + row;
            float sv = 0.f;
            if (lane < 8) sv = __hip_atomic_load(stats + (size_t)t * 8 + lane, __ATOMIC_RELAXED, __HIP_MEMORY_SCOPE_AGENT);
            sv += __shfl_xor(sv, 2); sv += __shfl_xor(sv, 4);
            const float s1 = __shfl(sv, 0), s2 = __shfl(sv, 1);
            const float mu = s1 * (1.0f / 1024.0f);
            const float rstd = rsqrtf(fmaxf(s2 * (1.0f / 1024.0f) - mu * mu, 0.f) + 1e-5f);
            const f32x4 y = (hrow(row) - mu) * rstd * gg + bb;
            if (L1) *(f32x4*)(p.out + (size_t)t * 1024 + col) = y;
            else st_bf4(x1b + (size_t)t * 1024 + col, y);
        }
        __syncthreads();
    }
}

DI void phase_in1(const Params& p, unsigned char* smem) {
    const bf16_t* x1b = (const bf16_t*)(p.ws + WS_A0);
    const bf16_t* wt = (const bf16_t*)(p.ws + WS_WT1IN);
    bf16_t* QK1 = (bf16_t*)(p.ws + WS_A1); bf16_t* V1t = (bf16_t*)(p.ws + WS_A2); bf16_t* G1 = (bf16_t*)(p.ws + WS_A3);
    int pm, nt;
    for (int it = 0; gemm_unit(it, 12, pm, nt); ++it) {
        const bf16_t* A = x1b + (size_t)pm * 256 * 1024;
        const bf16_t* B = wt + (size_t)nt * 256 * 1024;
        const int t0 = pm * 256;
        if (nt >= 4 && nt < 8) {
            const int sq = t0 >> 12, tl = t0 & 4095;
            gemm_tile_bf16(A, B, smem, [](f32x4 v, int, int) { return v; },
                           [&](int j, int i, u32x4 w) { *(u32x4*)(V1t + v1_off(sq, nt - 4, (tl + i) >> 6) + j * 64 + (i & 63)) = w; });
        } else if (nt < 4) {
            const float sc = nt < 2 ? 0.08838834764831845f : 1.0f;
            gemm_tile_bf16(B, A, smem, [&](f32x4 v, int, int) { return v * sc; },
                           [&](int j, int i, u32x4 w) { const int t = t0 + j, f = (nt & 1) * 256 + i;
                               *(u32x4*)(QK1 + qk_off(t >> 12, f >> 7, (t >> 6) & 63) + (nt >> 1) * 8192 + (t & 63) * 128 + (f & 127)) = w; });
        } else {
            gemm_tile_bf16(B, A, smem, [](f32x4 v, int, int) { return (f32x4){silu(v[0]), silu(v[1]), silu(v[2]), silu(v[3])}; },
                           [&](int j, int i, u32x4 w) { *(u32x4*)(G1 + (size_t)(t0 + j) * 1024 + (nt - 8) * 256 + i) = w; });
        }
    }
}

DI void phase_gates(const Params& p, unsigned char* smem) {
    const bf16_t* x1b = (const bf16_t*)(p.ws + WS_A0);
    const bf16_t* wlr = (const bf16_t*)(p.ws + WS_WT1IN) + (size_t)3072 * 1024;
    bf16_t* QK1 = (bf16_t*)(p.ws + WS_A1);
    bf16_t* QKf = (bf16_t*)(p.ws + WS_A4);
    float* part = (float*)smem;
    bf16_t* sIn = (bf16_t*)smem;
    bf16_t* sOut = (bf16_t*)(smem + 32768);
    float* sTot = (float*)(smem + 98304);
    float* lr = (float*)(smem + 102400);
    const int tid = opq_tid(), lane = tid & 63, wid = tid >> 6, r = lane & 31, h = lane >> 5;
    const int c = tid & 127, grp = tid >> 7;
    for (int cg = blockIdx.x; cg < T_TOK / 64; cg += gridDim.x) {
        const int tb = cg * 64, sq = cg >> 6, ch = cg & 63;
        {
            f32x16 a0, a1;
#pragma unroll
            for (int i = 0; i < 16; ++i) { a0[i] = 0.f; a1[i] = 0.f; }
#pragma unroll
            for (int s = 0; s < 8; ++s) {
                const int k = wid * 128 + s * 16 + h * 8;
                const bf16x8 bq = *(const bf16x8*)(wlr + (size_t)r * 1024 + k);
                const bf16x8 x0 = *(const bf16x8*)(x1b + (size_t)(tb + r) * 1024 + k);
                const bf16x8 x1 = *(const bf16x8*)(x1b + (size_t)(tb + 32 + r) * 1024 + k);
                a0 = MFMA32(x0, bq, a0); a1 = MFMA32(x1, bq, a1);
            }
            __syncthreads();
#pragma unroll
            for (int i = 0; i < 16; ++i) {
                const int t = (i & 3) + 8 * (i >> 2) + 4 * h;
                part[wid * 2048 + t * 32 + r] = a0[i];
                part[wid * 2048 + (t + 32) * 32 + r] = a1[i];
            }
            __syncthreads();
#pragma unroll
            for (int q = 0; q < 4; ++q) { const int e = tid + NTHR * q; float s = 0.f;
#pragma unroll
                for (int w = 0; w < 8; ++w) s += part[w * 2048 + e];
                lr[e] = s; }
            __syncthreads();
        }
#pragma unroll 1
        for (int hd = 0; hd < 4; ++hd) {
            bf16_t* gin = QK1 + qk_off(sq, hd, ch);
            bf16_t* gf = QKf + qk_off(sq, hd, ch);
#pragma unroll
            for (int q = 0; q < 4; ++q) *(u32x4*)(sIn + (tid + NTHR * q) * 8) = *(const u32x4*)(gin + (tid + NTHR * q) * 8);
            float pl[2][16];
#pragma unroll
            for (int dir = 0; dir < 2; ++dir) {
                const float* wg = (dir ? p.wgb : p.wgf) + hd * 128 + c;
                float w[16];
#pragma unroll
                for (int q = 0; q < 16; ++q) w[q] = wg[q * 512];
                const float bg = (dir ? p.bgb : p.bgf)[hd * 128 + c];
                float run = 0.f;
#pragma unroll
                for (int i = 0; i < 16; ++i) {
                    const f32x4* lp = (const f32x4*)(lr + (grp * 16 + i) * 32 + dir * 16);
                    const f32x4 l0 = lp[0], l1 = lp[1], l2 = lp[2], l3 = lp[3];
                    float z = bg;
                    z += l0[0] * w[0]; z += l0[1] * w[1]; z += l0[2] * w[2]; z += l0[3] * w[3];
                    z += l1[0] * w[4]; z += l1[1] * w[5]; z += l1[2] * w[6]; z += l1[3] * w[7];
                    z += l2[0] * w[8]; z += l2[1] * w[9]; z += l2[2] * w[10]; z += l2[3] * w[11];
                    z += l3[0] * w[12]; z += l3[1] * w[13]; z += l3[2] * w[14]; z += l3[3] * w[15];
                    run += (fminf(z, 0.f) - __logf(1.0f + __expf(-fabsf(z)))) * (1.0f / 16.0f);
                    pl[dir][i] = run;
                }
                sTot[(dir * 4 + grp) * 128 + c] = run;
            }
            __syncthreads();
#pragma unroll
            for (int dir = 0; dir < 2; ++dir) {
                const float t0 = sTot[(dir * 4 + 0) * 128 + c], t1 = sTot[(dir * 4 + 1) * 128 + c], t2 = sTot[(dir * 4 + 2) * 128 + c], t3 = sTot[(dir * 4 + 3) * 128 + c];
                const float tot = (t0 + t1) + (t2 + t3);
                const float base = (grp > 0 ? t0 : 0.f) + (grp > 1 ? t1 : 0.f) + (grp > 2 ? t2 : 0.f);
                if (grp == 0) ((float*)(p.ws + (dir ? WS_ELB : WS_ELF)))[(size_t)cg * 512 + hd * 128 + c] = __expf(tot);
#pragma unroll
                for (int i = 0; i < 16; ++i) {
                    const int t = grp * 16 + i;
                    const float qv = bf2f(sIn[t * 128 + c]), kv = bf2f(sIn[8192 + t * 128 + c]);
                    const float incl = base + pl[dir][i];
                    const float b = dir ? (tot - (base + (i ? pl[dir][i - 1] : 0.f))) : incl;
                    sOut[dir * 16384 + t * 128 + c] = f2bf(qv * __expf(b));
                    sOut[dir * 16384 + 8192 + t * 128 + c] = f2bf(kv * __expf(-b));
                }
            }
            __syncthreads();
#pragma unroll
            for (int q = 0; q < 4; ++q) {
                *(u32x4*)(gf + (tid + NTHR * q) * 8) = *(const u32x4*)(sOut + (tid + NTHR * q) * 8);
                *(u32x4*)(gin + (tid + NTHR * q) * 8) = *(const u32x4*)(sOut + 16384 + (tid + NTHR * q) * 8);
            }
        }
    }
}

#define LDS3 __attribute__((address_space(3)))
DI s16x4 tr_read(const bf16_t* p) { return __builtin_amdgcn_ds_read_tr16_b64_v4i16((LDS3 s16x4*)p); }
DI void phase_gla(const Params& p, unsigned char* smem) {
    const bf16_t* V1t = (const bf16_t*)(p.ws + WS_A2);
    bf16_t* sQD = (bf16_t*)smem;
    bf16_t* sKI = (bf16_t*)(smem + 17408);
    bf16_t* sVt = (bf16_t*)(smem + 34816);
    float* sEL = (float*)(smem + 71680);
    bf16_t* sAtt = (bf16_t*)(smem + 104448);
    const int tid = opq_tid(), lane = tid & 63, wid = tid >> 6, r = lane & 31, h = lane >> 5;
    const int dvs = wid * 32;
    const bf16_t* trb = sKI + (8 * h + ((lane & 15) >> 2)) * 136 + 16 * ((lane >> 4) & 1) + 4 * (lane & 3);
    for (int u = blockIdx.x; u < NSEQ * 8; u += gridDim.x) {
        const int dir = u & 1, hd = (u >> 1) & 3, sq = u >> 3;
        const bf16_t* QK = (const bf16_t*)(p.ws + (dir ? WS_A1 : WS_A4));
        const float* EL = (const float*)(p.ws + (dir ? WS_ELB : WS_ELF));
        bf16_t* od = (bf16_t*)p.out + (dir ? (size_t)T_TOK * 1024 : 0);
        f32x16 S[4];
#pragma unroll
        for (int d4 = 0; d4 < 4; ++d4)
#pragma unroll
            for (int i = 0; i < 16; ++i) S[d4][i] = 0.f;
        u32x4 rqd[2], rki[2], rv[4];
        auto gload = [&](int ch) {
            const bf16_t* gq = QK + qk_off(sq, hd, ch);
            const bf16_t* gv = V1t + v1_off(sq, hd, ch);
#pragma unroll
            for (int q = 0; q < 2; ++q) { rqd[q] = *(const u32x4*)(gq + (tid + NTHR * q) * 8); rki[q] = *(const u32x4*)(gq + 8192 + (tid + NTHR * q) * 8); }
#pragma unroll
            for (int q = 0; q < 4; ++q) rv[q] = *(const u32x4*)(gv + (tid + NTHR * q) * 8);
        };
        auto swrite = [&]() {
#pragma unroll
            for (int q = 0; q < 2; ++q) { const int c2 = tid + NTHR * q, row = c2 >> 4, cc = c2 & 15;
                *(u32x4*)(sQD + row * 136 + cc * 8) = rqd[q];
                *(u32x4*)(sKI + row * 136 + cc * 8) = rki[q]; }
#pragma unroll
            for (int q = 0; q < 4; ++q) { const int c2 = tid + NTHR * q, row = c2 >> 3, cc = c2 & 7; *(u32x4*)(sVt + row * 72 + cc * 8) = rv[q]; }
        };
        gload(dir ? 63 : 0);
        __syncthreads();
#pragma unroll 2
        for (int q = 0; q < 16; ++q) { const int e = tid + NTHR * q; sEL[e] = EL[((size_t)sq * 64 + (e >> 7)) * 512 + hd * 128 + (e & 127)]; }
        swrite();
        __syncthreads();
        for (int stp = 0; stp < 64; ++stp) {
            const int ch = dir ? 63 - stp : stp;
            if (stp + 1 < 64) gload(dir ? ch - 1 : ch + 1);
            __builtin_amdgcn_sched_barrier(0);
            if (wid < 4) {
                const int a = wid >> 1, b = wid & 1;
                bf16x8 kf[8], qf[8];
#pragma unroll
                for (int s8 = 0; s8 < 8; ++s8) { kf[s8] = *(const bf16x8*)(sKI + (32 * a + r) * 136 + 16 * s8 + 8 * h); qf[s8] = *(const bf16x8*)(sQD + (32 * b + r) * 136 + 16 * s8 + 8 * h); }
                f32x16 at0, at1;
#pragma unroll
                for (int i = 0; i < 16; ++i) { at0[i] = 0.f; at1[i] = 0.f; }
#pragma unroll
                for (int s8 = 0; s8 < 8; s8 += 2) { at0 = MFMA32(kf[s8], qf[s8], at0); at1 = MFMA32(kf[s8 + 1], qf[s8 + 1], at1); }
                const int t = 32 * b + r;
#pragma unroll
                for (int i = 0; i < 16; ++i) {
                    const int s = 32 * a + (i & 3) + 8 * (i >> 2) + 4 * h;
                    const bool keep = dir ? (s > t) : (s <= t);
                    at0[i] = keep ? (at0[i] + at1[i]) : 0.f;
                }
#pragma unroll
                for (int s2 = 0; s2 < 2; ++s2) *(bf16x8*)(sAtt + ((a * 2 + b) * 2 + s2) * 512 + lane * 8) = pack8(at0, s2);
            }
            __builtin_amdgcn_sched_barrier(0);
            f32x16 o0, o1;
#pragma unroll
            for (int i = 0; i < 16; ++i) { o0[i] = 0.f; o1[i] = 0.f; }
#pragma unroll
            for (int d4 = 0; d4 < 4; ++d4)
#pragma unroll
                for (int s2 = 0; s2 < 2; ++s2) {
                    const bf16x8 ps = pack8(S[d4], s2);
                    const bf16_t* qb = sQD + r * 136 + 32 * d4 + 16 * s2 + 4 * h;
                    const bf16x8 q0 = cat44(*(const s16x4*)qb, *(const s16x4*)(qb + 8));
                    const bf16x8 q1 = cat44(*(const s16x4*)(qb + 32 * 136), *(const s16x4*)(qb + 32 * 136 + 8));
                    o0 = MFMA32(ps, q0, o0);
                    o1 = MFMA32(ps, q1, o1);
                }
            __syncthreads();
#pragma unroll
            for (int a = 0; a < 2; ++a)
#pragma unroll
                for (int s2 = 0; s2 < 2; ++s2) {
                    const bf16_t* vb = sVt + (dvs + r) * 72 + 32 * a + 16 * s2 + 4 * h;
                    const bf16x8 va = cat44(*(const s16x4*)vb, *(const s16x4*)(vb + 8));
                    const bf16x8 p0 = *(const bf16x8*)(sAtt + ((a * 2 + 0) * 2 + s2) * 512 + lane * 8);
                    const bf16x8 p1 = *(const bf16x8*)(sAtt + ((a * 2 + 1) * 2 + s2) * 512 + lane * 8);
                    o0 = MFMA32(va, p0, o0);
                    o1 = MFMA32(va, p1, o1);
                }
            {
                const size_t tbase = (size_t)sq * SEQ + ch * 64;
#pragma unroll
                for (int g = 0; g < 4; ++g) {
                    f32x4 v0 = {o0[4 * g], o0[4 * g + 1], o0[4 * g + 2], o0[4 * g + 3]};
                    f32x4 v1 = {o1[4 * g], o1[4 * g + 1], o1[4 * g + 2], o1[4 * g + 3]};
                    st_bf4(od + (tbase + r) * 1024 + hd * 256 + dvs + 8 * g + 4 * h, v0);
                    st_bf4(od + (tbase + 32 + r) * 1024 + hd * 256 + dvs + 8 * g + 4 * h, v1);
                }
            }
            __builtin_amdgcn_sched_barrier(0);
#pragma unroll
            for (int d4 = 0; d4 < 4; ++d4) {
#pragma unroll
                for (int s4 = 0; s4 < 4; ++s4) {
                    const bf16x8 ka = cat44(tr_read(trb + (16 * s4) * 136 + 32 * d4), tr_read(trb + (16 * s4 + 4) * 136 + 32 * d4));
                    const bf16x8 vb = *(const bf16x8*)(sVt + (dvs + r) * 72 + 16 * s4 + 8 * h);
                    S[d4] = MFMA32(ka, vb, S[d4]);
                }
            }
#pragma unroll
            for (int d4 = 0; d4 < 4; ++d4)
#pragma unroll
                for (int g = 0; g < 4; ++g) {
                    const f32x4 e4 = *(const f32x4*)(sEL + ch * 128 + 32 * d4 + 8 * g + 4 * h);
                    S[d4][4 * g] *= e4[0]; S[d4][4 * g + 1] *= e4[1]; S[d4][4 * g + 2] *= e4[2]; S[d4][4 * g + 3] *= e4[3];
                }
            __syncthreads();
            if (stp + 1 < 64) swrite();
            __syncthreads();
        }
    }
}

DI void phase_combine(const Params& p) {
    const bf16_t* of = (const bf16_t*)p.out; const bf16_t* ob = of + (size_t)T_TOK * 1024;
    const bf16_t* G1 = (const bf16_t*)(p.ws + WS_A3);
    bf16_t* og = (bf16_t*)(p.ws + WS_A2);
    const int tid = opq_tid(), lane = tid & 63, wid = tid >> 6;
    for (int row = blockIdx.x * 8 + wid; row < T_TOK; row += gridDim.x * 8) {
        const size_t base = (size_t)row * 1024 + lane * 16;
        float v[16]; float ss = 0.f;
#pragma unroll
        for (int q = 0; q < 2; ++q) {
            const u32x4 a = *(const u32x4*)(of + base + q * 8), b = *(const u32x4*)(ob + base + q * 8);
#pragma unroll
            for (int j = 0; j < 4; ++j) { v[q * 8 + 2 * j] = bf_lo(a[j]) + bf_lo(b[j]); v[q * 8 + 2 * j + 1] = bf_hi(a[j]) + bf_hi(b[j]); }
        }
#pragma unroll
        for (int j = 0; j < 16; ++j) ss += v[j] * v[j];
#pragma unroll
        for (int o = 1; o < 16; o <<= 1) ss += __shfl_xor(ss, o);
        const float rstd = rsqrtf(ss * (1.0f / 256.0f) + 1e-6f);
#pragma unroll
        for (int q = 0; q < 2; ++q) {
            const u32x4 gt = *(const u32x4*)(G1 + base + q * 8);
            const f32x4 h0 = *(const f32x4*)(p.hnorm + lane * 16 + q * 8), h1 = *(const f32x4*)(p.hnorm + lane * 16 + q * 8 + 4);
            u32x4 o;
            o[0] = pk2(v[q * 8 + 0] * rstd * h0[0] * bf_lo(gt[0]), v[q * 8 + 1] * rstd * h0[1] * bf_hi(gt[0]));
            o[1] = pk2(v[q * 8 + 2] * rstd * h0[2] * bf_lo(gt[1]), v[q * 8 + 3] * rstd * h0[3] * bf_hi(gt[1]));
            o[2] = pk2(v[q * 8 + 4] * rstd * h1[0] * bf_lo(gt[2]), v[q * 8 + 5] * rstd * h1[1] * bf_hi(gt[2]));
            o[3] = pk2(v[q * 8 + 6] * rstd * h1[2] * bf_lo(gt[3]), v[q * 8 + 7] * rstd * h1[3] * bf_hi(gt[3]));
            *(u32x4*)(og + base + q * 8) = o;
        }
    }
}

__global__ void __launch_bounds__(NTHR) fwd_megakernel(Params p) {
    extern __shared__ __attribute__((aligned(16))) unsigned char smem[];
    cg::grid_group grid = cg::this_grid();
    phase_convert(p, smem);      grid.sync();
    phase_in0(p, smem);          grid.sync();
    phase_attn(p, smem);         grid.sync();
    phase_out_ln<false>(p, smem); grid.sync();
    phase_in1(p, smem);          grid.sync();
    phase_gates(p, smem);        grid.sync();
    phase_gla(p, smem);          grid.sync();
    phase_combine(p);            grid.sync();
    phase_out_ln<true>(p, smem);
}

extern "C" void kernel_launch(void* const* d_in, const int* in_sizes, int n_in, void* d_out, int out_size, void* d_ws, size_t ws_size, hipStream_t stream) {
    static int grid_blocks = 0;
    if (!grid_blocks) {
        int dev = 0, cus = 0, per_cu = 0;
        hipGetDevice(&dev);
        hipDeviceGetAttribute(&cus, hipDeviceAttributeMultiprocessorCount, dev);
        hipFuncSetAttribute((const void*)fwd_megakernel, hipFuncAttributeMaxDynamicSharedMemorySize, LDS_BYTES);
        hipOccupancyMaxActiveBlocksPerMultiprocessor(&per_cu, (const void*)fwd_megakernel, NTHR, LDS_BYTES);
        if (per_cu < 1) { fprintf(stderr, "occupancy query says %d blocks/CU\n", per_cu); per_cu = 1; }
        grid_blocks = cus * per_cu;
        if (ws_size < WS_A5 + 16 * MiB) fprintf(stderr, "workspace too small: %zu\n", ws_size);
    }
    Params p{};
    p.xp = (const float*)d_in[0]; p.xs = (const float*)d_in[1]; p.w0in = (const float*)d_in[2]; p.sink = (const float*)d_in[3];
    p.w0out = (const float*)d_in[4]; p.ln0g = (const float*)d_in[5]; p.ln0b = (const float*)d_in[6]; p.w1in = (const float*)d_in[7];
    p.wgf = (const float*)d_in[8]; p.bgf = (const float*)d_in[9]; p.wgb = (const float*)d_in[10]; p.bgb = (const float*)d_in[11];
    p.hnorm = (const float*)d_in[12]; p.w1out = (const float*)d_in[13]; p.ln1g = (const float*)d_in[14]; p.ln1b = (const float*)d_in[15];
    p.out = (float*)d_out; p.ws = (unsigned char*)d_ws;
    void* args[] = {&p};
    hipError_t e = hipLaunchCooperativeKernel((const void*)fwd_megakernel, dim3(grid_blocks), dim3(NTHR), args, LDS_BYTES, stream);
    if (e != hipSuccess) fprintf(stderr, "cooperative launch failed: %s (grid %d)\n", hipGetErrorString(e), grid_blocks);
}
```

```cpp
#include <hip/hip_runtime.h>
#include <hip/hip_cooperative_groups.h>
#include <cstdio>
namespace cg = cooperative_groups;

typedef unsigned short bf16_t;
typedef short bf16x8 __attribute__((ext_vector_type(8)));
typedef short s16x4 __attribute__((ext_vector_type(4)));
typedef float f32x16 __attribute__((ext_vector_type(16)));
typedef float f32x4 __attribute__((ext_vector_type(4)));
typedef float f32x2 __attribute__((ext_vector_type(2)));
typedef unsigned u32x4 __attribute__((ext_vector_type(4)));
typedef unsigned u32x2 __attribute__((ext_vector_type(2)));
typedef __bf16 bfv2 __attribute__((ext_vector_type(2)));
#define DI __device__ __forceinline__
#define MFMA32(a, b, c) __builtin_amdgcn_mfma_f32_32x32x16_bf16((a), (b), (c), 0, 0, 0)

constexpr int T_TOK = 98304, TP = 32768, SEQ = 4096, NSEQ = 24, D = 1024;
constexpr int NTHR = 512;
constexpr size_t MiB = 1048576;
constexpr size_t RB = 192 * MiB;
constexpr int LDS_BYTES = 147456;
constexpr float LOG2E = 1.4426950408889634f;
constexpr float DN_ALPHA = 1.4142135623730951f;

struct Params {
    const float *xp, *xs, *w0in, *sink, *w0out, *ln0g, *ln0b, *w1in, *wgf, *bgf, *wgb, *bgb, *hnorm, *w1out, *ln1g, *ln1b;
    float* out;
    unsigned char* ws;
};

DI unsigned pk2(float a, float b) { f32x2 v = {a, b}; bfv2 r = __builtin_convertvector(v, bfv2); return __builtin_bit_cast(unsigned, r); }
DI float bf_lo(unsigned u) { return __uint_as_float(u << 16); }
DI float bf_hi(unsigned u) { return __uint_as_float(u & 0xffff0000u); }
DI float bf2f(bf16_t v) { return __uint_as_float(((unsigned)v) << 16); }
DI bf16_t f2bf(float a) { return (bf16_t)(pk2(a, 0.f) & 0xffffu); }
DI bf16x8 pack8(const f32x16& x, int s) {
    u32x4 p = {pk2(x[8 * s], x[8 * s + 1]), pk2(x[8 * s + 2], x[8 * s + 3]), pk2(x[8 * s + 4], x[8 * s + 5]), pk2(x[8 * s + 6], x[8 * s + 7])};
    return __builtin_bit_cast(bf16x8, p);
}
DI bf16x8 cat44(s16x4 lo, s16x4 hi) { return __builtin_shufflevector(lo, hi, 0, 1, 2, 3, 4, 5, 6, 7); }
DI int opq_tid() { int t = threadIdx.x; asm volatile("" : "+v"(t)); return t; }
DI float silu(float x) { return x / (1.0f + __expf(-x)); }
DI const float* xrow(const Params& p, int t) { return t < TP ? p.xp + (size_t)t * D : p.xs + (size_t)(t - TP) * D; }

constexpr size_t WS_WT0IN = 0, WS_WT0OUT = WS_WT0IN + 2560 * 1024 * 2, WS_WT1IN = WS_WT0OUT + 1024 * 1024 * 2, WS_WT1OUT = WS_WT1IN + 3104 * 1024 * 2;
constexpr size_t WS_A0 = 16 * MiB, WS_A1 = WS_A0 + RB, WS_A2 = WS_A1 + RB, WS_A3 = WS_A2 + RB, WS_A4 = WS_A3 + RB, WS_A5 = WS_A4 + RB;
constexpr size_t WS_K0 = WS_A3, WS_V0T = WS_A3 + 48 * MiB;
constexpr size_t WS_ELF = WS_A5, WS_ELB = WS_A5 + 1536 * 512 * 4;
constexpr size_t WS_STAT0 = WS_A5 + 6 * MiB, WS_STAT1 = WS_STAT0 + 3 * MiB, WS_CNT = WS_STAT1 + 3 * MiB;

DI void phase_convert(const Params& p, unsigned char* smem) {
    bf16_t* xb = (bf16_t*)(p.ws + WS_A0);
    const int tid = opq_tid();
    const size_t n8 = (size_t)T_TOK * D / 8;
    for (size_t i = (size_t)blockIdx.x * NTHR + tid; i < n8; i += (size_t)gridDim.x * NTHR) {
        const size_t e = i * 8; const int t = (int)(e >> 10);
        const float* src = xrow(p, t) + (e & 1023);
        const f32x4 a = *(const f32x4*)src, b = *(const f32x4*)(src + 4);
        u32x4 o = {pk2(a[0], a[1]), pk2(a[2], a[3]), pk2(b[0], b[1]), pk2(b[2], b[3])};
        *(u32x4*)(xb + e) = o;
    }
    if (blockIdx.x == 0) for (int i = tid; i < 768; i += NTHR) ((unsigned*)(p.ws + WS_CNT))[i] = 0u;
    float* tile = (float*)smem;
    for (int u = blockIdx.x; u < 3856; u += gridDim.x) {
        int v = u; const float* W; bf16_t* Wt; int N;
        if (v < 1280) { W = p.w0in; Wt = (bf16_t*)(p.ws + WS_WT0IN); N = 2560; }
        else if ((v -= 1280) < 512) { W = p.w0out; Wt = (bf16_t*)(p.ws + WS_WT0OUT); N = 1024; }
        else if ((v -= 512) < 1552) { W = p.w1in; Wt = (bf16_t*)(p.ws + WS_WT1IN); N = 3104; }
        else { v -= 1552; W = p.w1out; Wt = (bf16_t*)(p.ws + WS_WT1OUT); N = 1024; }
        const int nn32 = N / 32, nt = v % nn32, kt = v / nn32;
#pragma unroll
        for (int q = 0; q < 4; ++q) { const int e = tid + NTHR * q, kk = e >> 5, nn = e & 31; tile[kk * 33 + nn] = W[(size_t)(kt * 64 + kk) * N + nt * 32 + nn]; }
        __syncthreads();
#pragma unroll
        for (int q = 0; q < 2; ++q) { const int e = tid + NTHR * q, nn = e >> 5, kp = e & 31;
            *(unsigned*)(Wt + (size_t)(nt * 32 + nn) * 1024 + kt * 64 + 2 * kp) = pk2(tile[(2 * kp) * 33 + nn], tile[(2 * kp + 1) * 33 + nn]); }
        __syncthreads();
    }
}

DI void gemm_kloop(const bf16_t* __restrict__ P, const bf16_t* __restrict__ Q, const bf16_t* __restrict__ nP, const bf16_t* __restrict__ nQ, bool first,
                   unsigned char* smem, f32x16 (&acc)[4][2], u32x4 (&rp)[4], u32x4 (&rq)[4], int tid) {
    const int lane = tid & 63, wid = tid >> 6, wi = wid >> 2, wj = wid & 3, r = lane & 31, h = lane >> 5;
    const int crow = tid >> 3, ccol = (tid & 7) * 8;
#pragma unroll
    for (int a = 0; a < 4; ++a)
#pragma unroll
        for (int b = 0; b < 2; ++b)
#pragma unroll
            for (int i = 0; i < 16; ++i) acc[a][b][i] = 0.f;
    const unsigned char* Pb = (const unsigned char*)P;
    const unsigned char* Qb = (const unsigned char*)Q;
    const unsigned char* nPb = (const unsigned char*)nP;
    const unsigned char* nQb = (const unsigned char*)nQ;
    const unsigned voff = (unsigned)(crow * 1024 + ccol) * 2u;
    unsigned char* sw = smem + (crow * 72 + ccol) * 2;
    if (first) {
#pragma unroll
        for (int u = 0; u < 4; ++u) { rp[u] = *(const u32x4*)(Pb + (size_t)u * 131072 + voff); rq[u] = *(const u32x4*)(Qb + (size_t)u * 131072 + voff); }
    }
#pragma unroll
    for (int u = 0; u < 4; ++u) { *(u32x4*)(sw + u * 64 * 144) = rp[u]; *(u32x4*)(sw + 36864 + u * 64 * 144) = rq[u]; }
#pragma unroll
    for (int u = 0; u < 4; ++u) { rp[u] = *(const u32x4*)(Pb + (size_t)u * 131072 + 128 + voff); rq[u] = *(const u32x4*)(Qb + (size_t)u * 131072 + 128 + voff); }
    __syncthreads();
    const unsigned char* fpb = smem + ((wi * 128 + r) * 72 + h * 8) * 2;
    const unsigned char* fqb = smem + 36864 + ((wj * 64 + r) * 72 + h * 8) * 2;
    for (int kt = 0; kt < 16; ++kt) {
        const int cur = kt & 1;
        const unsigned char* bp = fpb + cur * 73728;
        const unsigned char* bq = fqb + cur * 73728;
        unsigned char* d = sw + (cur ^ 1) * 73728;
        const unsigned char* Pk = (kt + 2 < 16) ? Pb + (kt + 2) * 128 : nPb;
        const unsigned char* Qk = (kt + 2 < 16) ? Qb + (kt + 2) * 128 : nQb;
        const bool stage = kt + 1 < 16;
        bf16x8 fp[2][4], fq[2][2];
#pragma unroll
        for (int a = 0; a < 4; ++a) fp[0][a] = *(const bf16x8*)(bp + a * 32 * 144);
#pragma unroll
        for (int b = 0; b < 2; ++b) fq[0][b] = *(const bf16x8*)(bq + b * 32 * 144);
        __builtin_amdgcn_sched_barrier(0);
#pragma unroll
        for (int s = 0; s < 4; ++s) {
            if (s < 3) {
#pragma unroll
                for (int a = 0; a < 4; ++a) fp[(s + 1) & 1][a] = *(const bf16x8*)(bp + a * 32 * 144 + (s + 1) * 32);
#pragma unroll
                for (int b = 0; b < 2; ++b) fq[(s + 1) & 1][b] = *(const bf16x8*)(bq + b * 32 * 144 + (s + 1) * 32);
            }
            if (stage) {
                *(u32x4*)(d + s * 64 * 144) = rp[s];
                *(u32x4*)(d + 36864 + s * 64 * 144) = rq[s];
                rp[s] = *(const u32x4*)(Pk + (size_t)s * 131072 + voff);
                rq[s] = *(const u32x4*)(Qk + (size_t)s * 131072 + voff);
            }
#pragma unroll
            for (int a = 0; a < 4; ++a)
#pragma unroll
                for (int b = 0; b < 2; ++b) acc[a][b] = MFMA32(fp[s & 1][a], fq[s & 1][b], acc[a][b]);
            __builtin_amdgcn_sched_barrier(0);
        }
        __syncthreads();
    }
}

template <class TF, class ST> DI void gemm_tile_bf16(const bf16_t* __restrict__ P, const bf16_t* __restrict__ Q, const bf16_t* __restrict__ nP, const bf16_t* __restrict__ nQ, bool first,
                                                 u32x4 (&rp)[4], u32x4 (&rq)[4], unsigned char* smem, TF tf, ST st) {
    const int tid = opq_tid(), lane = tid & 63, wid = tid >> 6, wi = wid >> 2, wj = wid & 3, r = lane & 31, h = lane >> 5;
    f32x16 acc[4][2];
    gemm_kloop(P, Q, nP, nQ, first, smem, acc, rp, rq, tid);
#pragma unroll
    for (int a = 0; a < 4; ++a)
#pragma unroll
        for (int b = 0; b < 2; ++b)
#pragma unroll
            for (int g = 0; g < 4; ++g) {
                const int i0 = wi * 128 + a * 32 + 8 * g + 4 * h, j = wj * 64 + b * 32 + r;
                f32x4 v = {acc[a][b][4 * g], acc[a][b][4 * g + 1], acc[a][b][4 * g + 2], acc[a][b][4 * g + 3]};
                v = tf(v, i0, j);
                u32x2 o = {pk2(v[0], v[1]), pk2(v[2], v[3])};
                *(u32x2*)(smem + j * 528 + i0 * 2) = o;
            }
    __syncthreads();
#pragma unroll 4
    for (int q = 0; q < 16; ++q) {
        const int c = tid + NTHR * q, j = c >> 5, ch = c & 31;
        const u32x4 w = *(const u32x4*)(smem + j * 528 + ch * 16);
        st(j, ch * 8, w);
    }
    __syncthreads();
}

DI bool gemm_unit(int it, int nN, int& pm, int& nt) {
    const int G = gridDim.x;
    if ((G & 7) == 0) {
        const int xcd = blockIdx.x & 7, l = blockIdx.x >> 3, per = G >> 3;
        const int u = it * per + l;
        if (u >= 48 * nN) return false;
        pm = (u / nN) * 8 + xcd; nt = u % nN; return true;
    } else {
        const int u = it * G + blockIdx.x;
        if (u >= 384 * nN) return false;
        pm = u / nN; nt = u % nN; return true;
    }
}

DI size_t qk_off(int sq, int hd, int ch) { return ((size_t)((sq * 4 + hd) * 64 + ch)) * 16384; }
DI size_t v1_off(int sq, int hd, int ch) { return ((size_t)((sq * 4 + hd) * 64 + ch)) * 16384; }
DI void st_bf4(bf16_t* dst, f32x4 v) { u32x2 o = {pk2(v[0], v[1]), pk2(v[2], v[3])}; *(u32x2*)dst = o; }

DI void phase_in0(const Params& p, unsigned char* smem) {
    const bf16_t* xb = (const bf16_t*)(p.ws + WS_A0);
    const bf16_t* wt = (const bf16_t*)(p.ws + WS_WT0IN);
    bf16_t* Q0 = (bf16_t*)(p.ws + WS_A1); bf16_t* G0 = (bf16_t*)(p.ws + WS_A2); bf16_t* K0 = (bf16_t*)(p.ws + WS_K0); bf16_t* V0t = (bf16_t*)(p.ws + WS_V0T);
    auto ident = [](f32x4 v, int, int) { return v; };
    auto opnd = [&](int pm, int nt, const bf16_t*& P, const bf16_t*& Q) {
        const bf16_t* A = xb + (size_t)pm * 256 * 1024; const bf16_t* B = wt + (size_t)nt * 256 * 1024;
        if (nt == 5) { P = A; Q = B; } else { P = B; Q = A; }
    };
    u32x4 rp[4], rq[4];
    int pm, nt, pm2, nt2;
    bool have = gemm_unit(0, 10, pm, nt);
    for (int it = 0; have; ++it) {
        const bf16_t *P, *Q, *nP, *nQ;
        opnd(pm, nt, P, Q);
        const bool more = gemm_unit(it + 1, 10, pm2, nt2);
        if (more) opnd(pm2, nt2, nP, nQ); else { nP = P; nQ = Q; }
        const int t0 = pm * 256; const bool first = (it == 0);
        if (nt == 5) {
            const int sq = t0 >> 12, tl = t0 & 4095;
            gemm_tile_bf16(P, Q, nP, nQ, first, rp, rq, smem, ident, [&](int j, int i, u32x4 w) { *(u32x4*)(V0t + ((size_t)(sq * 256 + j)) * 4096 + tl + i) = w; });
        } else if (nt < 4) {
            gemm_tile_bf16(P, Q, nP, nQ, first, rp, rq, smem, ident, [&](int j, int i, u32x4 w) { *(u32x4*)(Q0 + (size_t)(t0 + j) * 1024 + nt * 256 + i) = w; });
        } else if (nt == 4) {
            gemm_tile_bf16(P, Q, nP, nQ, first, rp, rq, smem, ident, [&](int j, int i, u32x4 w) { *(u32x4*)(K0 + (size_t)(t0 + j) * 256 + i) = w; });
        } else {
            gemm_tile_bf16(P, Q, nP, nQ, first, rp, rq, smem, [](f32x4 v, int, int) { return (f32x4){silu(v[0]), silu(v[1]), silu(v[2]), silu(v[3])}; },
                           [&](int j, int i, u32x4 w) { *(u32x4*)(G0 + (size_t)(t0 + j) * 1024 + (nt - 6) * 256 + i) = w; });
        }
        have = more; pm = pm2; nt = nt2;
    }
}

DI void phase_attn(const Params& p, unsigned char* smem) {
    const bf16_t* Q0 = (const bf16_t*)(p.ws + WS_A1); const bf16_t* G0 = (const bf16_t*)(p.ws + WS_A2);
    const bf16_t* K0 = (const bf16_t*)(p.ws + WS_K0); const bf16_t* V0t = (const bf16_t*)(p.ws + WS_V0T);
    bf16_t* og = (bf16_t*)(p.ws + WS_A4);
    bf16_t* sK = (bf16_t*)smem;
    bf16_t* sVt = (bf16_t*)(smem + 55296);
    const int tid = opq_tid(), lane = tid & 63, wid = tid >> 6, r = lane & 31, h = lane >> 5;
    for (int u = blockIdx.x; u < NSEQ * 32 * 4; u += gridDim.x) {
        const int g = u & 3, n = (u >> 2) & 31, sq = u >> 7;
        const int kbase = (n - 1) * 128;
        __syncthreads();
        const u32x4 zero4 = {0u, 0u, 0u, 0u};
#pragma unroll
        for (int q = 0; q < 6; ++q) {
            const int c = tid + NTHR * q, row = c >> 3, cc = c & 7, kpos = kbase + row;
            *(u32x4*)(sK + row * 72 + cc * 8) = (kpos >= 0 && kpos < SEQ) ? *(const u32x4*)(K0 + ((size_t)sq * SEQ + kpos) * 256 + g * 64 + cc * 8) : zero4;
        }
#pragma unroll
        for (int q = 0; q < 6; ++q) {
            const int c = tid + NTHR * q, row = c / 48, cc = c % 48, kpos = kbase + cc * 8;
            *(u32x4*)(sVt + row * 392 + cc * 8) = (kpos >= 0 && kpos < SEQ) ? *(const u32x4*)(V0t + ((size_t)(sq * 256 + g * 64 + row)) * 4096 + kpos) : zero4;
        }
        __syncthreads();
        const int head = wid >> 1, hq = g * 4 + head;
        const float slope2 = exp2f(-0.5f * (float)(hq + 1)) * LOG2E;
        const float sink2 = p.sink[hq] * LOG2E;
        const int tq0 = n * 128 + (wid & 1) * 64;
        bf16x8 qf[2][4];
        f32x16 o0[2], o1[2];
        float mrun[2], lsum[2];
#pragma unroll
        for (int e = 0; e < 2; ++e) {
            const size_t trow = (size_t)sq * SEQ + tq0 + 32 * e + r;
#pragma unroll
            for (int s = 0; s < 4; ++s) qf[e][s] = *(const bf16x8*)(Q0 + trow * 1024 + hq * 64 + s * 16 + h * 8);
#pragma unroll
            for (int i = 0; i < 16; ++i) { o0[e][i] = 0.f; o1[e][i] = 0.f; }
            mrun[e] = sink2; lsum[e] = (h == 0) ? 1.0f : 0.0f;
        }
        for (int m = -4; m <= 4; ++m) {
            const bool edge = (m == -4) || (m == 4);
            f32x16 st[2];
            int kl[2]; bool ok[2];
#pragma unroll
            for (int e = 0; e < 2; ++e) {
                const int kb = tq0 + 32 * e + 32 * m;
                ok[e] = (kb >= 0) && (kb < SEQ);
                kl[e] = kb - kbase;
#pragma unroll
                for (int i = 0; i < 16; ++i) st[e][i] = 0.f;
#pragma unroll
                for (int s = 0; s < 4; ++s) { const bf16x8 kf = *(const bf16x8*)(sK + (kl[e] + r) * 72 + s * 16 + h * 8); st[e] = MFMA32(kf, qf[e][s], st[e]); }
            }
            const float fd0 = (float)(r - 32 * m - 4 * h);
#pragma unroll
            for (int e = 0; e < 2; ++e) {
                float mx = -3.0e38f;
                const bool msk = edge || !ok[e];
#pragma unroll
                for (int i = 0; i < 16; ++i) {
                    const float fd = fabsf(fd0 - (float)((i & 3) + 8 * (i >> 2)));
                    float sc = st[e][i] * (0.125f * LOG2E) - slope2 * fd;
                    if (msk) sc = (ok[e] && fd <= 128.0f) ? sc : -3.0e38f;
                    st[e][i] = sc; mx = fmaxf(mx, sc);
                }
                mx = fmaxf(mx, __shfl_xor(mx, 32));
                const float mnew = fmaxf(mrun[e], mx);
                const float al = __builtin_amdgcn_exp2f(mrun[e] - mnew);
                mrun[e] = mnew;
                float ps = 0.f;
#pragma unroll
                for (int i = 0; i < 16; ++i) { const float pe = __builtin_amdgcn_exp2f(st[e][i] - mnew); st[e][i] = pe; ps += pe; }
                lsum[e] = lsum[e] * al + ps;
                if (__any(al != 1.0f)) {
#pragma unroll
                    for (int i = 0; i < 16; ++i) { o0[e][i] *= al; o1[e][i] *= al; }
                }
            }
#pragma unroll
            for (int e = 0; e < 2; ++e)
#pragma unroll
                for (int s2 = 0; s2 < 2; ++s2) {
                    const bf16x8 pf = pack8(st[e], s2);
                    const bf16_t* vb = sVt + r * 392 + kl[e] + 16 * s2 + 4 * h;
                    const bf16x8 v0 = cat44(*(const s16x4*)vb, *(const s16x4*)(vb + 8));
                    const bf16x8 v1 = cat44(*(const s16x4*)(vb + 32 * 392), *(const s16x4*)(vb + 32 * 392 + 8));
                    o0[e] = MFMA32(v0, pf, o0[e]);
                    o1[e] = MFMA32(v1, pf, o1[e]);
                }
        }
#pragma unroll
        for (int e = 0; e < 2; ++e) {
            const size_t trow = (size_t)sq * SEQ + tq0 + 32 * e + r;
            const float inv = 1.0f / (lsum[e] + __shfl_xor(lsum[e], 32));
#pragma unroll
            for (int dt = 0; dt < 2; ++dt)
#pragma unroll
                for (int gq = 0; gq < 4; ++gq) {
                    const int col = hq * 64 + dt * 32 + 8 * gq + 4 * h;
                    const u32x2 gt = *(const u32x2*)(G0 + trow * 1024 + col);
                    const f32x16& oo = dt ? o1[e] : o0[e];
                    f32x4 v = {oo[4 * gq] * inv * bf_lo(gt[0]), oo[4 * gq + 1] * inv * bf_hi(gt[0]), oo[4 * gq + 2] * inv * bf_lo(gt[1]), oo[4 * gq + 3] * inv * bf_hi(gt[1])};
                    st_bf4(og + trow * 1024 + col, v);
                }
        }
    }
}

template <bool L1> DI void phase_out_ln(const Params& p, unsigned char* smem) {
    const bf16_t* Ain = (const bf16_t*)(p.ws + (L1 ? WS_A2 : WS_A4));
    const bf16_t* wt = (const bf16_t*)(p.ws + (L1 ? WS_WT1OUT : WS_WT0OUT));
    bf16_t* x1b = (bf16_t*)(p.ws + WS_A0);
    float* stats = (float*)(p.ws + (L1 ? WS_STAT1 : WS_STAT0));
    unsigned* cnt = (unsigned*)(p.ws + WS_CNT) + (L1 ? 384 : 0);
    const float* gw = L1 ? p.ln1g : p.ln0g; const float* bw = L1 ? p.ln1b : p.ln0b;
    u32x4 rp[4], rq[4];
    int pm, nt, pm2, nt2;
    bool have = gemm_unit(0, 4, pm, nt);
    for (int it = 0; have; ++it) {
        const bf16_t* A = Ain + (size_t)pm * 256 * 1024;
        const bf16_t* B = wt + (size_t)nt * 256 * 1024;
        const bool more = gemm_unit(it + 1, 4, pm2, nt2);
        const bf16_t* nA = more ? Ain + (size_t)pm2 * 256 * 1024 : A;
        const bf16_t* nB = more ? wt + (size_t)nt2 * 256 * 1024 : B;
        const int t0 = pm * 256;
        const int tid = opq_tid(), lane = tid & 63, wid = tid >> 6, wi = wid >> 2, wj = wid & 3, r = lane & 31, h = lane >> 5;
        {
            f32x16 acc[4][2];
            gemm_kloop(B, A, nB, nA, it == 0, smem, acc, rp, rq, tid);
#pragma unroll
            for (int a = 0; a < 4; ++a)
#pragma unroll
                for (int b = 0; b < 2; ++b)
#pragma unroll
                    for (int g = 0; g < 4; ++g) {
                        const int i0 = wi * 128 + a * 32 + 8 * g + 4 * h, j = wj * 64 + b * 32 + r;
                        u32x2 o = {pk2(acc[a][b][4 * g], acc[a][b][4 * g + 1]), pk2(acc[a][b][4 * g + 2], acc[a][b][4 * g + 3])};
                        *(u32x2*)(smem + j * 528 + i0 * 2) = o;
                    }
        }
        __builtin_amdgcn_sched_barrier(0);
        __syncthreads();
        __builtin_amdgcn_sched_barrier(0);
        const int col = nt * 256 + lane * 4;
        auto hrow = [&](int row) -> f32x4 {
            const int t = t0 + row;
            const u32x2 mv = *(const u32x2*)(smem + row * 528 + lane * 8);
            f32x4 xr;
            if (L1) { const u32x2 xv = *(const u32x2*)(x1b + (size_t)t * 1024 + col); xr = (f32x4){bf_lo(xv[0]), bf_hi(xv[0]), bf_lo(xv[1]), bf_hi(xv[1])}; }
            else xr = *(const f32x4*)(xrow(p, t) + col);
            return xr * DN_ALPHA + (f32x4){bf_lo(mv[0]), bf_hi(mv[0]), bf_lo(mv[1]), bf_hi(mv[1])};
        };
#pragma unroll 4
        for (int q = 0; q < 32; ++q) {
            const int row = wid + 8 * q, t = t0 + row;
            const f32x4 hv = hrow(row);
            float s1 = (hv[0] + hv[1]) + (hv[2] + hv[3]);
            float s2 = (hv[0] * hv[0] + hv[1] * hv[1]) + (hv[2] * hv[2] + hv[3] * hv[3]);
#pragma unroll
            for (int o = 1; o < 64; o <<= 1) { s1 += __shfl_xor(s1, o); s2 += __shfl_xor(s2, o); }
            if (lane < 2) __hip_atomic_store(stats + ((size_t)t * 4 + nt) * 2 + lane, lane ? s2 : s1, __ATOMIC_RELAXED, __HIP_MEMORY_SCOPE_AGENT);
        }
        asm volatile("s_waitcnt vmcnt(0)" ::: "memory");
        __syncthreads();
        if (tid == 0) {
            __hip_atomic_fetch_add(cnt + pm, 1u, __ATOMIC_RELEASE, __HIP_MEMORY_SCOPE_AGENT);
            int polls = 0;
            while (__hip_atomic_load(cnt + pm, __ATOMIC_RELAXED, __HIP_MEMORY_SCOPE_AGENT) < 4u && polls < (1 << 22)) { __builtin_amdgcn_s_sleep(2); ++polls; }
            __builtin_amdgcn_fence(__ATOMIC_ACQUIRE, "agent");
        }
        __syncthreads();
        const f32x4 gg = *(const f32x4*)(gw + col), bb = *(const f32x4*)(bw + col);
#pragma unroll 4
        for (int q = 0; q < 32; ++q) {
            const int row = wid + 8 * q, t = t0 + row;
            float sv = 0.f;
            if (lane < 8) sv = __hip_atomic_load(stats + (size_t)t * 8 + lane, __ATOMIC_RELAXED, __HIP_MEMORY_SCOPE_AGENT);
            sv += __shfl_xor(sv, 2); sv += __shfl_xor(sv, 4);
            const float s1 = __shfl(sv, 0), s2 = __shfl(sv, 1);
            const float mu = s1 * (1.0f / 1024.0f);
            const float rstd = rsqrtf(fmaxf(s2 * (1.0f / 1024.0f) - mu * mu, 0.f) + 1e-5f);
            const f32x4 y = (hrow(row) - mu) * rstd * gg + bb;
            if (L1) *(f32x4*)(p.out + (size_t)t * 1024 + col) = y;
            else st_bf4(x1b + (size_t)t * 1024 + col, y);
        }
        __syncthreads();
        have = more; pm = pm2; nt = nt2;
    }
}

DI void phase_in1(const Params& p, unsigned char* smem) {
    const bf16_t* x1b = (const bf16_t*)(p.ws + WS_A0);
    const bf16_t* wt = (const bf16_t*)(p.ws + WS_WT1IN);
    bf16_t* QK1 = (bf16_t*)(p.ws + WS_A1); bf16_t* V1t = (bf16_t*)(p.ws + WS_A2); bf16_t* G1 = (bf16_t*)(p.ws + WS_A3);
    auto opnd = [&](int pm, int nt, const bf16_t*& P, const bf16_t*& Q) {
        const bf16_t* A = x1b + (size_t)pm * 256 * 1024; const bf16_t* B = wt + (size_t)nt * 256 * 1024;
        if (nt >= 4 && nt < 8) { P = A; Q = B; } else { P = B; Q = A; }
    };
    u32x4 rp[4], rq[4];
    int pm, nt, pm2, nt2;
    bool have = gemm_unit(0, 12, pm, nt);
    for (int it = 0; have; ++it) {
        const bf16_t *P, *Q, *nP, *nQ;
        opnd(pm, nt, P, Q);
        const bool more = gemm_unit(it + 1, 12, pm2, nt2);
        if (more) opnd(pm2, nt2, nP, nQ); else { nP = P; nQ = Q; }
        const int t0 = pm * 256; const bool first = (it == 0);
        if (nt >= 4 && nt < 8) {
            const int sq = t0 >> 12, tl = t0 & 4095;
            gemm_tile_bf16(P, Q, nP, nQ, first, rp, rq, smem, [](f32x4 v, int, int) { return v; },
                           [&](int j, int i, u32x4 w) { *(u32x4*)(V1t + v1_off(sq, nt - 4, (tl + i) >> 6) + j * 64 + (i & 63)) = w; });
        } else if (nt < 4) {
            const float sc = nt < 2 ? 0.08838834764831845f : 1.0f;
            gemm_tile_bf16(P, Q, nP, nQ, first, rp, rq, smem, [&](f32x4 v, int, int) { return v * sc; },
                           [&](int j, int i, u32x4 w) { const int t = t0 + j, f = (nt & 1) * 256 + i;
                               *(u32x4*)(QK1 + qk_off(t >> 12, f >> 7, (t >> 6) & 63) + (nt >> 1) * 8192 + (t & 63) * 128 + (f & 127)) = w; });
        } else {
            gemm_tile_bf16(P, Q, nP, nQ, first, rp, rq, smem, [](f32x4 v, int, int) { return (f32x4){silu(v[0]), silu(v[1]), silu(v[2]), silu(v[3])}; },
                           [&](int j, int i, u32x4 w) { *(u32x4*)(G1 + (size_t)(t0 + j) * 1024 + (nt - 8) * 256 + i) = w; });
        }
        have = more; pm = pm2; nt = nt2;
    }
}

DI void phase_gates(const Params& p, unsigned char* smem) {
    const bf16_t* x1b = (const bf16_t*)(p.ws + WS_A0);
    const bf16_t* wlr = (const bf16_t*)(p.ws + WS_WT1IN) + (size_t)3072 * 1024;
    bf16_t* QK1 = (bf16_t*)(p.ws + WS_A1);
    bf16_t* QKf = (bf16_t*)(p.ws + WS_A4);
    float* part = (float*)smem;
    bf16_t* sIn = (bf16_t*)smem;
    bf16_t* sOut = (bf16_t*)(smem + 32768);
    float* sTot = (float*)(smem + 98304);
    float* lr = (float*)(smem + 102400);
    const int tid = opq_tid(), lane = tid & 63, wid = tid >> 6, r = lane & 31, h = lane >> 5;
    const int c = tid & 127, grp = tid >> 7;
    for (int cg = blockIdx.x; cg < T_TOK / 64; cg += gridDim.x) {
        const int tb = cg * 64, sq = cg >> 6, ch = cg & 63;
        {
            f32x16 a0, a1;
#pragma unroll
            for (int i = 0; i < 16; ++i) { a0[i] = 0.f; a1[i] = 0.f; }
#pragma unroll
            for (int s = 0; s < 8; ++s) {
                const int k = wid * 128 + s * 16 + h * 8;
                const bf16x8 bq = *(const bf16x8*)(wlr + (size_t)r * 1024 + k);
                const bf16x8 x0 = *(const bf16x8*)(x1b + (size_t)(tb + r) * 1024 + k);
                const bf16x8 x1 = *(const bf16x8*)(x1b + (size_t)(tb + 32 + r) * 1024 + k);
                a0 = MFMA32(x0, bq, a0); a1 = MFMA32(x1, bq, a1);
            }
            __syncthreads();
#pragma unroll
            for (int i = 0; i < 16; ++i) {
                const int t = (i & 3) + 8 * (i >> 2) + 4 * h;
                part[wid * 2048 + t * 32 + r] = a0[i];
                part[wid * 2048 + (t + 32) * 32 + r] = a1[i];
            }
            __syncthreads();
#pragma unroll
            for (int q = 0; q < 4; ++q) { const int e = tid + NTHR * q; float s = 0.f;
#pragma unroll
                for (int w = 0; w < 8; ++w) s += part[w * 2048 + e];
                lr[e] = s; }
            __syncthreads();
        }
#pragma unroll 1
        for (int hd = 0; hd < 4; ++hd) {
            bf16_t* gin = QK1 + qk_off(sq, hd, ch);
            bf16_t* gf = QKf + qk_off(sq, hd, ch);
#pragma unroll
            for (int q = 0; q < 4; ++q) *(u32x4*)(sIn + (tid + NTHR * q) * 8) = *(const u32x4*)(gin + (tid + NTHR * q) * 8);
            float pl[2][16];
#pragma unroll
            for (int dir = 0; dir < 2; ++dir) {
                const float* wg = (dir ? p.wgb : p.wgf) + hd * 128 + c;
                float w[16];
#pragma unroll
                for (int q = 0; q < 16; ++q) w[q] = wg[q * 512];
                const float bg = (dir ? p.bgb : p.bgf)[hd * 128 + c];
                float run = 0.f;
#pragma unroll
                for (int i = 0; i < 16; ++i) {
                    const f32x4* lp = (const f32x4*)(lr + (grp * 16 + i) * 32 + dir * 16);
                    const f32x4 l0 = lp[0], l1 = lp[1], l2 = lp[2], l3 = lp[3];
                    float z = bg;
                    z += l0[0] * w[0]; z += l0[1] * w[1]; z += l0[2] * w[2]; z += l0[3] * w[3];
                    z += l1[0] * w[4]; z += l1[1] * w[5]; z += l1[2] * w[6]; z += l1[3] * w[7];
                    z += l2[0] * w[8]; z += l2[1] * w[9]; z += l2[2] * w[10]; z += l2[3] * w[11];
                    z += l3[0] * w[12]; z += l3[1] * w[13]; z += l3[2] * w[14]; z += l3[3] * w[15];
                    run += (fminf(z, 0.f) - __logf(1.0f + __expf(-fabsf(z)))) * (1.0f / 16.0f);
                    pl[dir][i] = run;
                }
                sTot[(dir * 4 + grp) * 128 + c] = run;
            }
            __syncthreads();
#pragma unroll
            for (int dir = 0; dir < 2; ++dir) {
                const float t0 = sTot[(dir * 4 + 0) * 128 + c], t1 = sTot[(dir * 4 + 1) * 128 + c], t2 = sTot[(dir * 4 + 2) * 128 + c], t3 = sTot[(dir * 4 + 3) * 128 + c];
                const float tot = (t0 + t1) + (t2 + t3);
                const float base = (grp > 0 ? t0 : 0.f) + (grp > 1 ? t1 : 0.f) + (grp > 2 ? t2 : 0.f);
                if (grp == 0) ((float*)(p.ws + (dir ? WS_ELB : WS_ELF)))[(size_t)cg * 512 + hd * 128 + c] = __expf(tot);
#pragma unroll
                for (int i = 0; i < 16; ++i) {
                    const int t = grp * 16 + i;
                    const float qv = bf2f(sIn[t * 128 + c]), kv = bf2f(sIn[8192 + t * 128 + c]);
                    const float incl = base + pl[dir][i];
                    const float b = dir ? (tot - (base + (i ? pl[dir][i - 1] : 0.f))) : incl;
                    sOut[dir * 16384 + t * 128 + c] = f2bf(qv * __expf(b));
                    sOut[dir * 16384 + 8192 + t * 128 + c] = f2bf(kv * __expf(-b));
                }
            }
            __syncthreads();
#pragma unroll
            for (int q = 0; q < 4; ++q) {
                *(u32x4*)(gf + (tid + NTHR * q) * 8) = *(const u32x4*)(sOut + (tid + NTHR * q) * 8);
                *(u32x4*)(gin + (tid + NTHR * q) * 8) = *(const u32x4*)(sOut + 16384 + (tid + NTHR * q) * 8);
            }
        }
    }
}

#define LDS3 __attribute__((address_space(3)))
DI s16x4 tr_read(const bf16_t* p) { return __builtin_amdgcn_ds_read_tr16_b64_v4i16((LDS3 s16x4*)p); }
DI void phase_gla(const Params& p, unsigned char* smem) {
    const bf16_t* V1t = (const bf16_t*)(p.ws + WS_A2);
    bf16_t* sQD = (bf16_t*)smem;
    bf16_t* sKI = (bf16_t*)(smem + 17408);
    bf16_t* sVt = (bf16_t*)(smem + 34816);
    float* sEL = (float*)(smem + 71680);
    bf16_t* sAtt = (bf16_t*)(smem + 104448);
    const int tid = opq_tid(), lane = tid & 63, wid = tid >> 6, r = lane & 31, h = lane >> 5;
    const int dvs = wid * 32;
    const bf16_t* trb = sKI + (8 * h + ((lane & 15) >> 2)) * 136 + 16 * ((lane >> 4) & 1) + 4 * (lane & 3);
    for (int u = blockIdx.x; u < NSEQ * 8; u += gridDim.x) {
        const int dir = u & 1, hd = (u >> 1) & 3, sq = u >> 3;
        const bf16_t* QK = (const bf16_t*)(p.ws + (dir ? WS_A1 : WS_A4));
        const float* EL = (const float*)(p.ws + (dir ? WS_ELB : WS_ELF));
        bf16_t* od = (bf16_t*)p.out + (dir ? (size_t)T_TOK * 1024 : 0);
        f32x16 S[4];
#pragma unroll
        for (int d4 = 0; d4 < 4; ++d4)
#pragma unroll
            for (int i = 0; i < 16; ++i) S[d4][i] = 0.f;
        u32x4 rqd[2], rki[2], rv[4];
        auto gload = [&](int ch) {
            const bf16_t* gq = QK + qk_off(sq, hd, ch);
            const bf16_t* gv = V1t + v1_off(sq, hd, ch);
#pragma unroll
            for (int q = 0; q < 2; ++q) { rqd[q] = *(const u32x4*)(gq + (tid + NTHR * q) * 8); rki[q] = *(const u32x4*)(gq + 8192 + (tid + NTHR * q) * 8); }
#pragma unroll
            for (int q = 0; q < 4; ++q) rv[q] = *(const u32x4*)(gv + (tid + NTHR * q) * 8);
        };
        auto swrite = [&]() {
#pragma unroll
            for (int q = 0; q < 2; ++q) { const int c2 = tid + NTHR * q, row = c2 >> 4, cc = c2 & 15;
                *(u32x4*)(sQD + row * 136 + cc * 8) = rqd[q];
                *(u32x4*)(sKI + row * 136 + cc * 8) = rki[q]; }
#pragma unroll
            for (int q = 0; q < 4; ++q) { const int c2 = tid + NTHR * q, row = c2 >> 3, cc = c2 & 7; *(u32x4*)(sVt + row * 72 + cc * 8) = rv[q]; }
        };
        gload(dir ? 63 : 0);
        __syncthreads();
#pragma unroll 2
        for (int q = 0; q < 16; ++q) { const int e = tid + NTHR * q; sEL[e] = EL[((size_t)sq * 64 + (e >> 7)) * 512 + hd * 128 + (e & 127)]; }
        swrite();
        __syncthreads();
        for (int stp = 0; stp < 64; ++stp) {
            const int ch = dir ? 63 - stp : stp;
            if (stp + 1 < 64) gload(dir ? ch - 1 : ch + 1);
            __builtin_amdgcn_sched_barrier(0);
            if (wid < 4) {
                const int a = wid >> 1, b = wid & 1;
                bf16x8 kf[8], qf[8];
#pragma unroll
                for (int s8 = 0; s8 < 8; ++s8) { kf[s8] = *(const bf16x8*)(sKI + (32 * a + r) * 136 + 16 * s8 + 8 * h); qf[s8] = *(const bf16x8*)(sQD + (32 * b + r) * 136 + 16 * s8 + 8 * h); }
                f32x16 at0, at1;
#pragma unroll
                for (int i = 0; i < 16; ++i) { at0[i] = 0.f; at1[i] = 0.f; }
#pragma unroll
                for (int s8 = 0; s8 < 8; s8 += 2) { at0 = MFMA32(kf[s8], qf[s8], at0); at1 = MFMA32(kf[s8 + 1], qf[s8 + 1], at1); }
                const int t = 32 * b + r;
#pragma unroll
                for (int i = 0; i < 16; ++i) {
                    const int s = 32 * a + (i & 3) + 8 * (i >> 2) + 4 * h;
                    const bool keep = dir ? (s > t) : (s <= t);
                    at0[i] = keep ? (at0[i] + at1[i]) : 0.f;
                }
#pragma unroll
                for (int s2 = 0; s2 < 2; ++s2) *(bf16x8*)(sAtt + ((a * 2 + b) * 2 + s2) * 512 + lane * 8) = pack8(at0, s2);
            }
            __builtin_amdgcn_sched_barrier(0);
            f32x16 o0, o1;
#pragma unroll
            for (int i = 0; i < 16; ++i) { o0[i] = 0.f; o1[i] = 0.f; }
#pragma unroll
            for (int d4 = 0; d4 < 4; ++d4)
#pragma unroll
                for (int s2 = 0; s2 < 2; ++s2) {
                    const bf16x8 ps = pack8(S[d4], s2);
                    const bf16_t* qb = sQD + r * 136 + 32 * d4 + 16 * s2 + 4 * h;
                    const bf16x8 q0 = cat44(*(const s16x4*)qb, *(const s16x4*)(qb + 8));
                    const bf16x8 q1 = cat44(*(const s16x4*)(qb + 32 * 136), *(const s16x4*)(qb + 32 * 136 + 8));
                    o0 = MFMA32(ps, q0, o0);
                    o1 = MFMA32(ps, q1, o1);
                }
            __syncthreads();
#pragma unroll
            for (int a = 0; a < 2; ++a)
#pragma unroll
                for (int s2 = 0; s2 < 2; ++s2) {
                    const bf16_t* vb = sVt + (dvs + r) * 72 + 32 * a + 16 * s2 + 4 * h;
                    const bf16x8 va = cat44(*(const s16x4*)vb, *(const s16x4*)(vb + 8));
                    const bf16x8 p0 = *(const bf16x8*)(sAtt + ((a * 2 + 0) * 2 + s2) * 512 + lane * 8);
                    const bf16x8 p1 = *(const bf16x8*)(sAtt + ((a * 2 + 1) * 2 + s2) * 512 + lane * 8);
                    o0 = MFMA32(va, p0, o0);
                    o1 = MFMA32(va, p1, o1);
                }
            {
                const size_t tbase = (size_t)sq * SEQ + ch * 64;
#pragma unroll
                for (int g = 0; g < 4; ++g) {
                    f32x4 v0 = {o0[4 * g], o0[4 * g + 1], o0[4 * g + 2], o0[4 * g + 3]};
                    f32x4 v1 = {o1[4 * g], o1[4 * g + 1], o1[4 * g + 2], o1[4 * g + 3]};
                    st_bf4(od + (tbase + r) * 1024 + hd * 256 + dvs + 8 * g + 4 * h, v0);
                    st_bf4(od + (tbase + 32 + r) * 1024 + hd * 256 + dvs + 8 * g + 4 * h, v1);
                }
            }
            __builtin_amdgcn_sched_barrier(0);
#pragma unroll
            for (int d4 = 0; d4 < 4; ++d4) {
#pragma unroll
                for (int s4 = 0; s4 < 4; ++s4) {
                    const bf16x8 ka = cat44(tr_read(trb + (16 * s4) * 136 + 32 * d4), tr_read(trb + (16 * s4 + 4) * 136 + 32 * d4));
                    const bf16x8 vb = *(const bf16x8*)(sVt + (dvs + r) * 72 + 16 * s4 + 8 * h);
                    S[d4] = MFMA32(ka, vb, S[d4]);
                }
            }
#pragma unroll
            for (int d4 = 0; d4 < 4; ++d4)
#pragma unroll
                for (int g = 0; g < 4; ++g) {
                    const f32x4 e4 = *(const f32x4*)(sEL + ch * 128 + 32 * d4 + 8 * g + 4 * h);
                    S[d4][4 * g] *= e4[0]; S[d4][4 * g + 1] *= e4[1]; S[d4][4 * g + 2] *= e4[2]; S[d4][4 * g + 3] *= e4[3];
                }
            __syncthreads();
            if (stp + 1 < 64) swrite();
            __syncthreads();
        }
    }
}

DI void phase_combine(const Params& p) {
    const bf16_t* of = (const bf16_t*)p.out; const bf16_t* ob = of + (size_t)T_TOK * 1024;
    const bf16_t* G1 = (const bf16_t*)(p.ws + WS_A3);
    bf16_t* og = (bf16_t*)(p.ws + WS_A2);
    const int tid = opq_tid(), lane = tid & 63, wid = tid >> 6;
    for (int row = blockIdx.x * 8 + wid; row < T_TOK; row += gridDim.x * 8) {
        const size_t base = (size_t)row * 1024 + lane * 16;
        float v[16]; float ss = 0.f;
#pragma unroll
        for (int q = 0; q < 2; ++q) {
            const u32x4 a = *(const u32x4*)(of + base + q * 8), b = *(const u32x4*)(ob + base + q * 8);
#pragma unroll
            for (int j = 0; j < 4; ++j) { v[q * 8 + 2 * j] = bf_lo(a[j]) + bf_lo(b[j]); v[q * 8 + 2 * j + 1] = bf_hi(a[j]) + bf_hi(b[j]); }
        }
#pragma unroll
        for (int j = 0; j < 16; ++j) ss += v[j] * v[j];
#pragma unroll
        for (int o = 1; o < 16; o <<= 1) ss += __shfl_xor(ss, o);
        const float rstd = rsqrtf(ss * (1.0f / 256.0f) + 1e-6f);
#pragma unroll
        for (int q = 0; q < 2; ++q) {
            const u32x4 gt = *(const u32x4*)(G1 + base + q * 8);
            const f32x4 h0 = *(const f32x4*)(p.hnorm + lane * 16 + q * 8), h1 = *(const f32x4*)(p.hnorm + lane * 16 + q * 8 + 4);
            u32x4 o;
            o[0] = pk2(v[q * 8 + 0] * rstd * h0[0] * bf_lo(gt[0]), v[q * 8 + 1] * rstd * h0[1] * bf_hi(gt[0]));
            o[1] = pk2(v[q * 8 + 2] * rstd * h0[2] * bf_lo(gt[1]), v[q * 8 + 3] * rstd * h0[3] * bf_hi(gt[1]));
            o[2] = pk2(v[q * 8 + 4] * rstd * h1[0] * bf_lo(gt[2]), v[q * 8 + 5] * rstd * h1[1] * bf_hi(gt[2]));
            o[3] = pk2(v[q * 8 + 6] * rstd * h1[2] * bf_lo(gt[3]), v[q * 8 + 7] * rstd * h1[3] * bf_hi(gt[3]));
            *(u32x4*)(og + base + q * 8) = o;
        }
    }
}

__global__ void __launch_bounds__(NTHR) fwd_megakernel(Params p) {
    extern __shared__ __attribute__((aligned(16))) unsigned char smem[];
    cg::grid_group grid = cg::this_grid();
    phase_convert(p, smem);      grid.sync();
    phase_in0(p, smem);          grid.sync();
    phase_attn(p, smem);         grid.sync();
    phase_out_ln<false>(p, smem); grid.sync();
    phase_in1(p, smem);          grid.sync();
    phase_gates(p, smem);        grid.sync();
    phase_gla(p, smem);          grid.sync();
    phase_combine(p);            grid.sync();
    phase_out_ln<true>(p, smem);
}

extern "C" void kernel_launch(void* const* d_in, const int* in_sizes, int n_in, void* d_out, int out_size, void* d_ws, size_t ws_size, hipStream_t stream) {
    static int grid_blocks = 0;
    if (!grid_blocks) {
        int dev = 0, cus = 0, per_cu = 0;
        hipGetDevice(&dev);
        hipDeviceGetAttribute(&cus, hipDeviceAttributeMultiprocessorCount, dev);
        hipFuncSetAttribute((const void*)fwd_megakernel, hipFuncAttributeMaxDynamicSharedMemorySize, LDS_BYTES);
        hipOccupancyMaxActiveBlocksPerMultiprocessor(&per_cu, (const void*)fwd_megakernel, NTHR, LDS_BYTES);
        if (per_cu < 1) { fprintf(stderr, "occupancy query says %d blocks/CU\n", per_cu); per_cu = 1; }
        grid_blocks = cus * per_cu;
        if (ws_size < WS_A5 + 16 * MiB) fprintf(stderr, "workspace too small: %zu\n", ws_size);
    }
    Params p{};
    p.xp = (const float*)d_in[0]; p.xs = (const float*)d_in[1]; p.w0in = (const float*)d_in[2]; p.sink = (const float*)d_in[3];
    p.w0out = (const float*)d_in[4]; p.ln0g = (const float*)d_in[5]; p.ln0b = (const float*)d_in[6]; p.w1in = (const float*)d_in[7];
    p.wgf = (const float*)d_in[8]; p.bgf = (const float*)d_in[9]; p.wgb = (const float*)d_in[10]; p.bgb = (const float*)d_in[11];
    p.hnorm = (const float*)d_in[12]; p.w1out = (const float*)d_in[13]; p.ln1g = (const float*)d_in[14]; p.ln1b = (const float*)d_in[15];
    p.out = (float*)d_out; p.ws = (unsigned char*)d_ws;
    void* args[] = {&p};
    hipError_t e = hipLaunchCooperativeKernel((const void*)fwd_megakernel, dim3(grid_blocks), dim3(NTHR), args, LDS_BYTES, stream);
    if (e != hipSuccess) fprintf(stderr, "cooperative launch failed: %s (grid %d)\n", hipGetErrorString(e), grid_blocks);
}
```

```cpp
#include <hip/hip_runtime.h>
#include <hip/hip_cooperative_groups.h>
#include <cstdio>
#include <type_traits>
namespace cg = cooperative_groups;

typedef unsigned short bf16_t;
typedef short bf16x8 __attribute__((ext_vector_type(8)));
typedef short s16x4 __attribute__((ext_vector_type(4)));
typedef float f32x16 __attribute__((ext_vector_type(16)));
typedef float f32x4 __attribute__((ext_vector_type(4)));
typedef float f32x2 __attribute__((ext_vector_type(2)));
typedef unsigned u32x4 __attribute__((ext_vector_type(4)));
typedef unsigned u32x2 __attribute__((ext_vector_type(2)));
typedef __bf16 bfv2 __attribute__((ext_vector_type(2)));
#define DI __device__ __forceinline__
#define MFMA32(a, b, c) __builtin_amdgcn_mfma_f32_32x32x16_bf16((a), (b), (c), 0, 0, 0)

constexpr int T_TOK = 98304, TP = 32768, SEQ = 4096, NSEQ = 24, D = 1024;
constexpr int NTHR = 512;
constexpr size_t MiB = 1048576;
constexpr size_t RB = 192 * MiB;
constexpr int LDS_BYTES = 147456 + 16;
constexpr float LOG2E = 1.4426950408889634f;
constexpr float DN_ALPHA = 1.4142135623730951f;

struct Params {
    const float *xp, *xs, *w0in, *sink, *w0out, *ln0g, *ln0b, *w1in, *wgf, *bgf, *wgb, *bgb, *hnorm, *w1out, *ln1g, *ln1b;
    float* out;
    unsigned char* ws;
};

DI unsigned pk2(float a, float b) { f32x2 v = {a, b}; bfv2 r = __builtin_convertvector(v, bfv2); return __builtin_bit_cast(unsigned, r); }
DI float bf_lo(unsigned u) { return __uint_as_float(u << 16); }
DI float bf_hi(unsigned u) { return __uint_as_float(u & 0xffff0000u); }
DI float bf2f(bf16_t v) { return __uint_as_float(((unsigned)v) << 16); }
DI bf16_t f2bf(float a) { return (bf16_t)(pk2(a, 0.f) & 0xffffu); }
DI bf16x8 pack8(const f32x16& x, int s) {
    u32x4 p = {pk2(x[8 * s], x[8 * s + 1]), pk2(x[8 * s + 2], x[8 * s + 3]), pk2(x[8 * s + 4], x[8 * s + 5]), pk2(x[8 * s + 6], x[8 * s + 7])};
    return __builtin_bit_cast(bf16x8, p);
}
DI bf16x8 cat44(s16x4 lo, s16x4 hi) { return __builtin_shufflevector(lo, hi, 0, 1, 2, 3, 4, 5, 6, 7); }
DI int opq_tid() { int t = threadIdx.x; asm volatile("" : "+v"(t)); return t; }
DI float silu(float x) { return x * __builtin_amdgcn_rcpf(1.0f + __builtin_amdgcn_exp2f(-1.4426950408889634f * x)); }
DI const float* xrow(const Params& p, int t) { return t < TP ? p.xp + (size_t)t * D : p.xs + (size_t)(t - TP) * D; }

constexpr size_t WS_WT0IN = 0, WS_WT0OUT = WS_WT0IN + 2560 * 1024 * 2, WS_WT1IN = WS_WT0OUT + 1024 * 1024 * 2, WS_WT1OUT = WS_WT1IN + 3104 * 1024 * 2;
constexpr size_t WS_A0 = 16 * MiB, WS_A1 = WS_A0 + RB, WS_A2 = WS_A1 + RB, WS_A3 = WS_A2 + RB, WS_A4 = WS_A3 + RB, WS_A5 = WS_A4 + RB;
constexpr size_t WS_K0 = WS_A3, WS_V0T = WS_A3 + 48 * MiB;
constexpr size_t WS_ELF = WS_A5, WS_ELB = WS_A5 + 1536 * 512 * 4;
constexpr size_t WS_STAT0 = WS_A5 + 6 * MiB, WS_STAT1 = WS_STAT0 + 3 * MiB, WS_CNT = WS_STAT1 + 3 * MiB, WS_XBAR = WS_CNT + 4096;

DI void phase_convert(const Params& p, unsigned char* smem) {
    bf16_t* xb = (bf16_t*)(p.ws + WS_A0);
    const int tid = opq_tid();
    const size_t n8 = (size_t)T_TOK * D / 8;
    const size_t stride = (size_t)gridDim.x * NTHR;
    size_t i = (size_t)blockIdx.x * NTHR + tid;
    for (; i + 7 * stride < n8; i += 8 * stride) {
        f32x4 a[8], b[8];
#pragma unroll
        for (int q = 0; q < 8; ++q) { const size_t e = (i + q * stride) * 8; const float* src = xrow(p, (int)(e >> 10)) + (e & 1023); a[q] = *(const f32x4*)src; b[q] = *(const f32x4*)(src + 4); }
        asm volatile("" : "+v"(a[0]), "+v"(a[1]), "+v"(a[2]), "+v"(a[3]), "+v"(a[4]), "+v"(a[5]), "+v"(a[6]), "+v"(a[7]), "+v"(b[0]), "+v"(b[1]), "+v"(b[2]), "+v"(b[3]), "+v"(b[4]), "+v"(b[5]), "+v"(b[6]), "+v"(b[7]));
#pragma unroll
        for (int q = 0; q < 8; ++q) { u32x4 o = {pk2(a[q][0], a[q][1]), pk2(a[q][2], a[q][3]), pk2(b[q][0], b[q][1]), pk2(b[q][2], b[q][3])}; *(u32x4*)(xb + (i + q * stride) * 8) = o; }
    }
    for (; i < n8; i += stride) {
        const size_t e = i * 8; const int t = (int)(e >> 10);
        const float* src = xrow(p, t) + (e & 1023);
        const f32x4 a = *(const f32x4*)src, b = *(const f32x4*)(src + 4);
        u32x4 o = {pk2(a[0], a[1]), pk2(a[2], a[3]), pk2(b[0], b[1]), pk2(b[2], b[3])};
        *(u32x4*)(xb + e) = o;
    }
    if (blockIdx.x == 0) { for (int i = tid; i < 768; i += NTHR) ((unsigned*)(p.ws + WS_CNT))[i] = 0u;
        for (int i = tid; i < 3456; i += NTHR) ((unsigned*)(p.ws + WS_XBAR))[i] = 0u; }
    float* tile = (float*)smem;
    for (int u = blockIdx.x; u < 3856; u += gridDim.x) {
        int v = u; const float* W; bf16_t* Wt; int N;
        if (v < 1280) { W = p.w0in; Wt = (bf16_t*)(p.ws + WS_WT0IN); N = 2560; }
        else if ((v -= 1280) < 512) { W = p.w0out; Wt = (bf16_t*)(p.ws + WS_WT0OUT); N = 1024; }
        else if ((v -= 512) < 1552) { W = p.w1in; Wt = (bf16_t*)(p.ws + WS_WT1IN); N = 3104; }
        else { v -= 1552; W = p.w1out; Wt = (bf16_t*)(p.ws + WS_WT1OUT); N = 1024; }
        const int nn32 = N / 32, nt = v % nn32, kt = v / nn32;
#pragma unroll
        for (int q = 0; q < 4; ++q) { const int e = tid + NTHR * q, kk = e >> 5, nn = e & 31; tile[kk * 33 + nn] = W[(size_t)(kt * 64 + kk) * N + nt * 32 + nn]; }
        __syncthreads();
#pragma unroll
        for (int q = 0; q < 2; ++q) { const int e = tid + NTHR * q, nn = e >> 5, kp = e & 31;
            *(unsigned*)(Wt + (size_t)(nt * 32 + nn) * 1024 + kt * 64 + 2 * kp) = pk2(tile[(2 * kp) * 33 + nn], tile[(2 * kp + 1) * 33 + nn]); }
        __syncthreads();
    }
}

DI void gemm_kloop(const bf16_t* __restrict__ P, const bf16_t* __restrict__ Q, const bf16_t* __restrict__ nP, const bf16_t* __restrict__ nQ, bool first,
                   unsigned char* smem, f32x16 (&acc)[4][2], u32x4 (&rp)[4], u32x4 (&rq)[4], int tid) {
    const int lane = tid & 63, wid = tid >> 6, wi = wid >> 2, wj = wid & 3, r = lane & 31, h = lane >> 5;
    const int crow = tid >> 3, ccol = (tid & 7) * 8;
#pragma unroll
    for (int a = 0; a < 4; ++a)
#pragma unroll
        for (int b = 0; b < 2; ++b)
#pragma unroll
            for (int i = 0; i < 16; ++i) acc[a][b][i] = 0.f;
    const unsigned char* Pb = (const unsigned char*)P;
    const unsigned char* Qb = (const unsigned char*)Q;
    const unsigned char* nPb = (const unsigned char*)nP;
    const unsigned char* nQb = (const unsigned char*)nQ;
    const unsigned voff = (unsigned)(crow * 1024 + ccol) * 2u;
    unsigned char* sw = smem + (crow * 72 + ccol) * 2;
    if (first) {
#pragma unroll
        for (int u = 0; u < 4; ++u) { rp[u] = *(const u32x4*)(Pb + (size_t)u * 131072 + voff); rq[u] = *(const u32x4*)(Qb + (size_t)u * 131072 + voff); }
    }
#pragma unroll
    for (int u = 0; u < 4; ++u) { *(u32x4*)(sw + u * 64 * 144) = rp[u]; *(u32x4*)(sw + 36864 + u * 64 * 144) = rq[u]; }
#pragma unroll
    for (int u = 0; u < 4; ++u) { rp[u] = *(const u32x4*)(Pb + (size_t)u * 131072 + 128 + voff); rq[u] = *(const u32x4*)(Qb + (size_t)u * 131072 + 128 + voff); }
    __syncthreads();
    const unsigned char* fpb = smem + ((wi * 128 + r) * 72 + h * 8) * 2;
    const unsigned char* fqb = smem + 36864 + ((wj * 64 + r) * 72 + h * 8) * 2;
    for (int kt = 0; kt < 16; ++kt) {
        const int cur = kt & 1;
        const unsigned char* bp = fpb + cur * 73728;
        const unsigned char* bq = fqb + cur * 73728;
        unsigned char* d = sw + (cur ^ 1) * 73728;
        const unsigned char* Pk = (kt + 2 < 16) ? Pb + (kt + 2) * 128 : nPb;
        const unsigned char* Qk = (kt + 2 < 16) ? Qb + (kt + 2) * 128 : nQb;
        const bool stage = kt + 1 < 16;
        bf16x8 fp[2][4], fq[2][2];
#pragma unroll
        for (int a = 0; a < 4; ++a) fp[0][a] = *(const bf16x8*)(bp + a * 32 * 144);
#pragma unroll
        for (int b = 0; b < 2; ++b) fq[0][b] = *(const bf16x8*)(bq + b * 32 * 144);
        __builtin_amdgcn_sched_barrier(0);
#pragma unroll
        for (int s = 0; s < 4; ++s) {
            if (s < 3) {
#pragma unroll
                for (int a = 0; a < 4; ++a) fp[(s + 1) & 1][a] = *(const bf16x8*)(bp + a * 32 * 144 + (s + 1) * 32);
#pragma unroll
                for (int b = 0; b < 2; ++b) fq[(s + 1) & 1][b] = *(const bf16x8*)(bq + b * 32 * 144 + (s + 1) * 32);
            }
            if (stage) {
                *(u32x4*)(d + s * 64 * 144) = rp[s];
                *(u32x4*)(d + 36864 + s * 64 * 144) = rq[s];
                rp[s] = *(const u32x4*)(Pk + (size_t)s * 131072 + voff);
                rq[s] = *(const u32x4*)(Qk + (size_t)s * 131072 + voff);
            }
#pragma unroll
            for (int a = 0; a < 4; ++a)
#pragma unroll
                for (int b = 0; b < 2; ++b) acc[a][b] = MFMA32(fp[s & 1][a], fq[s & 1][b], acc[a][b]);
            __builtin_amdgcn_sched_barrier(0);
        }
        __syncthreads();
    }
}

template <class TF, class ST> DI void gemm_tile_bf16(const bf16_t* __restrict__ P, const bf16_t* __restrict__ Q, const bf16_t* __restrict__ nP, const bf16_t* __restrict__ nQ, bool first,
                                                 u32x4 (&rp)[4], u32x4 (&rq)[4], unsigned char* smem, TF tf, ST st) {
    const int tid = opq_tid(), lane = tid & 63, wid = tid >> 6, wi = wid >> 2, wj = wid & 3, r = lane & 31, h = lane >> 5;
    f32x16 acc[4][2];
    gemm_kloop(P, Q, nP, nQ, first, smem, acc, rp, rq, tid);
#pragma unroll
    for (int a = 0; a < 4; ++a)
#pragma unroll
        for (int b = 0; b < 2; ++b)
#pragma unroll
            for (int g = 0; g < 4; ++g) {
                const int i0 = wi * 128 + a * 32 + 8 * g + 4 * h, j = wj * 64 + b * 32 + r;
                f32x4 v = {acc[a][b][4 * g], acc[a][b][4 * g + 1], acc[a][b][4 * g + 2], acc[a][b][4 * g + 3]};
                v = tf(v, i0, j);
                u32x2 o = {pk2(v[0], v[1]), pk2(v[2], v[3])};
                *(u32x2*)(smem + j * 528 + i0 * 2) = o;
            }
    __syncthreads();
#pragma unroll 4
    for (int q = 0; q < 16; ++q) {
        const int c = tid + NTHR * q, j = c >> 5, ch = c & 31;
        const u32x4 w = *(const u32x4*)(smem + j * 528 + ch * 16);
        st(j, ch * 8, w);
    }
    __syncthreads();
}

DI bool gemm_unit(int it, int nN, int& pm, int& nt) {
    const int G = gridDim.x;
    if ((G & 7) == 0) {
        const int xcd = blockIdx.x & 7, l = blockIdx.x >> 3, per = G >> 3;
        const int u = it * per + l;
        if (u >= 48 * nN) return false;
        pm = (u / nN) * 8 + xcd; nt = u % nN; return true;
    } else {
        const int u = it * G + blockIdx.x;
        if (u >= 384 * nN) return false;
        pm = u / nN; nt = u % nN; return true;
    }
}

DI size_t qk_off(int sq, int hd, int ch) { return ((size_t)((sq * 4 + hd) * 64 + ch)) * 16384; }
DI size_t v1_off(int sq, int hd, int ch) { return ((size_t)((sq * 4 + hd) * 64 + ch)) * 16384; }
DI void st_bf4(bf16_t* dst, f32x4 v) { u32x2 o = {pk2(v[0], v[1]), pk2(v[2], v[3])}; *(u32x2*)dst = o; }

namespace pg8 {
#define PG8_LAS __attribute__((address_space(3)))
typedef unsigned short bf16_t;
typedef short bf16x8 __attribute__((ext_vector_type(8)));
typedef float f32x4 __attribute__((ext_vector_type(4)));
typedef unsigned u32x4 __attribute__((ext_vector_type(4)));
constexpr int BM = 256, BK = 64, HALF = 128, HTB = HALF * BK * 2  , STAGE_BYTES = 8 * HTB, NXCD = 8, WGM = 8;

__host__ __device__ __forceinline__ int lds_byte(int r, int c) { const int st = (r >> 4) * 2 + (c >> 5), rr = r & 15, cc = c & 31, ob = rr * 64 + cc * 2; return st * 1024 + (ob ^ (((ob >> 9) & 1) << 5)); }
__host__ __device__ __forceinline__ void stage_rc(int b, int& R, int& C) { const int st = b / 1024, sb = b % 1024, swz = sb ^ (((sb >> 9) & 1) << 5); R = (st >> 1) * 16 + swz / 64; C = (st & 1) * 32 + (swz % 64) / 2; }
__host__ __device__ __forceinline__ int perm32(int rho) { const int n = rho >> 4, i = rho & 15; return 8 * (i >> 2) + 4 * n + (i & 3); }

struct Unit { int pm, pn; };
struct Gemm { const bf16_t* A; const bf16_t* Bt; int M, N, K; };

struct StaticOrder {
    int nM, nN, nwg, G, c;
    __host__ __device__ void init(int M, int N, int G_, int c_) { nM = M / BM; nN = N / BM; nwg = nM * nN; G = G_; c = c_; }
    __host__ __device__ bool next(int i, Unit& u) const {
        const long L = (long)i * G + c; if (L >= nwg) return false;
        int wgid = (int)L; { const int q = nwg / NXCD, r = nwg % NXCD, xcd = wgid % NXCD, off = wgid / NXCD; wgid = (xcd < r ? xcd * (q + 1) : r * (q + 1) + (xcd - r) * q) + off; }
        const int nig = WGM * nN, gid = wgid / nig, fm = gid * WGM, gsz = (nM - fm) < WGM ? (nM - fm) : WGM;
        u.pm = fm + ((wgid % nig) % gsz); u.pn = (wgid % nig) / gsz; return true;
    }
    __device__ __forceinline__ void a_ready(const Unit&) const {}
    __device__ __forceinline__ void done(const Unit&) const {}
};
struct CountedOrder : StaticOrder {
    const unsigned* ready; unsigned need; unsigned* tmo;
    __device__ __forceinline__ void a_ready(const Unit& u) const {
        if (threadIdx.x < 64) {
            const unsigned long long t0 = __builtin_amdgcn_s_memrealtime(); unsigned polls = 0;
            while ((unsigned)__builtin_amdgcn_readfirstlane(__hip_atomic_load(ready + 64 * u.pm, __ATOMIC_RELAXED, __HIP_MEMORY_SCOPE_AGENT)) < need) {
                if ((++polls & 255u) == 0u && __builtin_amdgcn_readfirstlane(__hip_atomic_load(tmo, __ATOMIC_RELAXED, __HIP_MEMORY_SCOPE_AGENT)) != 0u) break;
                if (__builtin_amdgcn_s_memrealtime() - t0 > 2000000ull) {
                    if (threadIdx.x == 0) { unsigned expect = 0u; __hip_atomic_compare_exchange_strong(tmo + 1, &expect, 0x600u | (unsigned)(u.pm & 0xff), __ATOMIC_RELAXED, __ATOMIC_RELAXED, __HIP_MEMORY_SCOPE_AGENT); __hip_atomic_store(tmo, 1u, __ATOMIC_RELAXED, __HIP_MEMORY_SCOPE_AGENT); }
                    break; }
                __builtin_amdgcn_s_sleep(2); }
            __builtin_amdgcn_fence(__ATOMIC_ACQUIRE, "agent");
            asm volatile("s_waitcnt vmcnt(0)" ::: "memory");
        }
#if !defined(BROKEN_HOOK_NO_BARRIER)
        asm volatile("" ::: "memory"); __builtin_amdgcn_s_barrier(); asm volatile("" ::: "memory");
#endif
    }
};

__device__ __forceinline__ unsigned cvt_pk_bf16(float lo, float hi) { unsigned r; asm volatile("v_cvt_pk_bf16_f32 %0, %1, %2" : "=v"(r) : "v"(lo), "v"(hi)); return r; }
typedef float f32x2 __attribute__((ext_vector_type(2)));
__device__ __forceinline__ f32x2 gelu_pk(f32x2 v) {
    const f32x2 av = __builtin_elementwise_abs(v), d = av * 0.2316418882f + 1.0f;
    f32x2 t; t.x = __builtin_amdgcn_rcpf(d.x); t.y = __builtin_amdgcn_rcpf(d.y);
    f32x2 q = t * 0.5307027145f + (-0.7265760135f); q = q * t + 0.7107068705f; q = q * t + (-0.142248368f); q = q * t + 0.127414796f; q = q * t;
    const f32x2 s = (v * v) * (-0.72134752044f);
    f32x2 e; e.x = __builtin_amdgcn_exp2f(s.x); e.y = __builtin_amdgcn_exp2f(s.y);
    const f32x2 m = v * (q * e), r = v - m;
    f32x2 o; o.x = v.x < 0.f ? m.x : r.x; o.y = v.y < 0.f ? m.y : r.y; return o;
}

struct EpiF32 {
    static constexpr bool PERM = false, AFTER_DRAIN = false;
    float* C; int ldc; const float* bias;
    __device__ __forceinline__ void operator()(const f32x4 (&acc)[2][2][4][2], const Unit& u, int wr, int wc, int fr, int fq) const {
        const int row0 = u.pm * BM + wr * 64 + fr, col0 = u.pn * BM + wc * 32 + 4 * fq;
        f32x4 bv[2][2];
#pragma unroll
        for (int bj = 0; bj < 2; ++bj)
#pragma unroll
            for (int n = 0; n < 2; ++n) bv[bj][n] = bias ? *(const f32x4*)(bias + col0 + bj * HALF + n * 16) : (f32x4){0.f, 0.f, 0.f, 0.f};
#pragma unroll
        for (int ai = 0; ai < 2; ++ai)
#pragma unroll
            for (int m = 0; m < 4; ++m) { float* rowp = C + (size_t)(row0 + ai * HALF + m * 16) * ldc + col0;
#pragma unroll
                for (int bj = 0; bj < 2; ++bj)
#pragma unroll
                    for (int n = 0; n < 2; ++n) *(f32x4*)(rowp + bj * HALF + n * 16) = acc[ai][bj][m][n] + bv[bj][n]; }
    }
};
template <int ACT  > struct EpiBf16 {
    static constexpr bool PERM = true, AFTER_DRAIN = false;
    bf16_t* O; int ldc; const float* bias; int split_cols; size_t split_stride;
    __device__ __forceinline__ void operator()(const f32x4 (&acc)[2][2][4][2], const Unit& u, int wr, int wc, int fr, int fq) const {
        const int row0 = u.pm * BM + wr * 64 + fr; int colt = u.pn * BM; bf16_t* base = O;
        if (split_cols) { const int t = colt / split_cols; base += (size_t)t * split_stride; colt -= t * split_cols; }
        const int col0 = colt + wc * 32 + 8 * fq, bcol0 = u.pn * BM + wc * 32 + 8 * fq;
        f32x4 bv[2][2];
#pragma unroll
        for (int bj = 0; bj < 2; ++bj)
#pragma unroll
            for (int n = 0; n < 2; ++n) bv[bj][n] = bias ? *(const f32x4*)(bias + bcol0 + bj * HALF + 4 * n) : (f32x4){0.f, 0.f, 0.f, 0.f};
#pragma unroll
        for (int ai = 0; ai < 2; ++ai)
#pragma unroll
            for (int m = 0; m < 4; ++m) { bf16_t* rowp = base + (size_t)(row0 + ai * HALF + m * 16) * ldc + col0;
#pragma unroll
                for (int bj = 0; bj < 2; ++bj) { f32x4 v0 = acc[ai][bj][m][0] + bv[bj][0], v1 = acc[ai][bj][m][1] + bv[bj][1];
                    if (ACT == 1) { f32x2 a = gelu_pk((f32x2){v0[0], v0[1]}), b = gelu_pk((f32x2){v0[2], v0[3]}), c = gelu_pk((f32x2){v1[0], v1[1]}), d = gelu_pk((f32x2){v1[2], v1[3]});
                        v0 = (f32x4){a.x, a.y, b.x, b.y}; v1 = (f32x4){c.x, c.y, d.x, d.y}; }
                    if (ACT == 2) {
#pragma unroll
                        for (int j = 0; j < 4; ++j) { v0[j] = 0.5f * v0[j] * (1.0f + erff(v0[j] * 0.70710678f)); v1[j] = 0.5f * v1[j] * (1.0f + erff(v1[j] * 0.70710678f)); } }
                    u32x4 w; w.x = cvt_pk_bf16(v0[0], v0[1]); w.y = cvt_pk_bf16(v0[2], v0[3]); w.z = cvt_pk_bf16(v1[0], v1[1]); w.w = cvt_pk_bf16(v1[2], v1[3]);
                    *(u32x4*)(rowp + bj * HALF) = w; } }
    }
};

struct PanelStats {
    unsigned* xbuf;
    unsigned* cnt;
    unsigned* tmo;
    int ntn; float eps;
    unsigned code;
    __device__ __forceinline__ bool run(const f32x4 (&v)[2][2][4][2], const Unit& u, int wr, int wc, int fr, int fq, PG8_LAS unsigned char* lds, int wid, int lane) const {
        typedef float f32x2v __attribute__((ext_vector_type(2)));
        PG8_LAS f32x2v* P = (PG8_LAS f32x2v*)lds;
        PG8_LAS f32x2v* S = (PG8_LAS f32x2v*)(lds + 8192);
        PG8_LAS unsigned* flag = (PG8_LAS unsigned*)(lds + 8192 + 2048);
#pragma unroll
        for (int ai = 0; ai < 2; ++ai)
#pragma unroll
            for (int m = 0; m < 4; ++m) {
                float s = 0.f;
#pragma unroll
                for (int bj = 0; bj < 2; ++bj)
#pragma unroll
                    for (int n = 0; n < 2; ++n) { const f32x4 x = v[ai][bj][m][n]; s += (x[0] + x[1]) + (x[2] + x[3]); }
                s += __shfl_xor(s, 16); s += __shfl_xor(s, 32);
                const float mw = s * (1.0f / 64.0f); float q = 0.f;
#pragma unroll
                for (int bj = 0; bj < 2; ++bj)
#pragma unroll
                    for (int n = 0; n < 2; ++n) { const f32x4 d = v[ai][bj][m][n] - mw; q += (d[0] * d[0] + d[1] * d[1]) + (d[2] * d[2] + d[3] * d[3]); }
                q += __shfl_xor(q, 16); q += __shfl_xor(q, 32);
                if (fq == 0) P[(ai * HALF + wr * 64 + m * 16 + fr) * 4 + wc] = (f32x2v){mw, q};
            }
        asm volatile("s_waitcnt lgkmcnt(0)" ::: "memory"); __builtin_amdgcn_s_barrier(); asm volatile("" ::: "memory");
#if defined(BROKEN_NO_WAIT)
        if (blockIdx.x >= 64) { const long long t0 = clock64(); while (clock64() - t0 < 60000) __builtin_amdgcn_s_sleep(8); }
#endif
        const int row = wid * 32 + (lane & 31);
        if (lane < 32) {
            const f32x2v a = P[row * 4 + 0], b = P[row * 4 + 1], c = P[row * 4 + 2], d = P[row * 4 + 3];
            const float mt = (a.x + b.x + c.x + d.x) * 0.25f;
            const float da = a.x - mt, db = b.x - mt, dc = c.x - mt, dd = d.x - mt;
            const float m2 = (a.y + b.y) + (c.y + d.y) + 64.0f * ((da * da + db * db) + (dc * dc + dd * dd));
            unsigned long long* slot = (unsigned long long*)xbuf + ((size_t)(u.pm * BM + row) * 4 + u.pn);
            __hip_atomic_store(slot, ((unsigned long long)__float_as_uint(m2) << 32) | __float_as_uint(mt), __ATOMIC_RELAXED, __HIP_MEMORY_SCOPE_AGENT);
        }
        asm volatile("s_waitcnt vmcnt(0)" ::: "memory");
        if (lane == 0) __hip_atomic_fetch_add(cnt + 64 * u.pm, 1u, __ATOMIC_RELAXED, __HIP_MEMORY_SCOPE_AGENT);
        if (wid == 0) {
            bool dead = false; const unsigned long long t0 = __builtin_amdgcn_s_memrealtime(); const unsigned want = 8u * (unsigned)ntn;
            for (;;) {
#if defined(BROKEN_NO_WAIT)
                break;
#endif
                if ((unsigned)__builtin_amdgcn_readfirstlane(__hip_atomic_load(cnt + 64 * u.pm, __ATOMIC_RELAXED, __HIP_MEMORY_SCOPE_AGENT)) >= want) break;
                if (__builtin_amdgcn_s_memrealtime() - t0 > 2000000ull) {
                    if (lane == 0) { unsigned expect = 0u; __hip_atomic_compare_exchange_strong(tmo + 1, &expect, code | (unsigned)(u.pm & 0xff), __ATOMIC_RELAXED, __ATOMIC_RELAXED, __HIP_MEMORY_SCOPE_AGENT);
                                     __hip_atomic_store(tmo, 1u, __ATOMIC_RELAXED, __HIP_MEMORY_SCOPE_AGENT); }
                    dead = true; break; }
                __builtin_amdgcn_s_sleep(2);
            }
            __builtin_amdgcn_fence(__ATOMIC_ACQUIRE, "agent");
            if (lane == 0) flag[0] = dead ? 1u : 0u;
        }
        asm volatile("s_waitcnt vmcnt(0) lgkmcnt(0)" ::: "memory"); __builtin_amdgcn_s_barrier(); asm volatile("" ::: "memory");
        const bool bad = flag[0] != 0u;
        if (lane < 32) {
            const unsigned long long* slot = (const unsigned long long*)xbuf + (size_t)(u.pm * BM + row) * 4; float mt[4], m2[4]; float ms = 0.f;
#pragma unroll
            for (int t = 0; t < 4; ++t) { if (t < ntn) { const unsigned long long w = __hip_atomic_load(slot + t, __ATOMIC_RELAXED, __HIP_MEMORY_SCOPE_AGENT); mt[t] = __uint_as_float((unsigned)w); m2[t] = __uint_as_float((unsigned)(w >> 32)); } else { mt[t] = 0.f; m2[t] = 0.f; } ms += mt[t]; }
            const float mean = ms / (float)ntn; float q = 0.f;
#pragma unroll
            for (int t = 0; t < 4; ++t) if (t < ntn) { const float dm = mt[t] - mean; q += m2[t] + 256.0f * dm * dm; }
            S[row] = (f32x2v){mean, 1.0f / sqrtf(q / (256.0f * (float)ntn) + eps)};
        }
        asm volatile("s_waitcnt lgkmcnt(0)" ::: "memory"); __builtin_amdgcn_s_barrier(); asm volatile("" ::: "memory");
        return bad;
    }
};
struct EpiLnRes {
    static constexpr bool PERM = false, AFTER_DRAIN = true;
    const float* base; float* out; int ldc; const float* bias; PanelStats st; unsigned poison;
    __device__ __forceinline__ void refuse(size_t i0, size_t stride, int M, int N) const { const float q = __builtin_nanf(""); for (size_t i = i0; i < (size_t)M * N; i += stride) out[(i / N) * ldc + i % N] = q;
        if (i0 == 0) { unsigned expect = 0u; __hip_atomic_compare_exchange_strong(st.tmo + 1, &expect, 0x7f0u, __ATOMIC_RELAXED, __ATOMIC_RELAXED, __HIP_MEMORY_SCOPE_AGENT); __hip_atomic_store(st.tmo, 1u, __ATOMIC_RELAXED, __HIP_MEMORY_SCOPE_AGENT); } }
    __device__ __forceinline__ void fused(f32x4 (&acc)[2][2][4][2], const Unit& u, int wr, int wc, int fr, int fq, PG8_LAS unsigned char* lds, int wid, int lane) const {
        typedef float f32x2v __attribute__((ext_vector_type(2)));
        const PG8_LAS f32x2v* S = (const PG8_LAS f32x2v*)(lds + 8192);
        const int col0 = u.pn * BM + wc * 32 + 4 * fq;
#pragma unroll
        for (int bj = 0; bj < 2; ++bj)
#pragma unroll
            for (int n = 0; n < 2; ++n) { const f32x4 bv = bias ? *(const f32x4*)(bias + col0 + bj * HALF + n * 16) : (f32x4){0.f, 0.f, 0.f, 0.f};
#pragma unroll
                for (int ai = 0; ai < 2; ++ai)
#pragma unroll
                    for (int m = 0; m < 4; ++m) acc[ai][bj][m][n] += bv; }
        const bool bad = st.run(acc, u, wr, wc, fr, fq, lds, wid, lane) || poison != 0u;
        const float qnan = __builtin_nanf("");
#pragma unroll
        for (int ai = 0; ai < 2; ++ai)
#pragma unroll
            for (int m = 0; m < 4; ++m) { const int r = ai * HALF + wr * 64 + m * 16 + fr; const f32x2v sr = S[r]; const size_t off = (size_t)(u.pm * BM + r) * ldc + col0;
#pragma unroll
                for (int bj = 0; bj < 2; ++bj)
#pragma unroll
                    for (int n = 0; n < 2; ++n) { const f32x4 bs = *(const f32x4*)(base + off + bj * HALF + n * 16); f32x4 o = bs + (acc[ai][bj][m][n] - sr.x) * sr.y;
                        if (bad) o = (f32x4){qnan, qnan, qnan, qnan}; *(f32x4*)(out + off + bj * HALF + n * 16) = o; }
                asm volatile("" ::: "memory"); }
    }
};
struct EpiLnResLn {
    static constexpr bool PERM = false, AFTER_DRAIN = true;
    const float* base; float* out; bf16_t* xn; int ldc; const float* bias; PanelStats st1, st2; unsigned poison;
    __device__ __forceinline__ void refuse(size_t i0, size_t stride, int M, int N) const { const float q = __builtin_nanf(""); for (size_t i = i0; i < (size_t)M * N; i += stride) { const size_t o = (i / N) * ldc + i % N; out[o] = q; xn[o] = (bf16_t)0x7fc0u; }
        if (i0 == 0) { unsigned expect = 0u; __hip_atomic_compare_exchange_strong(st1.tmo + 1, &expect, 0x7f0u, __ATOMIC_RELAXED, __ATOMIC_RELAXED, __HIP_MEMORY_SCOPE_AGENT); __hip_atomic_store(st1.tmo, 1u, __ATOMIC_RELAXED, __HIP_MEMORY_SCOPE_AGENT); } }
    __device__ __forceinline__ void fused(f32x4 (&acc)[2][2][4][2], const Unit& u, int wr, int wc, int fr, int fq, PG8_LAS unsigned char* lds, int wid, int lane) const {
        typedef float f32x2v __attribute__((ext_vector_type(2))); typedef unsigned u32x2v __attribute__((ext_vector_type(2)));
        const PG8_LAS f32x2v* S = (const PG8_LAS f32x2v*)(lds + 8192);
        const int col0 = u.pn * BM + wc * 32 + 4 * fq;
#pragma unroll
        for (int bj = 0; bj < 2; ++bj)
#pragma unroll
            for (int n = 0; n < 2; ++n) { const f32x4 bv = bias ? *(const f32x4*)(bias + col0 + bj * HALF + n * 16) : (f32x4){0.f, 0.f, 0.f, 0.f};
#pragma unroll
                for (int ai = 0; ai < 2; ++ai)
#pragma unroll
                    for (int m = 0; m < 4; ++m) acc[ai][bj][m][n] += bv; }
        bool bad = st1.run(acc, u, wr, wc, fr, fq, lds, wid, lane) || poison != 0u;
        const float qnan = __builtin_nanf("");
#pragma unroll
        for (int ai = 0; ai < 2; ++ai)
#pragma unroll
            for (int m = 0; m < 4; ++m) { const int r = ai * HALF + wr * 64 + m * 16 + fr; const f32x2v sr = S[r]; const size_t off = (size_t)(u.pm * BM + r) * ldc + col0;
#pragma unroll
                for (int bj = 0; bj < 2; ++bj)
#pragma unroll
                    for (int n = 0; n < 2; ++n) { const f32x4 bs = *(const f32x4*)(base + off + bj * HALF + n * 16); acc[ai][bj][m][n] = bs + (acc[ai][bj][m][n] - sr.x) * sr.y; }
                asm volatile("" : "+v"(acc[ai][0][m][0]), "+v"(acc[ai][0][m][1]), "+v"(acc[ai][1][m][0]), "+v"(acc[ai][1][m][1]));
                if (m & 1) asm volatile("" ::: "memory"); }
        const bool bad1 = bad;
        bad = st2.run(acc, u, wr, wc, fr, fq, lds, wid, lane) || bad;
#pragma unroll
        for (int ai = 0; ai < 2; ++ai)
#pragma unroll
            for (int m = 0; m < 4; ++m) { const int r = ai * HALF + wr * 64 + m * 16 + fr; const f32x2v sr = S[r]; const size_t off = (size_t)(u.pm * BM + r) * ldc + col0;
#pragma unroll
                for (int bj = 0; bj < 2; ++bj)
#pragma unroll
                    for (int n = 0; n < 2; ++n) { const f32x4 x1 = acc[ai][bj][m][n]; *(f32x4*)(out + off + bj * HALF + n * 16) = bad1 ? (f32x4){qnan, qnan, qnan, qnan} : x1;
                        const f32x4 o = (x1 - sr.x) * sr.y; u32x2v w; w.x = cvt_pk_bf16(o[0], o[1]); w.y = cvt_pk_bf16(o[2], o[3]);
                        if (bad) { w.x = 0x7fc07fc0u; w.y = 0x7fc07fc0u; } *(u32x2v*)(xn + off + bj * HALF + n * 16) = w; }
                asm volatile("" ::: "memory"); }
    }
};

template <class Epi, class Sched, bool STAMP = false>
__device__ __forceinline__ void gemm_phase(PG8_LAS unsigned char* lds, const Gemm g, const Sched& S, const Epi& E, unsigned long long* stamps) {
    const int tid = threadIdx.x, wid = __builtin_amdgcn_readfirstlane(tid >> 6), lane = tid & 63, wr = wid >> 2, wc = wid & 3, fr = lane & 15, fq = lane >> 4;
    const int K = g.K, nt = K / BK;
    int ts_lo = 0, ts_hi = 0, nts = 0; const unsigned long long rt_entry = STAMP ? (unsigned long long)wall_clock64() : 0ull;
#define PG8_STAMP() do { if (STAMP && wid == 0 && nts < 64) { const unsigned long long _c = (unsigned long long)clock64(); \
        ts_lo = (lane == nts) ? (int)(unsigned)_c : ts_lo; ts_hi = (lane == nts) ? (int)(unsigned)(_c >> 32) : ts_hi; ++nts; } } while (0)
    PG8_STAMP();
    unsigned voffA[2], voffB[2];
#pragma unroll
    for (int i = 0; i < 2; ++i) { int R, C; stage_rc(tid * 16 + i * 8192, R, C); const int Rb = Epi::PERM ? ((R & ~31) + perm32(R & 31)) : R;
        voffA[i] = (unsigned)(R * K + C) * 2u; voffB[i] = (unsigned)(Rb * K + C) * 2u; }
    const size_t kstep = (size_t)(BK * 2);
    const size_t hstep = (size_t)HALF * K * 2;
    const size_t tstep = 2 * hstep;
    const unsigned ldsw = (unsigned)wid * 1024u;
    const int aoff = lds_byte(wr * 64 + fr, fq * 8), boff = lds_byte(wc * 32 + fr, fq * 8);
#define PG8_SA(b, h) (((b) * 2 + (h)) * HTB)
#define PG8_SB(b, h) ((4 + (b) * 2 + (h)) * HTB)
#define PG8_STAGE(bufoff, gbase, voff) do { _Pragma("unroll") for (int _i = 0; _i < 2; ++_i) \
        __builtin_amdgcn_global_load_lds((const unsigned*)((const char*)(gbase) + (voff)[_i]), (PG8_LAS unsigned*)(lds + (bufoff) + ldsw + _i * 8192), 16, 0, 0); } while (0)
#define PG8_LDA(dst, b, h) do { _Pragma("unroll") for (int m = 0; m < 4; ++m) _Pragma("unroll") for (int k = 0; k < 2; ++k) dst[m][k] = *(const PG8_LAS bf16x8*)(lds + PG8_SA(b, h) + aoff + m * 2048 + k * 1024); } while (0)
#define PG8_LDB(dst, b, h) do { _Pragma("unroll") for (int n = 0; n < 2; ++n) _Pragma("unroll") for (int k = 0; k < 2; ++k) dst[n][k] = *(const PG8_LAS bf16x8*)(lds + PG8_SB(b, h) + boff + n * 2048 + k * 1024); } while (0)
#define PG8_MMA(ai, bj, At, Bt) do { __builtin_amdgcn_s_setprio(1); _Pragma("unroll") for (int m = 0; m < 4; ++m) _Pragma("unroll") for (int n = 0; n < 2; ++n) _Pragma("unroll") for (int k = 0; k < 2; ++k) \
        acc[ai][bj][m][n] = __builtin_amdgcn_mfma_f32_16x16x32_bf16(Bt[n][k], At[m][k], acc[ai][bj][m][n], 0, 0, 0); __builtin_amdgcn_s_setprio(0); } while (0)
#define PG8_WAIT_V(n) asm volatile("s_waitcnt vmcnt(" #n ")" ::: "memory")
#define PG8_WAIT_L(n) asm volatile("s_waitcnt lgkmcnt(" #n ")" ::: "memory")
#define PG8_BAR __builtin_amdgcn_s_barrier()
#define PG8_SCHED __builtin_amdgcn_sched_barrier(0)
    Unit cur, nxt; int ui = 0;
    if (!S.next(0, cur)) return;
    f32x4 acc[2][2][4][2];
#pragma unroll
    for (int a = 0; a < 2; ++a)
#pragma unroll
        for (int b = 0; b < 2; ++b)
#pragma unroll
            for (int m = 0; m < 4; ++m)
#pragma unroll
                for (int n = 0; n < 2; ++n) acc[a][b][m][n] = (f32x4){0.f, 0.f, 0.f, 0.f};
    bf16x8 At[4][2], B0[2][2], B1[2][2];
    const char* cA = (const char*)g.A + (size_t)cur.pm * tstep; const char* cB = (const char*)g.Bt + (size_t)cur.pn * tstep;
    S.a_ready(cur);
    PG8_STAGE(PG8_SB(0, 0), cB, voffB); PG8_STAGE(PG8_SA(0, 0), cA, voffA); PG8_STAGE(PG8_SB(0, 1), cB + hstep, voffB); PG8_STAGE(PG8_SA(0, 1), cA + hstep, voffA);
    if (wr == 1) PG8_BAR;
    PG8_WAIT_V(4); PG8_BAR;
    PG8_STAGE(PG8_SB(1, 0), cB + kstep, voffB); PG8_STAGE(PG8_SA(1, 0), cA + kstep, voffA); PG8_STAGE(PG8_SB(1, 1), cB + hstep + kstep, voffB);
    PG8_WAIT_V(6); PG8_BAR;
    PG8_STAMP();
    for (;;) {
        const bool has_next = S.next(ui + 1, nxt);
        const char* nA = has_next ? (const char*)g.A + (size_t)nxt.pm * tstep : cA; const char* nB = has_next ? (const char*)g.Bt + (size_t)nxt.pn * tstep : cB;
        for (int t = 0; t < nt; t += 2) {
            const bool last = (t == nt - 2);
            const char* a1 = cA + (size_t)(t + 1) * kstep;
            const char* a2 = last ? nA : cA + (size_t)(t + 2) * kstep; const char* b2 = last ? nB : cB + (size_t)(t + 2) * kstep;
            const char* a3 = a2 + kstep; const char* b3 = b2 + kstep;
            if (last && has_next) S.a_ready(nxt);
            PG8_LDB(B0, 0, 0); PG8_SCHED; PG8_LDA(At, 0, 0); PG8_STAGE(PG8_SA(1, 1), a1 + hstep, voffA);
            PG8_WAIT_L(8); PG8_BAR; PG8_WAIT_L(0); PG8_MMA(0, 0, At, B0); PG8_BAR; PG8_SCHED;
            PG8_LDB(B1, 0, 1); PG8_STAGE(PG8_SB(0, 0), b2, voffB);
            PG8_BAR; PG8_WAIT_L(0); PG8_MMA(0, 1, At, B1); PG8_BAR;
            PG8_LDA(At, 0, 1); PG8_STAGE(PG8_SA(0, 0), a2, voffA);
            PG8_BAR; PG8_WAIT_L(0); PG8_MMA(1, 0, At, B0); PG8_BAR; PG8_SCHED;
            PG8_STAGE(PG8_SB(0, 1), b2 + hstep, voffB);
            PG8_WAIT_V(6); PG8_BAR; PG8_MMA(1, 1, At, B1); PG8_BAR;
            PG8_LDB(B0, 1, 0); PG8_SCHED; PG8_LDA(At, 1, 0); PG8_STAGE(PG8_SA(0, 1), a2 + hstep, voffA);
            PG8_WAIT_L(8); PG8_BAR; PG8_WAIT_L(0); PG8_MMA(0, 0, At, B0); PG8_BAR; PG8_SCHED;
            PG8_LDB(B1, 1, 1); PG8_STAGE(PG8_SB(1, 0), b3, voffB);
            PG8_BAR; PG8_WAIT_L(0); PG8_MMA(0, 1, At, B1); PG8_BAR;
            PG8_LDA(At, 1, 1); PG8_STAGE(PG8_SA(1, 0), a3, voffA);
            PG8_BAR; PG8_WAIT_L(0); PG8_MMA(1, 0, At, B0); PG8_BAR; PG8_SCHED;
            PG8_STAGE(PG8_SB(1, 1), b3 + hstep, voffB);
            PG8_WAIT_V(6); PG8_BAR; PG8_MMA(1, 1, At, B1); PG8_BAR;
        }
        PG8_STAMP();
        if constexpr (!Epi::AFTER_DRAIN) { E(acc, cur, wr, wc, fr, fq); S.done(cur); }
        PG8_STAMP();
        if (!has_next) break;
#pragma unroll
        for (int a = 0; a < 2; ++a)
#pragma unroll
            for (int b = 0; b < 2; ++b)
#pragma unroll
                for (int m = 0; m < 4; ++m)
#pragma unroll
                    for (int n = 0; n < 2; ++n) acc[a][b][m][n] = (f32x4){0.f, 0.f, 0.f, 0.f};
        cur = nxt; cA = nA; cB = nB; ++ui;
    }
    PG8_WAIT_V(0);
    if (wr == 0) PG8_BAR;
    PG8_BAR;
    if constexpr (Epi::AFTER_DRAIN) { E.fused(acc, cur, wr, wc, fr, fq, lds, wid, lane); S.done(cur); }
    PG8_STAMP();
    if (STAMP && wid == 0) { stamps[lane] = lane < nts ? (((unsigned long long)(unsigned)ts_hi << 32) | (unsigned)ts_lo) : 0ull;
        if (lane == 62) stamps[62] = rt_entry; if (lane == 63) stamps[63] = (unsigned long long)wall_clock64(); }
#undef PG8_STAMP
#undef PG8_SA
#undef PG8_SB
#undef PG8_STAGE
#undef PG8_LDA
#undef PG8_LDB
#undef PG8_MMA
#undef PG8_WAIT_V
#undef PG8_WAIT_L
#undef PG8_BAR
#undef PG8_SCHED
}
}

struct EpiIn0 {
    static constexpr bool PERM = true, AFTER_DRAIN = false;
    bf16_t *Q0, *K0, *V0t, *G0;
    __device__ __forceinline__ void operator()(const pg8::f32x4 (&acc)[2][2][4][2], const pg8::Unit& u, int wr, int wc, int fr, int fq) const {
        const int pn = u.pn;
#pragma unroll
        for (int ai = 0; ai < 2; ++ai)
#pragma unroll
            for (int m = 0; m < 4; ++m) {
                const int t = u.pm * 256 + ai * 128 + wr * 64 + m * 16 + fr;
#pragma unroll
                for (int bj = 0; bj < 2; ++bj) {
                    const int c = bj * 128 + wc * 32 + 8 * fq;
                    pg8::f32x4 v0 = acc[ai][bj][m][0], v1 = acc[ai][bj][m][1];
                    if (pn == 5) {
                        bf16_t* d = V0t + ((size_t)((t >> 12) * 256 + c)) * 4096 + (t & 4095);
#pragma unroll
                        for (int e = 0; e < 4; ++e) { d[(size_t)e * 4096] = f2bf(v0[e]); d[(size_t)(e + 4) * 4096] = f2bf(v1[e]); }
                    } else {
                        u32x4 w = {pk2(v0[0], v0[1]), pk2(v0[2], v0[3]), pk2(v1[0], v1[1]), pk2(v1[2], v1[3])};
                        bf16_t* d = pn < 4 ? Q0 + (size_t)t * 1024 + pn * 256 + c : (pn == 4 ? K0 + (size_t)t * 256 + c : G0 + (size_t)t * 1024 + (pn - 6) * 256 + c);
                        *(u32x4*)d = w;
                    }
                }
            }
    }
};
struct EpiIn1 {
    static constexpr bool PERM = true, AFTER_DRAIN = false;
    bf16_t *QK1, *V1t, *G1;
    __device__ __forceinline__ void operator()(const pg8::f32x4 (&acc)[2][2][4][2], const pg8::Unit& u, int wr, int wc, int fr, int fq) const {
        const int pn = u.pn;
#pragma unroll
        for (int ai = 0; ai < 2; ++ai)
#pragma unroll
            for (int m = 0; m < 4; ++m) {
                const int t = u.pm * 256 + ai * 128 + wr * 64 + m * 16 + fr;
                const int sq = t >> 12, ch = (t >> 6) & 63, tok = t & 63;
#pragma unroll
                for (int bj = 0; bj < 2; ++bj) {
                    const int c = bj * 128 + wc * 32 + 8 * fq;
                    pg8::f32x4 v0 = acc[ai][bj][m][0], v1 = acc[ai][bj][m][1];
                    if (pn >= 4 && pn < 8) {
                        bf16_t* d = V1t + v1_off(sq, pn - 4, ch) + c * 64 + tok;
#pragma unroll
                        for (int e = 0; e < 4; ++e) { d[e * 64] = f2bf(v0[e]); d[(e + 4) * 64] = f2bf(v1[e]); }
                    } else if (pn < 4) {
                        const float sc = pn < 2 ? 0.08838834764831845f : 1.0f;
                        const int f = (pn & 1) * 256 + c;
                        u32x4 w = {pk2(v0[0] * sc, v0[1] * sc), pk2(v0[2] * sc, v0[3] * sc), pk2(v1[0] * sc, v1[1] * sc), pk2(v1[2] * sc, v1[3] * sc)};
                        *(u32x4*)(QK1 + qk_off(sq, f >> 7, ch) + (pn >> 1) * 8192 + tok * 128 + (f & 127)) = w;
                    } else {
                        u32x4 w = {pk2(v0[0], v0[1]), pk2(v0[2], v0[3]), pk2(v1[0], v1[1]), pk2(v1[2], v1[3])};
                        *(u32x4*)(G1 + (size_t)t * 1024 + (pn - 8) * 256 + c) = w;
                    }
                }
            }
    }
};

DI void phase_in0(const Params& p, unsigned char* smem) {
    pg8::Gemm g; g.A = (const pg8::bf16_t*)(p.ws + WS_A0); g.Bt = (const pg8::bf16_t*)(p.ws + WS_WT0IN); g.M = T_TOK; g.N = 2560; g.K = 1024;
    pg8::StaticOrder S; S.init(T_TOK, 2560, gridDim.x, blockIdx.x);
    EpiIn0 E; E.Q0 = (bf16_t*)(p.ws + WS_A1); E.G0 = (bf16_t*)(p.ws + WS_A2); E.K0 = (bf16_t*)(p.ws + WS_K0); E.V0t = (bf16_t*)(p.ws + WS_V0T);
    pg8::gemm_phase<EpiIn0, pg8::StaticOrder, false>((PG8_LAS unsigned char*)smem, g, S, E, nullptr);
}

DI void phase_attn(const Params& p, unsigned char* smem) {
    const bf16_t* Q0 = (const bf16_t*)(p.ws + WS_A1); const bf16_t* G0 = (const bf16_t*)(p.ws + WS_A2);
    const bf16_t* K0 = (const bf16_t*)(p.ws + WS_K0); const bf16_t* V0t = (const bf16_t*)(p.ws + WS_V0T);
    bf16_t* og = (bf16_t*)(p.ws + WS_A4);
    bf16_t* sK = (bf16_t*)smem;
    bf16_t* sVt = (bf16_t*)(smem + 55296);
    const int tid = opq_tid(), lane = tid & 63, wid = tid >> 6, r = lane & 31, h = lane >> 5;
    for (int u = blockIdx.x; u < NSEQ * 32 * 4; u += gridDim.x) {
        const int g = u & 3, n = (u >> 2) & 31, sq = u >> 7;
        const int kbase = (n - 1) * 128;
        __syncthreads();
        {
            const u32x4 zero4 = {0u, 0u, 0u, 0u};
            u32x4 kv[6], vv[6];
#pragma unroll
            for (int q = 0; q < 6; ++q) {
                const int c = tid + NTHR * q, row = c >> 3, cc = c & 7, kpos = kbase + row;
                const int kc = kpos < 0 ? 0 : (kpos >= SEQ ? SEQ - 1 : kpos);
                kv[q] = *(const u32x4*)(K0 + ((size_t)sq * SEQ + kc) * 256 + g * 64 + cc * 8);
            }
#pragma unroll
            for (int q = 0; q < 6; ++q) {
                const int c = tid + NTHR * q, row = c / 48, cc = c % 48, kpos = kbase + cc * 8;
                const int kc = kpos < 0 ? 0 : (kpos >= SEQ ? SEQ - 8 : kpos);
                vv[q] = *(const u32x4*)(V0t + ((size_t)(sq * 256 + g * 64 + row)) * 4096 + kc);
            }
#pragma unroll
            for (int q = 0; q < 6; ++q) {
                const int c = tid + NTHR * q, row = c >> 3, cc = c & 7, kpos = kbase + row;
                *(u32x4*)(sK + row * 72 + cc * 8) = (kpos >= 0 && kpos < SEQ) ? kv[q] : zero4;
            }
#pragma unroll
            for (int q = 0; q < 6; ++q) {
                const int c = tid + NTHR * q, row = c / 48, cc = c % 48, kpos = kbase + cc * 8;
                *(u32x4*)(sVt + row * 392 + cc * 8) = (kpos >= 0 && kpos < SEQ) ? vv[q] : zero4;
            }
        }
        __syncthreads();
        const int head = wid >> 1, hq = g * 4 + head;
        const float slope2 = exp2f(-0.5f * (float)(hq + 1)) * LOG2E;
        const float sink2 = p.sink[hq] * LOG2E;
        const int tq0 = n * 128 + (wid & 1) * 64;
        bf16x8 qf[2][4];
        f32x16 o0[2], o1[2];
        float mrun[2], lsum[2];
#pragma unroll
        for (int e = 0; e < 2; ++e) {
            const size_t trow = (size_t)sq * SEQ + tq0 + 32 * e + r;
#pragma unroll
            for (int s = 0; s < 4; ++s) qf[e][s] = *(const bf16x8*)(Q0 + trow * 1024 + hq * 64 + s * 16 + h * 8);
#pragma unroll
            for (int i = 0; i < 16; ++i) { o0[e][i] = 0.f; o1[e][i] = 0.f; }
            mrun[e] = sink2; lsum[e] = (h == 0) ? 1.0f : 0.0f;
        }
        auto tile_step = [&](auto maskc, int m) {
            constexpr bool MASKED = decltype(maskc)::value;
            const bool edge = (m == -4) || (m == 4);
            f32x16 st[2];
            int kl[2]; bool ok[2];
#pragma unroll
            for (int e = 0; e < 2; ++e) {
                const int kb = tq0 + 32 * e + 32 * m;
                ok[e] = (kb >= 0) && (kb < SEQ);
                kl[e] = kb - kbase;
#pragma unroll
                for (int i = 0; i < 16; ++i) st[e][i] = 0.f;
#pragma unroll
                for (int s = 0; s < 4; ++s) { const bf16x8 kf = *(const bf16x8*)(sK + (kl[e] + r) * 72 + s * 16 + h * 8); st[e] = MFMA32(kf, qf[e][s], st[e]); }
            }
            const float fd0 = (float)(r - 32 * m - 4 * h);
#pragma unroll
            for (int e = 0; e < 2; ++e) {
                float mx = -3.0e38f;
                const bool msk = edge || !ok[e];
#pragma unroll
                for (int i = 0; i < 16; ++i) {
                    const float fd = fabsf(fd0 - (float)((i & 3) + 8 * (i >> 2)));
                    float sc = st[e][i] * (0.125f * LOG2E) - slope2 * fd;
                    if (MASKED) { if (msk) sc = (ok[e] && fd <= 128.0f) ? sc : -3.0e38f; }
                    st[e][i] = sc; mx = fmaxf(mx, sc);
                }
                mx = fmaxf(mx, __shfl_xor(mx, 32));
                const float mnew = fmaxf(mrun[e], mx);
                const float al = __builtin_amdgcn_exp2f(mrun[e] - mnew);
                mrun[e] = mnew;
                float ps = 0.f;
#pragma unroll
                for (int i = 0; i < 16; ++i) { const float pe = __builtin_amdgcn_exp2f(st[e][i] - mnew); st[e][i] = pe; ps += pe; }
                lsum[e] = lsum[e] * al + ps;
                if (__any(al != 1.0f)) {
#pragma unroll
                    for (int i = 0; i < 16; ++i) { o0[e][i] *= al; o1[e][i] *= al; }
                }
            }
#pragma unroll
            for (int e = 0; e < 2; ++e)
#pragma unroll
                for (int s2 = 0; s2 < 2; ++s2) {
                    const bf16x8 pf = pack8(st[e], s2);
                    const bf16_t* vb = sVt + r * 392 + kl[e] + 16 * s2 + 4 * h;
                    const bf16x8 v0 = cat44(*(const s16x4*)vb, *(const s16x4*)(vb + 8));
                    const bf16x8 v1 = cat44(*(const s16x4*)(vb + 32 * 392), *(const s16x4*)(vb + 32 * 392 + 8));
                    o0[e] = MFMA32(v0, pf, o0[e]);
                    o1[e] = MFMA32(v1, pf, o1[e]);
                }
        };
        for (int m = -4; m <= 4; ++m) {
            const int kb0 = tq0 + 32 * m;
            const bool plain = (m > -4) && (m < 4) && (kb0 >= 0) && (kb0 + 32 < SEQ);
            if (plain) tile_step(std::integral_constant<bool, false>{}, m); else tile_step(std::integral_constant<bool, true>{}, m);
        }
        bf16_t* sO = (bf16_t*)(smem + 105472) + wid * 2304;
#pragma unroll
        for (int e = 0; e < 2; ++e) {
            const float inv = 1.0f / (lsum[e] + __shfl_xor(lsum[e], 32));
#pragma unroll
            for (int dt = 0; dt < 2; ++dt)
#pragma unroll
                for (int gq = 0; gq < 4; ++gq) {
                    const f32x16& oo = dt ? o1[e] : o0[e];
                    f32x4 v = {oo[4 * gq] * inv, oo[4 * gq + 1] * inv, oo[4 * gq + 2] * inv, oo[4 * gq + 3] * inv};
                    st_bf4(sO + r * 72 + dt * 32 + 8 * gq + 4 * h, v);
                }
            const size_t tb = (size_t)sq * SEQ + tq0 + 32 * e;
#pragma unroll
            for (int k = 0; k < 4; ++k) {
                const int c = lane + 64 * k, row = c >> 3, cc = c & 7;
                const u32x4 ov = *(const u32x4*)(sO + row * 72 + cc * 8);
                const u32x4 gt = *(const u32x4*)(G0 + (tb + row) * 1024 + hq * 64 + cc * 8);
                u32x4 w;
#pragma unroll
                for (int j = 0; j < 4; ++j) w[j] = pk2(bf_lo(ov[j]) * silu(bf_lo(gt[j])), bf_hi(ov[j]) * silu(bf_hi(gt[j])));
                *(u32x4*)(og + (tb + row) * 1024 + hq * 64 + cc * 8) = w;
            }
        }
    }
}

template <bool L1> DI void phase_out_ln(const Params& p, unsigned char* smem) {
    const bf16_t* Ain = (const bf16_t*)(p.ws + (L1 ? WS_A2 : WS_A4));
    const bf16_t* wt = (const bf16_t*)(p.ws + (L1 ? WS_WT1OUT : WS_WT0OUT));
    bf16_t* x1b = (bf16_t*)(p.ws + WS_A0);
    float* stats = (float*)(p.ws + (L1 ? WS_STAT1 : WS_STAT0));
    unsigned* cnt = (unsigned*)(p.ws + WS_CNT) + (L1 ? 384 : 0);
    const float* gw = L1 ? p.ln1g : p.ln0g; const float* bw = L1 ? p.ln1b : p.ln0b;
    u32x4 rp[4], rq[4];
    int pm, nt, pm2, nt2;
    bool have = gemm_unit(0, 4, pm, nt);
    for (int it = 0; have; ++it) {
        const bf16_t* A = Ain + (size_t)pm * 256 * 1024;
        const bf16_t* B = wt + (size_t)nt * 256 * 1024;
        const bool more = gemm_unit(it + 1, 4, pm2, nt2);
        const bf16_t* nA = more ? Ain + (size_t)pm2 * 256 * 1024 : A;
        const bf16_t* nB = more ? wt + (size_t)nt2 * 256 * 1024 : B;
        const int t0 = pm * 256;
        const int tid = opq_tid(), lane = tid & 63, wid = tid >> 6, wi = wid >> 2, wj = wid & 3, r = lane & 31, h = lane >> 5;
        {
            f32x16 acc[4][2];
            gemm_kloop(B, A, nB, nA, it == 0, smem, acc, rp, rq, tid);
#pragma unroll
            for (int a = 0; a < 4; ++a)
#pragma unroll
                for (int b = 0; b < 2; ++b)
#pragma unroll
                    for (int g = 0; g < 4; ++g) {
                        const int i0 = wi * 128 + a * 32 + 8 * g + 4 * h, j = wj * 64 + b * 32 + r;
                        u32x2 o = {pk2(acc[a][b][4 * g], acc[a][b][4 * g + 1]), pk2(acc[a][b][4 * g + 2], acc[a][b][4 * g + 3])};
                        *(u32x2*)(smem + j * 528 + i0 * 2) = o;
                    }
        }
        __builtin_amdgcn_sched_barrier(0);
        __syncthreads();
        __builtin_amdgcn_sched_barrier(0);
        const int col = nt * 256 + lane * 4;
        auto hrow = [&](int row) -> f32x4 {
            const int t = t0 + row;
            const u32x2 mv = *(const u32x2*)(smem + row * 528 + lane * 8);
            f32x4 xr;
            if (L1) { const u32x2 xv = *(const u32x2*)(x1b + (size_t)t * 1024 + col); xr = (f32x4){bf_lo(xv[0]), bf_hi(xv[0]), bf_lo(xv[1]), bf_hi(xv[1])}; }
            else xr = *(const f32x4*)(xrow(p, t) + col);
            return xr * DN_ALPHA + (f32x4){bf_lo(mv[0]), bf_hi(mv[0]), bf_lo(mv[1]), bf_hi(mv[1])};
        };
        {
            float v[64];
#pragma unroll
            for (int hb = 0; hb < 4; ++hb) {
                f32x4 xr[8];
#pragma unroll
                for (int q = 0; q < 8; ++q) {
                    const int t = t0 + wid + 8 * (hb * 8 + q);
                    if (L1) { const u32x2 xv = *(const u32x2*)(x1b + (size_t)t * 1024 + col); xr[q] = (f32x4){__uint_as_float(xv[0]), __uint_as_float(xv[1]), 0.f, 0.f}; }
                    else xr[q] = *(const f32x4*)(xrow(p, t) + col);
                }
                asm volatile("" : "+v"(xr[0]), "+v"(xr[1]), "+v"(xr[2]), "+v"(xr[3]), "+v"(xr[4]), "+v"(xr[5]), "+v"(xr[6]), "+v"(xr[7]));
#pragma unroll
                for (int q = 0; q < 8; ++q) {
                    const int qq = hb * 8 + q, row = wid + 8 * qq;
                    const u32x2 mv = *(const u32x2*)(smem + row * 528 + lane * 8);
                    f32x4 xv;
                    if (L1) { const unsigned u0 = __float_as_uint(xr[q][0]), u1 = __float_as_uint(xr[q][1]); xv = (f32x4){bf_lo(u0), bf_hi(u0), bf_lo(u1), bf_hi(u1)}; }
                    else xv = xr[q];
                    const f32x4 hv = xv * DN_ALPHA + (f32x4){bf_lo(mv[0]), bf_hi(mv[0]), bf_lo(mv[1]), bf_hi(mv[1])};
                    v[2 * qq] = (hv[0] + hv[1]) + (hv[2] + hv[3]);
                    v[2 * qq + 1] = (hv[0] * hv[0] + hv[1] * hv[1]) + (hv[2] * hv[2] + hv[3] * hv[3]);
                }
            }
#pragma unroll
            for (int k = 0; k < 6; ++k) {
                const int hlf = 32 >> k;
                const bool up = (lane >> k) & 1;
#pragma unroll
                for (int i = 0; i < hlf; ++i) {
                    const float keep = up ? v[hlf + i] : v[i];
                    const float send = up ? v[i] : v[hlf + i];
                    v[i] = keep + __shfl_xor(send, 1 << k);
                }
            }
            const int idx = ((lane & 1) << 5) | ((lane & 2) << 3) | ((lane & 4) << 1) | ((lane & 8) >> 1) | ((lane & 16) >> 3) | ((lane & 32) >> 5);
            const int row = wid + 8 * (idx >> 1);
            __hip_atomic_store(stats + ((size_t)(t0 + row) * 4 + nt) * 2 + (idx & 1), v[0], __ATOMIC_RELAXED, __HIP_MEMORY_SCOPE_AGENT);
        }
        asm volatile("s_waitcnt vmcnt(0)" ::: "memory");
        __syncthreads();
        if (tid == 0) {
            __hip_atomic_fetch_add(cnt + pm, 1u, __ATOMIC_RELEASE, __HIP_MEMORY_SCOPE_AGENT);
            int polls = 0;
            while (__hip_atomic_load(cnt + pm, __ATOMIC_RELAXED, __HIP_MEMORY_SCOPE_AGENT) < 4u && polls < (1 << 22)) { __builtin_amdgcn_s_sleep(2); ++polls; }
            __builtin_amdgcn_fence(__ATOMIC_ACQUIRE, "agent");
        }
        __syncthreads();
        const f32x4 gg = *(const f32x4*)(gw + col), bb = *(const f32x4*)(bw + col);
        float mu_l, rstd_l;
        {
            const float* sp = stats + (size_t)(t0 + wid + 8 * (lane & 31)) * 8;
            float s1 = 0.f, s2 = 0.f;
#pragma unroll
            for (int i = 0; i < 4; ++i) { s1 += __hip_atomic_load(sp + 2 * i, __ATOMIC_RELAXED, __HIP_MEMORY_SCOPE_AGENT); s2 += __hip_atomic_load(sp + 2 * i + 1, __ATOMIC_RELAXED, __HIP_MEMORY_SCOPE_AGENT); }
            mu_l = s1 * (1.0f / 1024.0f);
            rstd_l = rsqrtf(fmaxf(s2 * (1.0f / 1024.0f) - mu_l * mu_l, 0.f) + 1e-5f);
        }
#pragma unroll 1
        for (int hb = 0; hb < 4; ++hb) {
            f32x4 xr[8];
#pragma unroll
            for (int q = 0; q < 8; ++q) {
                const int t = t0 + wid + 8 * (hb * 8 + q);
                if (L1) { const u32x2 xv = *(const u32x2*)(x1b + (size_t)t * 1024 + col); xr[q] = (f32x4){__uint_as_float(xv[0]), __uint_as_float(xv[1]), 0.f, 0.f}; }
                else xr[q] = *(const f32x4*)(xrow(p, t) + col);
            }
            asm volatile("" : "+v"(xr[0]), "+v"(xr[1]), "+v"(xr[2]), "+v"(xr[3]), "+v"(xr[4]), "+v"(xr[5]), "+v"(xr[6]), "+v"(xr[7]));
#pragma unroll
            for (int q = 0; q < 8; ++q) {
                const int qq = hb * 8 + q, row = wid + 8 * qq, t = t0 + row;
                const float mu = __int_as_float(__builtin_amdgcn_readlane(__float_as_int(mu_l), qq));
                const float rstd = __int_as_float(__builtin_amdgcn_readlane(__float_as_int(rstd_l), qq));
                const u32x2 mv = *(const u32x2*)(smem + row * 528 + lane * 8);
                f32x4 xv;
                if (L1) { const unsigned u0 = __float_as_uint(xr[q][0]), u1 = __float_as_uint(xr[q][1]); xv = (f32x4){bf_lo(u0), bf_hi(u0), bf_lo(u1), bf_hi(u1)}; }
                else xv = xr[q];
                const f32x4 hv = xv * DN_ALPHA + (f32x4){bf_lo(mv[0]), bf_hi(mv[0]), bf_lo(mv[1]), bf_hi(mv[1])};
                const f32x4 y = (hv - mu) * rstd * gg + bb;
                if (L1) *(f32x4*)(p.out + (size_t)t * 1024 + col) = y;
                else st_bf4(x1b + (size_t)t * 1024 + col, y);
            }
        }
        __syncthreads();
        have = more; pm = pm2; nt = nt2;
    }
}

DI void phase_in1(const Params& p, unsigned char* smem) {
    pg8::Gemm g; g.A = (const pg8::bf16_t*)(p.ws + WS_A0); g.Bt = (const pg8::bf16_t*)(p.ws + WS_WT1IN); g.M = T_TOK; g.N = 3072; g.K = 1024;
    pg8::StaticOrder S; S.init(T_TOK, 3072, gridDim.x, blockIdx.x);
    EpiIn1 E; E.QK1 = (bf16_t*)(p.ws + WS_A1); E.V1t = (bf16_t*)(p.ws + WS_A2); E.G1 = (bf16_t*)(p.ws + WS_A3);
    pg8::gemm_phase<EpiIn1, pg8::StaticOrder, false>((PG8_LAS unsigned char*)smem, g, S, E, nullptr);
}

DI void phase_gates(const Params& p, unsigned char* smem) {
    const bf16_t* x1b = (const bf16_t*)(p.ws + WS_A0);
    const bf16_t* wlr = (const bf16_t*)(p.ws + WS_WT1IN) + (size_t)3072 * 1024;
    bf16_t* QK1 = (bf16_t*)(p.ws + WS_A1);
    bf16_t* QKf = (bf16_t*)(p.ws + WS_A4);
    float* part = (float*)smem;
    bf16_t* sIn = (bf16_t*)smem;
    bf16_t* sOut = (bf16_t*)(smem + 32768);
    bf16_t* lrb = (bf16_t*)(smem + 98304);
    const int tid = opq_tid(), lane = tid & 63, wid = tid >> 6, r = lane & 31, h = lane >> 5;
    const int ct = wid & 3, dir = wid >> 2;
    const float* wgp = dir ? p.wgb : p.wgf; const float* bgp = dir ? p.bgb : p.bgf;
    for (int cg = blockIdx.x; cg < T_TOK / 64; cg += gridDim.x) {
        const int tb = cg * 64, sq = cg >> 6, ch = cg & 63;
        {
            f32x16 a0, a1;
#pragma unroll
            for (int i = 0; i < 16; ++i) { a0[i] = 0.f; a1[i] = 0.f; }
            bf16x8 fbq[8], fx0[8], fx1[8];
#pragma unroll
            for (int s = 0; s < 8; ++s) {
                const int k = wid * 128 + s * 16 + h * 8;
                fbq[s] = *(const bf16x8*)(wlr + (size_t)r * 1024 + k);
                fx0[s] = *(const bf16x8*)(x1b + (size_t)(tb + r) * 1024 + k);
                fx1[s] = *(const bf16x8*)(x1b + (size_t)(tb + 32 + r) * 1024 + k);
            }
            asm volatile("" : "+v"(fx0[0]), "+v"(fx0[1]), "+v"(fx0[2]), "+v"(fx0[3]), "+v"(fx0[4]), "+v"(fx0[5]), "+v"(fx0[6]), "+v"(fx0[7]),
                              "+v"(fx1[0]), "+v"(fx1[1]), "+v"(fx1[2]), "+v"(fx1[3]), "+v"(fx1[4]), "+v"(fx1[5]), "+v"(fx1[6]), "+v"(fx1[7]));
#pragma unroll
            for (int s = 0; s < 8; ++s) { a0 = MFMA32(fx0[s], fbq[s], a0); a1 = MFMA32(fx1[s], fbq[s], a1); }
            __syncthreads();
#pragma unroll
            for (int i = 0; i < 16; ++i) {
                const int t = (i & 3) + 8 * (i >> 2) + 4 * h;
                part[wid * 2048 + t * 32 + r] = a0[i];
                part[wid * 2048 + (t + 32) * 32 + r] = a1[i];
            }
            __syncthreads();
            float s4[4];
#pragma unroll
            for (int q = 0; q < 4; ++q) { const int e = tid + NTHR * q; float s = 0.f;
#pragma unroll
                for (int w = 0; w < 8; ++w) s += part[w * 2048 + e];
                s4[q] = s; }
#pragma unroll
            for (int q = 0; q < 4; ++q) lrb[tid + NTHR * q] = f2bf(s4[q]);
            __syncthreads();
        }
#pragma unroll 1
        for (int hd = 0; hd < 4; ++hd) {
            bf16_t* gin = QK1 + qk_off(sq, hd, ch);
            bf16_t* gf = QKf + qk_off(sq, hd, ch);
            u32x4 rin[4];
#pragma unroll
            for (int q = 0; q < 4; ++q) rin[q] = *(const u32x4*)(gin + (tid + NTHR * q) * 8);
            const int col = hd * 128 + ct * 32 + r;
            bf16x8 bw;
            { float wv[8];
#pragma unroll
              for (int j = 0; j < 8; ++j) wv[j] = wgp[(8 * h + j) * 512 + col];
              u32x4 pw = {pk2(wv[0], wv[1]), pk2(wv[2], wv[3]), pk2(wv[4], wv[5]), pk2(wv[6], wv[7])}; bw = __builtin_bit_cast(bf16x8, pw); }
            const float bg = bgp[col];
            f32x16 z[2];
#pragma unroll
            for (int tt = 0; tt < 2; ++tt) {
#pragma unroll
                for (int i = 0; i < 16; ++i) z[tt][i] = 0.f;
                const bf16x8 af = *(const bf16x8*)(lrb + (tt * 32 + r) * 32 + dir * 16 + 8 * h);
                z[tt] = MFMA32(af, bw, z[tt]);
            }
            float seg[8];
#pragma unroll
            for (int tt = 0; tt < 2; ++tt)
#pragma unroll
                for (int g4 = 0; g4 < 4; ++g4) {
                    float s = 0.f;
#pragma unroll
                    for (int e = 0; e < 4; ++e) { const float zz = z[tt][4 * g4 + e] + bg;
                        const float gv = (fminf(zz, 0.f) - __logf(1.0f + __expf(-fabsf(zz)))) * (1.0f / 16.0f);
                        z[tt][4 * g4 + e] = gv; s += gv; }
                    seg[tt * 4 + g4] = s;
                }
            float off[8]; float run = 0.f;
#pragma unroll
            for (int k = 0; k < 8; ++k) { const float oth = __shfl_xor(seg[k], 32); off[k] = run + (h ? oth : 0.f); run += seg[k] + oth; }
            const float tot = run;
            if (h == 0) ((float*)(p.ws + (dir ? WS_ELB : WS_ELF)))[(size_t)cg * 512 + col] = __expf(tot);
#pragma unroll
            for (int q = 0; q < 4; ++q) *(u32x4*)(sIn + (tid + NTHR * q) * 8) = rin[q];
            __syncthreads();
#pragma unroll
            for (int tt = 0; tt < 2; ++tt)
#pragma unroll
                for (int g4 = 0; g4 < 4; ++g4) {
                    float pre = off[tt * 4 + g4];
#pragma unroll
                    for (int e = 0; e < 4; ++e) {
                        const int t = tt * 32 + 8 * g4 + 4 * h + e;
                        const float gv = z[tt][4 * g4 + e];
                        const float b = dir ? (tot - pre) : (pre + gv);
                        pre += gv;
                        const float qv = bf2f(sIn[t * 128 + ct * 32 + r]), kv = bf2f(sIn[8192 + t * 128 + ct * 32 + r]);
                        sOut[dir * 16384 + t * 128 + ct * 32 + r] = f2bf(qv * __expf(b));
                        sOut[dir * 16384 + 8192 + t * 128 + ct * 32 + r] = f2bf(kv * __expf(-b));
                    }
                }
            __syncthreads();
#pragma unroll
            for (int q = 0; q < 4; ++q) {
                *(u32x4*)(gf + (tid + NTHR * q) * 8) = *(const u32x4*)(sOut + (tid + NTHR * q) * 8);
                *(u32x4*)(gin + (tid + NTHR * q) * 8) = *(const u32x4*)(sOut + 16384 + (tid + NTHR * q) * 8);
            }
        }
    }
}

#define LDS3 __attribute__((address_space(3)))
DI s16x4 tr_read(const bf16_t* p) { return __builtin_amdgcn_ds_read_tr16_b64_v4i16((LDS3 s16x4*)p); }
DI void phase_gla(const Params& p, unsigned char* smem) {
    const bf16_t* V1t = (const bf16_t*)(p.ws + WS_A2);
    bf16_t* sQD = (bf16_t*)smem;
    bf16_t* sKI = (bf16_t*)(smem + 17408);
    bf16_t* sVt = (bf16_t*)(smem + 34816);
    float* sEL = (float*)(smem + 71680);
    bf16_t* sAtt = (bf16_t*)(smem + 104448);
    bf16_t* sOut = (bf16_t*)(smem + 112640);
    const int tid = opq_tid(), lane = tid & 63, wid = tid >> 6, r = lane & 31, h = lane >> 5;
    const int dvs = wid * 32;
    const bf16_t* trb = sKI + (8 * h + ((lane & 15) >> 2)) * 136 + 16 * ((lane >> 4) & 1) + 4 * (lane & 3);
    for (int u = blockIdx.x; u < NSEQ * 8; u += gridDim.x) {
        const int dir = u & 1, hd = (u >> 1) & 3, sq = u >> 3;
        const bf16_t* QK = (const bf16_t*)(p.ws + (dir ? WS_A1 : WS_A4));
        const float* EL = (const float*)(p.ws + (dir ? WS_ELB : WS_ELF));
        bf16_t* od = (bf16_t*)p.out + (dir ? (size_t)T_TOK * 1024 : 0);
        f32x16 S[4];
#pragma unroll
        for (int d4 = 0; d4 < 4; ++d4)
#pragma unroll
            for (int i = 0; i < 16; ++i) S[d4][i] = 0.f;
        u32x4 rqd[2], rki[2], rv[4];
        auto gload = [&](int ch) {
            const bf16_t* gq = QK + qk_off(sq, hd, ch);
            const bf16_t* gv = V1t + v1_off(sq, hd, ch);
#pragma unroll
            for (int q = 0; q < 2; ++q) { rqd[q] = *(const u32x4*)(gq + (tid + NTHR * q) * 8); rki[q] = *(const u32x4*)(gq + 8192 + (tid + NTHR * q) * 8); }
#pragma unroll
            for (int q = 0; q < 4; ++q) rv[q] = *(const u32x4*)(gv + (tid + NTHR * q) * 8);
        };
        auto swrite = [&]() {
#pragma unroll
            for (int q = 0; q < 2; ++q) { const int c2 = tid + NTHR * q, row = c2 >> 4, cc = c2 & 15;
                *(u32x4*)(sQD + row * 136 + cc * 8) = rqd[q];
                *(u32x4*)(sKI + row * 136 + cc * 8) = rki[q]; }
#pragma unroll
            for (int q = 0; q < 4; ++q) { const int c2 = tid + NTHR * q, row = c2 >> 3, cc = c2 & 7; *(u32x4*)(sVt + row * 72 + cc * 8) = rv[q]; }
        };
        gload(dir ? 63 : 0);
        __syncthreads();
#pragma unroll 2
        for (int q = 0; q < 16; ++q) { const int e = tid + NTHR * q; sEL[e] = EL[((size_t)sq * 64 + (e >> 7)) * 512 + hd * 128 + (e & 127)]; }
        swrite();
        __syncthreads();
        for (int stp = 0; stp < 64; ++stp) {
            const int ch = dir ? 63 - stp : stp;
            if (stp + 1 < 64) gload(dir ? ch - 1 : ch + 1);
            __builtin_amdgcn_sched_barrier(0);
            if (wid < 4) {
                const int a = wid >> 1, b = wid & 1;
                bf16x8 kf[8], qf[8];
#pragma unroll
                for (int s8 = 0; s8 < 8; ++s8) { kf[s8] = *(const bf16x8*)(sKI + (32 * a + r) * 136 + 16 * s8 + 8 * h); qf[s8] = *(const bf16x8*)(sQD + (32 * b + r) * 136 + 16 * s8 + 8 * h); }
                f32x16 at0, at1;
#pragma unroll
                for (int i = 0; i < 16; ++i) { at0[i] = 0.f; at1[i] = 0.f; }
#pragma unroll
                for (int s8 = 0; s8 < 8; s8 += 2) { at0 = MFMA32(kf[s8], qf[s8], at0); at1 = MFMA32(kf[s8 + 1], qf[s8 + 1], at1); }
                const int t = 32 * b + r;
#pragma unroll
                for (int i = 0; i < 16; ++i) {
                    const int s = 32 * a + (i & 3) + 8 * (i >> 2) + 4 * h;
                    const bool keep = dir ? (s > t) : (s <= t);
                    at0[i] = keep ? (at0[i] + at1[i]) : 0.f;
                }
#pragma unroll
                for (int s2 = 0; s2 < 2; ++s2) *(bf16x8*)(sAtt + ((a * 2 + b) * 2 + s2) * 512 + lane * 8) = pack8(at0, s2);
            }
            __builtin_amdgcn_sched_barrier(0);
            f32x16 o0, o1;
#pragma unroll
            for (int i = 0; i < 16; ++i) { o0[i] = 0.f; o1[i] = 0.f; }
#pragma unroll
            for (int d4 = 0; d4 < 4; ++d4)
#pragma unroll
                for (int s2 = 0; s2 < 2; ++s2) {
                    const bf16x8 ps = pack8(S[d4], s2);
                    const bf16_t* qb = sQD + r * 136 + 32 * d4 + 16 * s2 + 4 * h;
                    const bf16x8 q0 = cat44(*(const s16x4*)qb, *(const s16x4*)(qb + 8));
                    const bf16x8 q1 = cat44(*(const s16x4*)(qb + 32 * 136), *(const s16x4*)(qb + 32 * 136 + 8));
                    o0 = MFMA32(ps, q0, o0);
                    o1 = MFMA32(ps, q1, o1);
                }
            __syncthreads();
#pragma unroll
            for (int a = 0; a < 2; ++a)
#pragma unroll
                for (int s2 = 0; s2 < 2; ++s2) {
                    const bf16_t* vb = sVt + (dvs + r) * 72 + 32 * a + 16 * s2 + 4 * h;
                    const bf16x8 va = cat44(*(const s16x4*)vb, *(const s16x4*)(vb + 8));
                    const bf16x8 p0 = *(const bf16x8*)(sAtt + ((a * 2 + 0) * 2 + s2) * 512 + lane * 8);
                    const bf16x8 p1 = *(const bf16x8*)(sAtt + ((a * 2 + 1) * 2 + s2) * 512 + lane * 8);
                    o0 = MFMA32(va, p0, o0);
                    o1 = MFMA32(va, p1, o1);
                }
#pragma unroll
            for (int g = 0; g < 4; ++g) {
                f32x4 v0 = {o0[4 * g], o0[4 * g + 1], o0[4 * g + 2], o0[4 * g + 3]};
                f32x4 v1 = {o1[4 * g], o1[4 * g + 1], o1[4 * g + 2], o1[4 * g + 3]};
                st_bf4(sOut + r * 264 + dvs + 8 * g + 4 * h, v0);
                st_bf4(sOut + (32 + r) * 264 + dvs + 8 * g + 4 * h, v1);
            }
            __builtin_amdgcn_sched_barrier(0);
#pragma unroll
            for (int d4 = 0; d4 < 4; ++d4) {
#pragma unroll
                for (int s4 = 0; s4 < 4; ++s4) {
                    const bf16x8 ka = cat44(tr_read(trb + (16 * s4) * 136 + 32 * d4), tr_read(trb + (16 * s4 + 4) * 136 + 32 * d4));
                    const bf16x8 vb = *(const bf16x8*)(sVt + (dvs + r) * 72 + 16 * s4 + 8 * h);
                    S[d4] = MFMA32(ka, vb, S[d4]);
                }
            }
#pragma unroll
            for (int d4 = 0; d4 < 4; ++d4)
#pragma unroll
                for (int g = 0; g < 4; ++g) {
                    const f32x4 e4 = *(const f32x4*)(sEL + ch * 128 + 32 * d4 + 8 * g + 4 * h);
                    S[d4][4 * g] *= e4[0]; S[d4][4 * g + 1] *= e4[1]; S[d4][4 * g + 2] *= e4[2]; S[d4][4 * g + 3] *= e4[3];
                }
            __syncthreads();
            {
                const size_t tbase = (size_t)sq * SEQ + ch * 64;
#pragma unroll
                for (int q = 0; q < 4; ++q) { const int c2 = tid + NTHR * q, row = c2 >> 5, cc = c2 & 31;
                    *(u32x4*)(od + (tbase + row) * 1024 + hd * 256 + cc * 8) = *(const u32x4*)(sOut + row * 264 + cc * 8); }
            }
            if (stp + 1 < 64) swrite();
            __syncthreads();
        }
    }
}

DI void phase_combine(const Params& p) {
    const bf16_t* of = (const bf16_t*)p.out; const bf16_t* ob = of + (size_t)T_TOK * 1024;
    const bf16_t* G1 = (const bf16_t*)(p.ws + WS_A3);
    bf16_t* og = (bf16_t*)(p.ws + WS_A2);
    const int tid = opq_tid(), lane = tid & 63, wid = tid >> 6;
    f32x4 hn[4];
#pragma unroll
    for (int j = 0; j < 4; ++j) hn[j] = *(const f32x4*)(p.hnorm + lane * 16 + j * 4);
    const int rstride = gridDim.x * 8;
    for (int row0 = blockIdx.x * 8 + wid; row0 < T_TOK; row0 += 2 * rstride) {
        u32x4 a[2][2], b[2][2], gt[2][2];
#pragma unroll
        for (int k = 0; k < 2; ++k) { const int row = (row0 + k * rstride < T_TOK) ? row0 + k * rstride : row0; const size_t base = (size_t)row * 1024 + lane * 16;
#pragma unroll
            for (int q = 0; q < 2; ++q) { a[k][q] = *(const u32x4*)(of + base + q * 8); b[k][q] = *(const u32x4*)(ob + base + q * 8); gt[k][q] = *(const u32x4*)(G1 + base + q * 8); } }
        asm volatile("" : "+v"(a[0][0]), "+v"(a[0][1]), "+v"(a[1][0]), "+v"(a[1][1]), "+v"(b[0][0]), "+v"(b[0][1]), "+v"(b[1][0]), "+v"(b[1][1]), "+v"(gt[0][0]), "+v"(gt[0][1]), "+v"(gt[1][0]), "+v"(gt[1][1]));
#pragma unroll
        for (int k = 0; k < 2; ++k) {
            const int row = row0 + k * rstride;
            if (row < T_TOK) {
                const size_t base = (size_t)row * 1024 + lane * 16;
                float v[16]; float ss = 0.f;
#pragma unroll
                for (int q = 0; q < 2; ++q)
#pragma unroll
                    for (int j = 0; j < 4; ++j) { v[q * 8 + 2 * j] = bf_lo(a[k][q][j]) + bf_lo(b[k][q][j]); v[q * 8 + 2 * j + 1] = bf_hi(a[k][q][j]) + bf_hi(b[k][q][j]); }
#pragma unroll
                for (int j = 0; j < 16; ++j) ss += v[j] * v[j];
#pragma unroll
                for (int o = 1; o < 16; o <<= 1) ss += __shfl_xor(ss, o);
                const float rstd = rsqrtf(ss * (1.0f / 256.0f) + 1e-6f);
#pragma unroll
                for (int q = 0; q < 2; ++q) {
                    const f32x4 h0 = hn[2 * q], h1 = hn[2 * q + 1];
                    const u32x4 g4 = gt[k][q];
                    u32x4 o;
                    o[0] = pk2(v[q * 8 + 0] * rstd * h0[0] * silu(bf_lo(g4[0])), v[q * 8 + 1] * rstd * h0[1] * silu(bf_hi(g4[0])));
                    o[1] = pk2(v[q * 8 + 2] * rstd * h0[2] * silu(bf_lo(g4[1])), v[q * 8 + 3] * rstd * h0[3] * silu(bf_hi(g4[1])));
                    o[2] = pk2(v[q * 8 + 4] * rstd * h1[0] * silu(bf_lo(g4[2])), v[q * 8 + 5] * rstd * h1[1] * silu(bf_hi(g4[2])));
                    o[3] = pk2(v[q * 8 + 6] * rstd * h1[2] * silu(bf_lo(g4[3])), v[q * 8 + 7] * rstd * h1[3] * silu(bf_hi(g4[3])));
                    *(u32x4*)(og + base + q * 8) = o;
                }
            }
        }
    }
}

#define XB_TMO      128
#define XB_XCNT(j)  (256  + 64 * (j))
#define XB_XSUB(j)  (1280 + 64 * (j))
#define XB_XGEN(j)  (2304 + 64 * (j))
#define XB_TOP      3328
#define XB_TOPGEN   3392
#define XCD_BAR_WORDS 3456
#define XB_SPIN_CAP (1u << 18)
#define LAS __attribute__((address_space(3)))

__device__ __forceinline__ unsigned xb_ld(unsigned* p)              { return __hip_atomic_load(p, __ATOMIC_RELAXED, __HIP_MEMORY_SCOPE_AGENT); }
__device__ __forceinline__ unsigned xb_add(unsigned* p, unsigned v) { return __hip_atomic_fetch_add(p, v, __ATOMIC_RELAXED, __HIP_MEMORY_SCOPE_AGENT); }
__device__ __forceinline__ unsigned xb_xcc_id() { return (unsigned)__builtin_amdgcn_s_getreg((3 << 11) | 20) & 0xFu; }
#define XB_SPIN(cond, bar) do { unsigned _sp = 0; while (cond) { __builtin_amdgcn_s_sleep(1); \
    if ((++_sp & 255u) == 0u) { if (xb_ld(&(bar)[XB_TMO])) break; if (_sp > XB_SPIN_CAP) { atomicAdd(&(bar)[XB_TMO], 1u); break; } } } } while (0)

struct XcdBarrier {
    unsigned* bar; unsigned x;
    volatile LAS unsigned* st;
};

__device__ __forceinline__ XcdBarrier xcd_barrier_post(unsigned* bar, volatile LAS unsigned* st) {
    XcdBarrier b; b.bar = bar; b.x = xb_xcc_id(); b.st = st;
    if (threadIdx.x == 0) (void)xb_add(&bar[XB_XCNT(b.x)], 1u);
    return b;
}
__device__ __forceinline__ void xcd_barrier_complete(unsigned* bar, unsigned x, unsigned& nloc, unsigned& nx) {
    const unsigned G = gridDim.x * gridDim.y * gridDim.z;
    unsigned sum, cnt, mine, sp = 0u;
    for (;;) {
        sum = 0u; cnt = 0u; mine = 0u;
#pragma unroll
        for (unsigned j = 0; j < 16; ++j) { const unsigned c = xb_ld(&bar[XB_XCNT(j)]); sum += c; cnt += (c > 0u) ? 1u : 0u; mine = (j == x) ? c : mine; }
        if (sum == G) break;
        __builtin_amdgcn_s_sleep(1);
        if ((++sp & 255u) == 0u) { if (xb_ld(&bar[XB_TMO])) break; if (sp > XB_SPIN_CAP) { atomicAdd(&bar[XB_TMO], 1u); break; } }
    }
    nloc = mine > 0u ? mine : 1u; nx = cnt > 0u ? cnt : 1u;
}

__device__ __forceinline__ void xcd_barrier(const XcdBarrier& b) {
    asm volatile("s_waitcnt vmcnt(0)" ::: "memory");
    __syncthreads();
    if (threadIdx.x == 0) {
        unsigned* bar = b.bar;
        __builtin_amdgcn_s_waitcnt(0);
        unsigned nloc = b.st[0], nx = b.st[1];
        if (nloc == 0u) { xcd_barrier_complete(bar, b.x, nloc, nx); b.st[0] = nloc; b.st[1] = nx; }
        const unsigned old = xb_add(&bar[XB_XSUB(b.x)], 1u);
        const unsigned gen = old / nloc;
        if (old + 1u == (gen + 1u) * nloc) {
            __builtin_amdgcn_fence(__ATOMIC_RELEASE, "agent");
            asm volatile("s_waitcnt vmcnt(0)" ::: "memory");
            const unsigned og = xb_add(&bar[XB_TOP], 1u);
            const unsigned tg = og / nx;
            if (og + 1u == (tg + 1u) * nx) xb_add(&bar[XB_TOPGEN], 1u);
            else XB_SPIN(xb_ld(&bar[XB_TOPGEN]) == tg, bar);
            __builtin_amdgcn_fence(__ATOMIC_ACQUIRE, "agent");
            xb_add(&bar[XB_XGEN(b.x)], 1u);
            asm volatile("s_waitcnt vmcnt(0)" ::: "memory");
        } else {
            XB_SPIN(xb_ld(&bar[XB_XGEN(b.x)]) == gen, bar);
            __builtin_amdgcn_fence(__ATOMIC_ACQUIRE, "agent");
            asm volatile("s_waitcnt vmcnt(0)" ::: "memory");
        }
    }
    __syncthreads();
}


__global__ void __launch_bounds__(NTHR) fwd_megakernel(Params p) {
    extern __shared__ __attribute__((aligned(16))) unsigned char smem[];
    cg::grid_group grid = cg::this_grid();
    volatile LAS unsigned* xst = (volatile LAS unsigned*)(smem + 147456);
    if (threadIdx.x < 4) xst[threadIdx.x] = 0u;
    __syncthreads();
    phase_convert(p, smem);      grid.sync();
    const XcdBarrier xb = xcd_barrier_post((unsigned*)(p.ws + WS_XBAR), xst);
    phase_in0(p, smem);          xcd_barrier(xb);
    phase_attn(p, smem);         xcd_barrier(xb);
    phase_out_ln<false>(p, smem); xcd_barrier(xb);
    phase_in1(p, smem);          xcd_barrier(xb);
    phase_gates(p, smem);        xcd_barrier(xb);
    phase_gla(p, smem);          xcd_barrier(xb);
    phase_combine(p);            xcd_barrier(xb);
    phase_out_ln<true>(p, smem);
}

extern "C" void kernel_launch(void* const* d_in, const int* in_sizes, int n_in, void* d_out, int out_size, void* d_ws, size_t ws_size, hipStream_t stream) {
    static int grid_blocks = 0;
    if (!grid_blocks) {
        int dev = 0, cus = 0, per_cu = 0;
        hipGetDevice(&dev);
        hipDeviceGetAttribute(&cus, hipDeviceAttributeMultiprocessorCount, dev);
        hipFuncSetAttribute((const void*)fwd_megakernel, hipFuncAttributeMaxDynamicSharedMemorySize, LDS_BYTES);
        hipOccupancyMaxActiveBlocksPerMultiprocessor(&per_cu, (const void*)fwd_megakernel, NTHR, LDS_BYTES);
        if (per_cu < 1) { fprintf(stderr, "occupancy query says %d blocks/CU\n", per_cu); per_cu = 1; }
        grid_blocks = cus * per_cu;
        if (ws_size < WS_A5 + 16 * MiB) fprintf(stderr, "workspace too small: %zu\n", ws_size);
    }
    Params p{};
    p.xp = (const float*)d_in[0]; p.xs = (const float*)d_in[1]; p.w0in = (const float*)d_in[2]; p.sink = (const float*)d_in[3];
    p.w0out = (const float*)d_in[4]; p.ln0g = (const float*)d_in[5]; p.ln0b = (const float*)d_in[6]; p.w1in = (const float*)d_in[7];
    p.wgf = (const float*)d_in[8]; p.bgf = (const float*)d_in[9]; p.wgb = (const float*)d_in[10]; p.bgb = (const float*)d_in[11];
    p.hnorm = (const float*)d_in[12]; p.w1out = (const float*)d_in[13]; p.ln1g = (const float*)d_in[14]; p.ln1b = (const float*)d_in[15];
    p.out = (float*)d_out; p.ws = (unsigned char*)d_ws;
    void* args[] = {&p};
    hipError_t e = hipLaunchCooperativeKernel((const void*)fwd_megakernel, dim3(grid_blocks), dim3(NTHR), args, LDS_BYTES, stream);
    if (e != hipSuccess) fprintf(stderr, "cooperative launch failed: %s (grid %d)\n", hipGetErrorString(e), grid_blocks);
}
```

```cpp
#include <hip/hip_runtime.h>
#include <hip/hip_cooperative_groups.h>
#include <cstdio>
#include <type_traits>
namespace cg = cooperative_groups;

typedef unsigned short bf16_t;
typedef short bf16x8 __attribute__((ext_vector_type(8)));
typedef short s16x4 __attribute__((ext_vector_type(4)));
typedef float f32x16 __attribute__((ext_vector_type(16)));
typedef float f32x4 __attribute__((ext_vector_type(4)));
typedef float f32x2 __attribute__((ext_vector_type(2)));
typedef unsigned u32x4 __attribute__((ext_vector_type(4)));
typedef unsigned u32x2 __attribute__((ext_vector_type(2)));
typedef __bf16 bfv2 __attribute__((ext_vector_type(2)));
#define DI __device__ __forceinline__
#define MFMA32(a, b, c) __builtin_amdgcn_mfma_f32_32x32x16_bf16((a), (b), (c), 0, 0, 0)

constexpr int T_TOK = 98304, TP = 32768, SEQ = 4096, NSEQ = 24, D = 1024;
constexpr int NTHR = 512;
constexpr size_t MiB = 1048576;
constexpr size_t RB = 192 * MiB;
constexpr int LDS_BYTES = 147456 + 16;
constexpr float LOG2E = 1.4426950408889634f;
constexpr float DN_ALPHA = 1.4142135623730951f;

struct Params {
    const float *xp, *xs, *w0in, *sink, *w0out, *ln0g, *ln0b, *w1in, *wgf, *bgf, *wgb, *bgb, *hnorm, *w1out, *ln1g, *ln1b;
    float* out;
    unsigned char* ws;
};

DI unsigned pk2(float a, float b) { f32x2 v = {a, b}; bfv2 r = __builtin_convertvector(v, bfv2); return __builtin_bit_cast(unsigned, r); }
DI float bf_lo(unsigned u) { return __uint_as_float(u << 16); }
DI float bf_hi(unsigned u) { return __uint_as_float(u & 0xffff0000u); }
DI float bf2f(bf16_t v) { return __uint_as_float(((unsigned)v) << 16); }
DI bf16_t f2bf(float a) { return (bf16_t)(pk2(a, 0.f) & 0xffffu); }
DI bf16x8 pack8(const f32x16& x, int s) {
    u32x4 p = {pk2(x[8 * s], x[8 * s + 1]), pk2(x[8 * s + 2], x[8 * s + 3]), pk2(x[8 * s + 4], x[8 * s + 5]), pk2(x[8 * s + 6], x[8 * s + 7])};
    return __builtin_bit_cast(bf16x8, p);
}
DI bf16x8 cat44(s16x4 lo, s16x4 hi) { return __builtin_shufflevector(lo, hi, 0, 1, 2, 3, 4, 5, 6, 7); }
DI int opq_tid() { int t = threadIdx.x; asm volatile("" : "+v"(t)); return t; }
DI float silu(float x) { return x * __builtin_amdgcn_rcpf(1.0f + __builtin_amdgcn_exp2f(-1.4426950408889634f * x)); }
DI const float* xrow(const Params& p, int t) { return t < TP ? p.xp + (size_t)t * D : p.xs + (size_t)(t - TP) * D; }

constexpr size_t WS_WT0IN = 0, WS_WT0OUT = WS_WT0IN + 2560 * 1024 * 2, WS_WT1IN = WS_WT0OUT + 1024 * 1024 * 2, WS_WT1OUT = WS_WT1IN + 3104 * 1024 * 2;
constexpr size_t WS_A0 = 16 * MiB, WS_A1 = WS_A0 + RB, WS_A2 = WS_A1 + RB, WS_A3 = WS_A2 + RB, WS_A4 = WS_A3 + RB, WS_A5 = WS_A4 + RB;
constexpr size_t WS_K0 = WS_A3, WS_V0T = WS_A3 + 48 * MiB;
constexpr size_t WS_ELF = WS_A5, WS_ELB = WS_A5 + 1536 * 512 * 4;
constexpr size_t WS_STAT0 = WS_A5 + 6 * MiB, WS_STAT1 = WS_STAT0 + 3 * MiB, WS_CNT = WS_STAT1 + 3 * MiB, WS_XBAR = WS_CNT + 4096;

DI void phase_convert(const Params& p, unsigned char* smem) {
    bf16_t* xb = (bf16_t*)(p.ws + WS_A0);
    const int tid = opq_tid();
    const size_t n8 = (size_t)T_TOK * D / 8;
    const size_t stride = (size_t)gridDim.x * NTHR;
    size_t i = (size_t)blockIdx.x * NTHR + tid;
    for (; i + 3 * stride < n8; i += 4 * stride) {
        f32x4 a[4], b[4];
#pragma unroll
        for (int q = 0; q < 4; ++q) { const size_t e = (i + q * stride) * 8; const float* src = xrow(p, (int)(e >> 10)) + (e & 1023); a[q] = *(const f32x4*)src; b[q] = *(const f32x4*)(src + 4); }
        asm volatile("" : "+v"(a[0]), "+v"(a[1]), "+v"(a[2]), "+v"(a[3]), "+v"(b[0]), "+v"(b[1]), "+v"(b[2]), "+v"(b[3]));
#pragma unroll
        for (int q = 0; q < 4; ++q) { u32x4 o = {pk2(a[q][0], a[q][1]), pk2(a[q][2], a[q][3]), pk2(b[q][0], b[q][1]), pk2(b[q][2], b[q][3])}; *(u32x4*)(xb + (i + q * stride) * 8) = o; }
    }
    for (; i < n8; i += stride) {
        const size_t e = i * 8; const int t = (int)(e >> 10);
        const float* src = xrow(p, t) + (e & 1023);
        const f32x4 a = *(const f32x4*)src, b = *(const f32x4*)(src + 4);
        u32x4 o = {pk2(a[0], a[1]), pk2(a[2], a[3]), pk2(b[0], b[1]), pk2(b[2], b[3])};
        *(u32x4*)(xb + e) = o;
    }
    if (blockIdx.x == 0) { for (int i = tid; i < 768; i += NTHR) ((unsigned*)(p.ws + WS_CNT))[i] = 0u;
        for (int i = tid; i < 3456; i += NTHR) ((unsigned*)(p.ws + WS_XBAR))[i] = 0u; }
    float* tile = (float*)smem;
    auto decode = [&](int u, const float*& W, bf16_t*& Wt, int& N, int& nt, int& kt) {
        int v = u;
        if (v < 1280) { W = p.w0in; Wt = (bf16_t*)(p.ws + WS_WT0IN); N = 2560; }
        else if ((v -= 1280) < 512) { W = p.w0out; Wt = (bf16_t*)(p.ws + WS_WT0OUT); N = 1024; }
        else if ((v -= 512) < 1552) { W = p.w1in; Wt = (bf16_t*)(p.ws + WS_WT1IN); N = 3104; }
        else { v -= 1552; W = p.w1out; Wt = (bf16_t*)(p.ws + WS_WT1OUT); N = 1024; }
        const int nn32 = N / 32; nt = v % nn32; kt = v / nn32;
    };
    auto loadu = [&](int u, float (&wv)[4]) {
        const float* W; bf16_t* Wt; int N, nt, kt; decode(u, W, Wt, N, nt, kt);
#pragma unroll
        for (int q = 0; q < 4; ++q) { const int e = tid + NTHR * q, kk = e >> 5, nn = e & 31; wv[q] = W[(size_t)(kt * 64 + kk) * N + nt * 32 + nn]; }
    };
    float wcur[4], wnxt[4];
    if ((int)blockIdx.x < 3856) loadu(blockIdx.x, wcur);
    for (int u = blockIdx.x; u < 3856; u += gridDim.x) {
        const float* W; bf16_t* Wt; int N, nt, kt; decode(u, W, Wt, N, nt, kt);
        const int un = u + gridDim.x;
        loadu(un < 3856 ? un : u, wnxt);
#pragma unroll
        for (int q = 0; q < 4; ++q) { const int e = tid + NTHR * q, kk = e >> 5, nn = e & 31; tile[kk * 33 + nn] = wcur[q]; }
        __syncthreads();
#pragma unroll
        for (int q = 0; q < 2; ++q) { const int e = tid + NTHR * q, nn = e >> 5, kp = e & 31;
            *(unsigned*)(Wt + (size_t)(nt * 32 + nn) * 1024 + kt * 64 + 2 * kp) = pk2(tile[(2 * kp) * 33 + nn], tile[(2 * kp + 1) * 33 + nn]); }
        __syncthreads();
#pragma unroll
        for (int q = 0; q < 4; ++q) wcur[q] = wnxt[q];
    }
}

DI void gemm_kloop(const bf16_t* __restrict__ P, const bf16_t* __restrict__ Q, const bf16_t* __restrict__ nP, const bf16_t* __restrict__ nQ, bool first,
                   unsigned char* smem, f32x16 (&acc)[4][2], u32x4 (&rp)[4], u32x4 (&rq)[4], int tid) {
    const int lane = tid & 63, wid = tid >> 6, wi = wid >> 2, wj = wid & 3, r = lane & 31, h = lane >> 5;
    const int crow = tid >> 3, ccol = (tid & 7) * 8;
#pragma unroll
    for (int a = 0; a < 4; ++a)
#pragma unroll
        for (int b = 0; b < 2; ++b)
#pragma unroll
            for (int i = 0; i < 16; ++i) acc[a][b][i] = 0.f;
    const unsigned char* Pb = (const unsigned char*)P;
    const unsigned char* Qb = (const unsigned char*)Q;
    const unsigned char* nPb = (const unsigned char*)nP;
    const unsigned char* nQb = (const unsigned char*)nQ;
    const unsigned voff = (unsigned)(crow * 1024 + ccol) * 2u;
    unsigned char* sw = smem + (crow * 72 + ccol) * 2;
    if (first) {
#pragma unroll
        for (int u = 0; u < 4; ++u) { rp[u] = *(const u32x4*)(Pb + (size_t)u * 131072 + voff); rq[u] = *(const u32x4*)(Qb + (size_t)u * 131072 + voff); }
    }
#pragma unroll
    for (int u = 0; u < 4; ++u) { *(u32x4*)(sw + u * 64 * 144) = rp[u]; *(u32x4*)(sw + 36864 + u * 64 * 144) = rq[u]; }
#pragma unroll
    for (int u = 0; u < 4; ++u) { rp[u] = *(const u32x4*)(Pb + (size_t)u * 131072 + 128 + voff); rq[u] = *(const u32x4*)(Qb + (size_t)u * 131072 + 128 + voff); }
    __syncthreads();
    const unsigned char* fpb = smem + ((wi * 128 + r) * 72 + h * 8) * 2;
    const unsigned char* fqb = smem + 36864 + ((wj * 64 + r) * 72 + h * 8) * 2;
    for (int kt = 0; kt < 16; ++kt) {
        const int cur = kt & 1;
        const unsigned char* bp = fpb + cur * 73728;
        const unsigned char* bq = fqb + cur * 73728;
        unsigned char* d = sw + (cur ^ 1) * 73728;
        const unsigned char* Pk = (kt + 2 < 16) ? Pb + (kt + 2) * 128 : nPb;
        const unsigned char* Qk = (kt + 2 < 16) ? Qb + (kt + 2) * 128 : nQb;
        const bool stage = kt + 1 < 16;
        bf16x8 fp[2][4], fq[2][2];
#pragma unroll
        for (int a = 0; a < 4; ++a) fp[0][a] = *(const bf16x8*)(bp + a * 32 * 144);
#pragma unroll
        for (int b = 0; b < 2; ++b) fq[0][b] = *(const bf16x8*)(bq + b * 32 * 144);
        __builtin_amdgcn_sched_barrier(0);
#pragma unroll
        for (int s = 0; s < 4; ++s) {
            if (s < 3) {
#pragma unroll
                for (int a = 0; a < 4; ++a) fp[(s + 1) & 1][a] = *(const bf16x8*)(bp + a * 32 * 144 + (s + 1) * 32);
#pragma unroll
                for (int b = 0; b < 2; ++b) fq[(s + 1) & 1][b] = *(const bf16x8*)(bq + b * 32 * 144 + (s + 1) * 32);
            }
            if (stage) {
                *(u32x4*)(d + s * 64 * 144) = rp[s];
                *(u32x4*)(d + 36864 + s * 64 * 144) = rq[s];
                rp[s] = *(const u32x4*)(Pk + (size_t)s * 131072 + voff);
                rq[s] = *(const u32x4*)(Qk + (size_t)s * 131072 + voff);
            }
#pragma unroll
            for (int a = 0; a < 4; ++a)
#pragma unroll
                for (int b = 0; b < 2; ++b) acc[a][b] = MFMA32(fp[s & 1][a], fq[s & 1][b], acc[a][b]);
            __builtin_amdgcn_sched_barrier(0);
        }
        __syncthreads();
    }
}

template <class TF, class ST> DI void gemm_tile_bf16(const bf16_t* __restrict__ P, const bf16_t* __restrict__ Q, const bf16_t* __restrict__ nP, const bf16_t* __restrict__ nQ, bool first,
                                                 u32x4 (&rp)[4], u32x4 (&rq)[4], unsigned char* smem, TF tf, ST st) {
    const int tid = opq_tid(), lane = tid & 63, wid = tid >> 6, wi = wid >> 2, wj = wid & 3, r = lane & 31, h = lane >> 5;
    f32x16 acc[4][2];
    gemm_kloop(P, Q, nP, nQ, first, smem, acc, rp, rq, tid);
#pragma unroll
    for (int a = 0; a < 4; ++a)
#pragma unroll
        for (int b = 0; b < 2; ++b)
#pragma unroll
            for (int g = 0; g < 4; ++g) {
                const int i0 = wi * 128 + a * 32 + 8 * g + 4 * h, j = wj * 64 + b * 32 + r;
                f32x4 v = {acc[a][b][4 * g], acc[a][b][4 * g + 1], acc[a][b][4 * g + 2], acc[a][b][4 * g + 3]};
                v = tf(v, i0, j);
                u32x2 o = {pk2(v[0], v[1]), pk2(v[2], v[3])};
                *(u32x2*)(smem + j * 528 + i0 * 2) = o;
            }
    __syncthreads();
#pragma unroll 4
    for (int q = 0; q < 16; ++q) {
        const int c = tid + NTHR * q, j = c >> 5, ch = c & 31;
        const u32x4 w = *(const u32x4*)(smem + j * 528 + ch * 16);
        st(j, ch * 8, w);
    }
    __syncthreads();
}

DI bool gemm_unit(int it, int nN, int& pm, int& nt) {
    const int G = gridDim.x;
    if ((G & 7) == 0) {
        const int xcd = blockIdx.x & 7, l = blockIdx.x >> 3, per = G >> 3;
        const int u = it * per + l;
        if (u >= 48 * nN) return false;
        pm = (u / nN) * 8 + xcd; nt = u % nN; return true;
    } else {
        const int u = it * G + blockIdx.x;
        if (u >= 384 * nN) return false;
        pm = u / nN; nt = u % nN; return true;
    }
}

DI size_t qk_off(int sq, int hd, int ch) { return ((size_t)((sq * 4 + hd) * 64 + ch)) * 16384; }
DI size_t v1_off(int sq, int hd, int ch) { return ((size_t)((sq * 4 + hd) * 64 + ch)) * 16384; }
DI void st_bf4(bf16_t* dst, f32x4 v) { u32x2 o = {pk2(v[0], v[1]), pk2(v[2], v[3])}; *(u32x2*)dst = o; }

namespace pg8 {
#define PG8_LAS __attribute__((address_space(3)))
typedef unsigned short bf16_t;
typedef short bf16x8 __attribute__((ext_vector_type(8)));
typedef float f32x4 __attribute__((ext_vector_type(4)));
typedef unsigned u32x4 __attribute__((ext_vector_type(4)));
constexpr int BM = 256, BK = 64, HALF = 128, HTB = HALF * BK * 2  , STAGE_BYTES = 8 * HTB, NXCD = 8, WGM = 8;

__host__ __device__ __forceinline__ int lds_byte(int r, int c) { const int st = (r >> 4) * 2 + (c >> 5), rr = r & 15, cc = c & 31, ob = rr * 64 + cc * 2; return st * 1024 + (ob ^ (((ob >> 9) & 1) << 5)); }
__host__ __device__ __forceinline__ void stage_rc(int b, int& R, int& C) { const int st = b / 1024, sb = b % 1024, swz = sb ^ (((sb >> 9) & 1) << 5); R = (st >> 1) * 16 + swz / 64; C = (st & 1) * 32 + (swz % 64) / 2; }
__host__ __device__ __forceinline__ int perm32(int rho) { const int n = rho >> 4, i = rho & 15; return 8 * (i >> 2) + 4 * n + (i & 3); }

struct Unit { int pm, pn; };
struct Gemm { const bf16_t* A; const bf16_t* Bt; int M, N, K; };

struct StaticOrder {
    int nM, nN, nwg, G, c;
    __host__ __device__ void init(int M, int N, int G_, int c_) { nM = M / BM; nN = N / BM; nwg = nM * nN; G = G_; c = c_; }
    __host__ __device__ bool next(int i, Unit& u) const {
        const long L = (long)i * G + c; if (L >= nwg) return false;
        int wgid = (int)L; { const int q = nwg / NXCD, r = nwg % NXCD, xcd = wgid % NXCD, off = wgid / NXCD; wgid = (xcd < r ? xcd * (q + 1) : r * (q + 1) + (xcd - r) * q) + off; }
        const int nig = WGM * nN, gid = wgid / nig, fm = gid * WGM, gsz = (nM - fm) < WGM ? (nM - fm) : WGM;
        u.pm = fm + ((wgid % nig) % gsz); u.pn = (wgid % nig) / gsz; return true;
    }
    __device__ __forceinline__ void a_ready(const Unit&) const {}
    __device__ __forceinline__ void done(const Unit&) const {}
};
struct CountedOrder : StaticOrder {
    const unsigned* ready; unsigned need; unsigned* tmo;
    __device__ __forceinline__ void a_ready(const Unit& u) const {
        if (threadIdx.x < 64) {
            const unsigned long long t0 = __builtin_amdgcn_s_memrealtime(); unsigned polls = 0;
            while ((unsigned)__builtin_amdgcn_readfirstlane(__hip_atomic_load(ready + 64 * u.pm, __ATOMIC_RELAXED, __HIP_MEMORY_SCOPE_AGENT)) < need) {
                if ((++polls & 255u) == 0u && __builtin_amdgcn_readfirstlane(__hip_atomic_load(tmo, __ATOMIC_RELAXED, __HIP_MEMORY_SCOPE_AGENT)) != 0u) break;
                if (__builtin_amdgcn_s_memrealtime() - t0 > 2000000ull) {
                    if (threadIdx.x == 0) { unsigned expect = 0u; __hip_atomic_compare_exchange_strong(tmo + 1, &expect, 0x600u | (unsigned)(u.pm & 0xff), __ATOMIC_RELAXED, __ATOMIC_RELAXED, __HIP_MEMORY_SCOPE_AGENT); __hip_atomic_store(tmo, 1u, __ATOMIC_RELAXED, __HIP_MEMORY_SCOPE_AGENT); }
                    break; }
                __builtin_amdgcn_s_sleep(2); }
            __builtin_amdgcn_fence(__ATOMIC_ACQUIRE, "agent");
            asm volatile("s_waitcnt vmcnt(0)" ::: "memory");
        }
#if !defined(BROKEN_HOOK_NO_BARRIER)
        asm volatile("" ::: "memory"); __builtin_amdgcn_s_barrier(); asm volatile("" ::: "memory");
#endif
    }
};

__device__ __forceinline__ unsigned cvt_pk_bf16(float lo, float hi) { unsigned r; asm volatile("v_cvt_pk_bf16_f32 %0, %1, %2" : "=v"(r) : "v"(lo), "v"(hi)); return r; }
typedef float f32x2 __attribute__((ext_vector_type(2)));
__device__ __forceinline__ f32x2 gelu_pk(f32x2 v) {
    const f32x2 av = __builtin_elementwise_abs(v), d = av * 0.2316418882f + 1.0f;
    f32x2 t; t.x = __builtin_amdgcn_rcpf(d.x); t.y = __builtin_amdgcn_rcpf(d.y);
    f32x2 q = t * 0.5307027145f + (-0.7265760135f); q = q * t + 0.7107068705f; q = q * t + (-0.142248368f); q = q * t + 0.127414796f; q = q * t;
    const f32x2 s = (v * v) * (-0.72134752044f);
    f32x2 e; e.x = __builtin_amdgcn_exp2f(s.x); e.y = __builtin_amdgcn_exp2f(s.y);
    const f32x2 m = v * (q * e), r = v - m;
    f32x2 o; o.x = v.x < 0.f ? m.x : r.x; o.y = v.y < 0.f ? m.y : r.y; return o;
}

struct EpiF32 {
    static constexpr bool PERM = false, AFTER_DRAIN = false;
    float* C; int ldc; const float* bias;
    __device__ __forceinline__ void operator()(const f32x4 (&acc)[2][2][4][2], const Unit& u, int wr, int wc, int fr, int fq) const {
        const int row0 = u.pm * BM + wr * 64 + fr, col0 = u.pn * BM + wc * 32 + 4 * fq;
        f32x4 bv[2][2];
#pragma unroll
        for (int bj = 0; bj < 2; ++bj)
#pragma unroll
            for (int n = 0; n < 2; ++n) bv[bj][n] = bias ? *(const f32x4*)(bias + col0 + bj * HALF + n * 16) : (f32x4){0.f, 0.f, 0.f, 0.f};
#pragma unroll
        for (int ai = 0; ai < 2; ++ai)
#pragma unroll
            for (int m = 0; m < 4; ++m) { float* rowp = C + (size_t)(row0 + ai * HALF + m * 16) * ldc + col0;
#pragma unroll
                for (int bj = 0; bj < 2; ++bj)
#pragma unroll
                    for (int n = 0; n < 2; ++n) *(f32x4*)(rowp + bj * HALF + n * 16) = acc[ai][bj][m][n] + bv[bj][n]; }
    }
};
template <int ACT  > struct EpiBf16 {
    static constexpr bool PERM = true, AFTER_DRAIN = false;
    bf16_t* O; int ldc; const float* bias; int split_cols; size_t split_stride;
    __device__ __forceinline__ void operator()(const f32x4 (&acc)[2][2][4][2], const Unit& u, int wr, int wc, int fr, int fq) const {
        const int row0 = u.pm * BM + wr * 64 + fr; int colt = u.pn * BM; bf16_t* base = O;
        if (split_cols) { const int t = colt / split_cols; base += (size_t)t * split_stride; colt -= t * split_cols; }
        const int col0 = colt + wc * 32 + 8 * fq, bcol0 = u.pn * BM + wc * 32 + 8 * fq;
        f32x4 bv[2][2];
#pragma unroll
        for (int bj = 0; bj < 2; ++bj)
#pragma unroll
            for (int n = 0; n < 2; ++n) bv[bj][n] = bias ? *(const f32x4*)(bias + bcol0 + bj * HALF + 4 * n) : (f32x4){0.f, 0.f, 0.f, 0.f};
#pragma unroll
        for (int ai = 0; ai < 2; ++ai)
#pragma unroll
            for (int m = 0; m < 4; ++m) { bf16_t* rowp = base + (size_t)(row0 + ai * HALF + m * 16) * ldc + col0;
#pragma unroll
                for (int bj = 0; bj < 2; ++bj) { f32x4 v0 = acc[ai][bj][m][0] + bv[bj][0], v1 = acc[ai][bj][m][1] + bv[bj][1];
                    if (ACT == 1) { f32x2 a = gelu_pk((f32x2){v0[0], v0[1]}), b = gelu_pk((f32x2){v0[2], v0[3]}), c = gelu_pk((f32x2){v1[0], v1[1]}), d = gelu_pk((f32x2){v1[2], v1[3]});
                        v0 = (f32x4){a.x, a.y, b.x, b.y}; v1 = (f32x4){c.x, c.y, d.x, d.y}; }
                    if (ACT == 2) {
#pragma unroll
                        for (int j = 0; j < 4; ++j) { v0[j] = 0.5f * v0[j] * (1.0f + erff(v0[j] * 0.70710678f)); v1[j] = 0.5f * v1[j] * (1.0f + erff(v1[j] * 0.70710678f)); } }
                    u32x4 w; w.x = cvt_pk_bf16(v0[0], v0[1]); w.y = cvt_pk_bf16(v0[2], v0[3]); w.z = cvt_pk_bf16(v1[0], v1[1]); w.w = cvt_pk_bf16(v1[2], v1[3]);
                    *(u32x4*)(rowp + bj * HALF) = w; } }
    }
};

struct PanelStats {
    unsigned* xbuf;
    unsigned* cnt;
    unsigned* tmo;
    int ntn; float eps;
    unsigned code;
    __device__ __forceinline__ bool run(const f32x4 (&v)[2][2][4][2], const Unit& u, int wr, int wc, int fr, int fq, PG8_LAS unsigned char* lds, int wid, int lane) const {
        typedef float f32x2v __attribute__((ext_vector_type(2)));
        PG8_LAS f32x2v* P = (PG8_LAS f32x2v*)lds;
        PG8_LAS f32x2v* S = (PG8_LAS f32x2v*)(lds + 8192);
        PG8_LAS unsigned* flag = (PG8_LAS unsigned*)(lds + 8192 + 2048);
#pragma unroll
        for (int ai = 0; ai < 2; ++ai)
#pragma unroll
            for (int m = 0; m < 4; ++m) {
                float s = 0.f;
#pragma unroll
                for (int bj = 0; bj < 2; ++bj)
#pragma unroll
                    for (int n = 0; n < 2; ++n) { const f32x4 x = v[ai][bj][m][n]; s += (x[0] + x[1]) + (x[2] + x[3]); }
                s += __shfl_xor(s, 16); s += __shfl_xor(s, 32);
                const float mw = s * (1.0f / 64.0f); float q = 0.f;
#pragma unroll
                for (int bj = 0; bj < 2; ++bj)
#pragma unroll
                    for (int n = 0; n < 2; ++n) { const f32x4 d = v[ai][bj][m][n] - mw; q += (d[0] * d[0] + d[1] * d[1]) + (d[2] * d[2] + d[3] * d[3]); }
                q += __shfl_xor(q, 16); q += __shfl_xor(q, 32);
                if (fq == 0) P[(ai * HALF + wr * 64 + m * 16 + fr) * 4 + wc] = (f32x2v){mw, q};
            }
        asm volatile("s_waitcnt lgkmcnt(0)" ::: "memory"); __builtin_amdgcn_s_barrier(); asm volatile("" ::: "memory");
#if defined(BROKEN_NO_WAIT)
        if (blockIdx.x >= 64) { const long long t0 = clock64(); while (clock64() - t0 < 60000) __builtin_amdgcn_s_sleep(8); }
#endif
        const int row = wid * 32 + (lane & 31);
        if (lane < 32) {
            const f32x2v a = P[row * 4 + 0], b = P[row * 4 + 1], c = P[row * 4 + 2], d = P[row * 4 + 3];
            const float mt = (a.x + b.x + c.x + d.x) * 0.25f;
            const float da = a.x - mt, db = b.x - mt, dc = c.x - mt, dd = d.x - mt;
            const float m2 = (a.y + b.y) + (c.y + d.y) + 64.0f * ((da * da + db * db) + (dc * dc + dd * dd));
            unsigned long long* slot = (unsigned long long*)xbuf + ((size_t)(u.pm * BM + row) * 4 + u.pn);
            __hip_atomic_store(slot, ((unsigned long long)__float_as_uint(m2) << 32) | __float_as_uint(mt), __ATOMIC_RELAXED, __HIP_MEMORY_SCOPE_AGENT);
        }
        asm volatile("s_waitcnt vmcnt(0)" ::: "memory");
        if (lane == 0) __hip_atomic_fetch_add(cnt + 64 * u.pm, 1u, __ATOMIC_RELAXED, __HIP_MEMORY_SCOPE_AGENT);
        if (wid == 0) {
            bool dead = false; const unsigned long long t0 = __builtin_amdgcn_s_memrealtime(); const unsigned want = 8u * (unsigned)ntn;
            for (;;) {
#if defined(BROKEN_NO_WAIT)
                break;
#endif
                if ((unsigned)__builtin_amdgcn_readfirstlane(__hip_atomic_load(cnt + 64 * u.pm, __ATOMIC_RELAXED, __HIP_MEMORY_SCOPE_AGENT)) >= want) break;
                if (__builtin_amdgcn_s_memrealtime() - t0 > 2000000ull) {
                    if (lane == 0) { unsigned expect = 0u; __hip_atomic_compare_exchange_strong(tmo + 1, &expect, code | (unsigned)(u.pm & 0xff), __ATOMIC_RELAXED, __ATOMIC_RELAXED, __HIP_MEMORY_SCOPE_AGENT);
                                     __hip_atomic_store(tmo, 1u, __ATOMIC_RELAXED, __HIP_MEMORY_SCOPE_AGENT); }
                    dead = true; break; }
                __builtin_amdgcn_s_sleep(2);
            }
            __builtin_amdgcn_fence(__ATOMIC_ACQUIRE, "agent");
            if (lane == 0) flag[0] = dead ? 1u : 0u;
        }
        asm volatile("s_waitcnt vmcnt(0) lgkmcnt(0)" ::: "memory"); __builtin_amdgcn_s_barrier(); asm volatile("" ::: "memory");
        const bool bad = flag[0] != 0u;
        if (lane < 32) {
            const unsigned long long* slot = (const unsigned long long*)xbuf + (size_t)(u.pm * BM + row) * 4; float mt[4], m2[4]; float ms = 0.f;
#pragma unroll
            for (int t = 0; t < 4; ++t) { if (t < ntn) { const unsigned long long w = __hip_atomic_load(slot + t, __ATOMIC_RELAXED, __HIP_MEMORY_SCOPE_AGENT); mt[t] = __uint_as_float((unsigned)w); m2[t] = __uint_as_float((unsigned)(w >> 32)); } else { mt[t] = 0.f; m2[t] = 0.f; } ms += mt[t]; }
            const float mean = ms / (float)ntn; float q = 0.f;
#pragma unroll
            for (int t = 0; t < 4; ++t) if (t < ntn) { const float dm = mt[t] - mean; q += m2[t] + 256.0f * dm * dm; }
            S[row] = (f32x2v){mean, 1.0f / sqrtf(q / (256.0f * (float)ntn) + eps)};
        }
        asm volatile("s_waitcnt lgkmcnt(0)" ::: "memory"); __builtin_amdgcn_s_barrier(); asm volatile("" ::: "memory");
        return bad;
    }
};
struct EpiLnRes {
    static constexpr bool PERM = false, AFTER_DRAIN = true;
    const float* base; float* out; int ldc; const float* bias; PanelStats st; unsigned poison;
    __device__ __forceinline__ void refuse(size_t i0, size_t stride, int M, int N) const { const float q = __builtin_nanf(""); for (size_t i = i0; i < (size_t)M * N; i += stride) out[(i / N) * ldc + i % N] = q;
        if (i0 == 0) { unsigned expect = 0u; __hip_atomic_compare_exchange_strong(st.tmo + 1, &expect, 0x7f0u, __ATOMIC_RELAXED, __ATOMIC_RELAXED, __HIP_MEMORY_SCOPE_AGENT); __hip_atomic_store(st.tmo, 1u, __ATOMIC_RELAXED, __HIP_MEMORY_SCOPE_AGENT); } }
    __device__ __forceinline__ void fused(f32x4 (&acc)[2][2][4][2], const Unit& u, int wr, int wc, int fr, int fq, PG8_LAS unsigned char* lds, int wid, int lane) const {
        typedef float f32x2v __attribute__((ext_vector_type(2)));
        const PG8_LAS f32x2v* S = (const PG8_LAS f32x2v*)(lds + 8192);
        const int col0 = u.pn * BM + wc * 32 + 4 * fq;
#pragma unroll
        for (int bj = 0; bj < 2; ++bj)
#pragma unroll
            for (int n = 0; n < 2; ++n) { const f32x4 bv = bias ? *(const f32x4*)(bias + col0 + bj * HALF + n * 16) : (f32x4){0.f, 0.f, 0.f, 0.f};
#pragma unroll
                for (int ai = 0; ai < 2; ++ai)
#pragma unroll
                    for (int m = 0; m < 4; ++m) acc[ai][bj][m][n] += bv; }
        const bool bad = st.run(acc, u, wr, wc, fr, fq, lds, wid, lane) || poison != 0u;
        const float qnan = __builtin_nanf("");
#pragma unroll
        for (int ai = 0; ai < 2; ++ai)
#pragma unroll
            for (int m = 0; m < 4; ++m) { const int r = ai * HALF + wr * 64 + m * 16 + fr; const f32x2v sr = S[r]; const size_t off = (size_t)(u.pm * BM + r) * ldc + col0;
#pragma unroll
                for (int bj = 0; bj < 2; ++bj)
#pragma unroll
                    for (int n = 0; n < 2; ++n) { const f32x4 bs = *(const f32x4*)(base + off + bj * HALF + n * 16); f32x4 o = bs + (acc[ai][bj][m][n] - sr.x) * sr.y;
                        if (bad) o = (f32x4){qnan, qnan, qnan, qnan}; *(f32x4*)(out + off + bj * HALF + n * 16) = o; }
                asm volatile("" ::: "memory"); }
    }
};
struct EpiLnResLn {
    static constexpr bool PERM = false, AFTER_DRAIN = true;
    const float* base; float* out; bf16_t* xn; int ldc; const float* bias; PanelStats st1, st2; unsigned poison;
    __device__ __forceinline__ void refuse(size_t i0, size_t stride, int M, int N) const { const float q = __builtin_nanf(""); for (size_t i = i0; i < (size_t)M * N; i += stride) { const size_t o = (i / N) * ldc + i % N; out[o] = q; xn[o] = (bf16_t)0x7fc0u; }
        if (i0 == 0) { unsigned expect = 0u; __hip_atomic_compare_exchange_strong(st1.tmo + 1, &expect, 0x7f0u, __ATOMIC_RELAXED, __ATOMIC_RELAXED, __HIP_MEMORY_SCOPE_AGENT); __hip_atomic_store(st1.tmo, 1u, __ATOMIC_RELAXED, __HIP_MEMORY_SCOPE_AGENT); } }
    __device__ __forceinline__ void fused(f32x4 (&acc)[2][2][4][2], const Unit& u, int wr, int wc, int fr, int fq, PG8_LAS unsigned char* lds, int wid, int lane) const {
        typedef float f32x2v __attribute__((ext_vector_type(2))); typedef unsigned u32x2v __attribute__((ext_vector_type(2)));
        const PG8_LAS f32x2v* S = (const PG8_LAS f32x2v*)(lds + 8192);
        const int col0 = u.pn * BM + wc * 32 + 4 * fq;
#pragma unroll
        for (int bj = 0; bj < 2; ++bj)
#pragma unroll
            for (int n = 0; n < 2; ++n) { const f32x4 bv = bias ? *(const f32x4*)(bias + col0 + bj * HALF + n * 16) : (f32x4){0.f, 0.f, 0.f, 0.f};
#pragma unroll
                for (int ai = 0; ai < 2; ++ai)
#pragma unroll
                    for (int m = 0; m < 4; ++m) acc[ai][bj][m][n] += bv; }
        bool bad = st1.run(acc, u, wr, wc, fr, fq, lds, wid, lane) || poison != 0u;
        const float qnan = __builtin_nanf("");
#pragma unroll
        for (int ai = 0; ai < 2; ++ai)
#pragma unroll
            for (int m = 0; m < 4; ++m) { const int r = ai * HALF + wr * 64 + m * 16 + fr; const f32x2v sr = S[r]; const size_t off = (size_t)(u.pm * BM + r) * ldc + col0;
#pragma unroll
                for (int bj = 0; bj < 2; ++bj)
#pragma unroll
                    for (int n = 0; n < 2; ++n) { const f32x4 bs = *(const f32x4*)(base + off + bj * HALF + n * 16); acc[ai][bj][m][n] = bs + (acc[ai][bj][m][n] - sr.x) * sr.y; }
                asm volatile("" : "+v"(acc[ai][0][m][0]), "+v"(acc[ai][0][m][1]), "+v"(acc[ai][1][m][0]), "+v"(acc[ai][1][m][1]));
                if (m & 1) asm volatile("" ::: "memory"); }
        const bool bad1 = bad;
        bad = st2.run(acc, u, wr, wc, fr, fq, lds, wid, lane) || bad;
#pragma unroll
        for (int ai = 0; ai < 2; ++ai)
#pragma unroll
            for (int m = 0; m < 4; ++m) { const int r = ai * HALF + wr * 64 + m * 16 + fr; const f32x2v sr = S[r]; const size_t off = (size_t)(u.pm * BM + r) * ldc + col0;
#pragma unroll
                for (int bj = 0; bj < 2; ++bj)
#pragma unroll
                    for (int n = 0; n < 2; ++n) { const f32x4 x1 = acc[ai][bj][m][n]; *(f32x4*)(out + off + bj * HALF + n * 16) = bad1 ? (f32x4){qnan, qnan, qnan, qnan} : x1;
                        const f32x4 o = (x1 - sr.x) * sr.y; u32x2v w; w.x = cvt_pk_bf16(o[0], o[1]); w.y = cvt_pk_bf16(o[2], o[3]);
                        if (bad) { w.x = 0x7fc07fc0u; w.y = 0x7fc07fc0u; } *(u32x2v*)(xn + off + bj * HALF + n * 16) = w; }
                asm volatile("" ::: "memory"); }
    }
};

template <class Epi, class Sched, bool STAMP = false>
__device__ __forceinline__ void gemm_phase(PG8_LAS unsigned char* lds, const Gemm g, const Sched& S, const Epi& E, unsigned long long* stamps) {
    const int tid = threadIdx.x, wid = __builtin_amdgcn_readfirstlane(tid >> 6), lane = tid & 63, wr = wid >> 2, wc = wid & 3, fr = lane & 15, fq = lane >> 4;
    const int K = g.K, nt = K / BK;
    int ts_lo = 0, ts_hi = 0, nts = 0; const unsigned long long rt_entry = STAMP ? (unsigned long long)wall_clock64() : 0ull;
#define PG8_STAMP() do { if (STAMP && wid == 0 && nts < 64) { const unsigned long long _c = (unsigned long long)clock64(); \
        ts_lo = (lane == nts) ? (int)(unsigned)_c : ts_lo; ts_hi = (lane == nts) ? (int)(unsigned)(_c >> 32) : ts_hi; ++nts; } } while (0)
    PG8_STAMP();
    unsigned voffA[2], voffB[2];
#pragma unroll
    for (int i = 0; i < 2; ++i) { int R, C; stage_rc(tid * 16 + i * 8192, R, C); const int Rb = Epi::PERM ? ((R & ~31) + perm32(R & 31)) : R;
        voffA[i] = (unsigned)(R * K + C) * 2u; voffB[i] = (unsigned)(Rb * K + C) * 2u; }
    const size_t kstep = (size_t)(BK * 2);
    const size_t hstep = (size_t)HALF * K * 2;
    const size_t tstep = 2 * hstep;
    const unsigned ldsw = (unsigned)wid * 1024u;
    const int aoff = lds_byte(wr * 64 + fr, fq * 8), boff = lds_byte(wc * 32 + fr, fq * 8);
#define PG8_SA(b, h) (((b) * 2 + (h)) * HTB)
#define PG8_SB(b, h) ((4 + (b) * 2 + (h)) * HTB)
#define PG8_STAGE(bufoff, gbase, voff) do { _Pragma("unroll") for (int _i = 0; _i < 2; ++_i) \
        __builtin_amdgcn_global_load_lds((const unsigned*)((const char*)(gbase) + (voff)[_i]), (PG8_LAS unsigned*)(lds + (bufoff) + ldsw + _i * 8192), 16, 0, 0); } while (0)
#define PG8_LDA(dst, b, h) do { _Pragma("unroll") for (int m = 0; m < 4; ++m) _Pragma("unroll") for (int k = 0; k < 2; ++k) dst[m][k] = *(const PG8_LAS bf16x8*)(lds + PG8_SA(b, h) + aoff + m * 2048 + k * 1024); } while (0)
#define PG8_LDB(dst, b, h) do { _Pragma("unroll") for (int n = 0; n < 2; ++n) _Pragma("unroll") for (int k = 0; k < 2; ++k) dst[n][k] = *(const PG8_LAS bf16x8*)(lds + PG8_SB(b, h) + boff + n * 2048 + k * 1024); } while (0)
#define PG8_MMA(ai, bj, At, Bt) do { __builtin_amdgcn_s_setprio(1); _Pragma("unroll") for (int m = 0; m < 4; ++m) _Pragma("unroll") for (int n = 0; n < 2; ++n) _Pragma("unroll") for (int k = 0; k < 2; ++k) \
        acc[ai][bj][m][n] = __builtin_amdgcn_mfma_f32_16x16x32_bf16(Bt[n][k], At[m][k], acc[ai][bj][m][n], 0, 0, 0); __builtin_amdgcn_s_setprio(0); } while (0)
#define PG8_WAIT_V(n) asm volatile("s_waitcnt vmcnt(" #n ")" ::: "memory")
#define PG8_WAIT_L(n) asm volatile("s_waitcnt lgkmcnt(" #n ")" ::: "memory")
#define PG8_BAR __builtin_amdgcn_s_barrier()
#define PG8_SCHED __builtin_amdgcn_sched_barrier(0)
    Unit cur, nxt; int ui = 0;
    if (!S.next(0, cur)) return;
    f32x4 acc[2][2][4][2];
#pragma unroll
    for (int a = 0; a < 2; ++a)
#pragma unroll
        for (int b = 0; b < 2; ++b)
#pragma unroll
            for (int m = 0; m < 4; ++m)
#pragma unroll
                for (int n = 0; n < 2; ++n) acc[a][b][m][n] = (f32x4){0.f, 0.f, 0.f, 0.f};
    bf16x8 At[4][2], B0[2][2], B1[2][2];
    const char* cA = (const char*)g.A + (size_t)cur.pm * tstep; const char* cB = (const char*)g.Bt + (size_t)cur.pn * tstep;
    S.a_ready(cur);
    PG8_STAGE(PG8_SB(0, 0), cB, voffB); PG8_STAGE(PG8_SA(0, 0), cA, voffA); PG8_STAGE(PG8_SB(0, 1), cB + hstep, voffB); PG8_STAGE(PG8_SA(0, 1), cA + hstep, voffA);
    if (wr == 1) PG8_BAR;
    PG8_WAIT_V(4); PG8_BAR;
    PG8_STAGE(PG8_SB(1, 0), cB + kstep, voffB); PG8_STAGE(PG8_SA(1, 0), cA + kstep, voffA); PG8_STAGE(PG8_SB(1, 1), cB + hstep + kstep, voffB);
    PG8_WAIT_V(6); PG8_BAR;
    PG8_STAMP();
    for (;;) {
        const bool has_next = S.next(ui + 1, nxt);
        const char* nA = has_next ? (const char*)g.A + (size_t)nxt.pm * tstep : cA; const char* nB = has_next ? (const char*)g.Bt + (size_t)nxt.pn * tstep : cB;
        for (int t = 0; t < nt; t += 2) {
            const bool last = (t == nt - 2);
            const char* a1 = cA + (size_t)(t + 1) * kstep;
            const char* a2 = last ? nA : cA + (size_t)(t + 2) * kstep; const char* b2 = last ? nB : cB + (size_t)(t + 2) * kstep;
            const char* a3 = a2 + kstep; const char* b3 = b2 + kstep;
            if (last && has_next) S.a_ready(nxt);
            PG8_LDB(B0, 0, 0); PG8_SCHED; PG8_LDA(At, 0, 0); PG8_STAGE(PG8_SA(1, 1), a1 + hstep, voffA);
            PG8_WAIT_L(8); PG8_BAR; PG8_WAIT_L(0); PG8_MMA(0, 0, At, B0); PG8_BAR; PG8_SCHED;
            PG8_LDB(B1, 0, 1); PG8_STAGE(PG8_SB(0, 0), b2, voffB);
            PG8_BAR; PG8_WAIT_L(0); PG8_MMA(0, 1, At, B1); PG8_BAR;
            PG8_LDA(At, 0, 1); PG8_STAGE(PG8_SA(0, 0), a2, voffA);
            PG8_BAR; PG8_WAIT_L(0); PG8_MMA(1, 0, At, B0); PG8_BAR; PG8_SCHED;
            PG8_STAGE(PG8_SB(0, 1), b2 + hstep, voffB);
            PG8_WAIT_V(6); PG8_BAR; PG8_MMA(1, 1, At, B1); PG8_BAR;
            PG8_LDB(B0, 1, 0); PG8_SCHED; PG8_LDA(At, 1, 0); PG8_STAGE(PG8_SA(0, 1), a2 + hstep, voffA);
            PG8_WAIT_L(8); PG8_BAR; PG8_WAIT_L(0); PG8_MMA(0, 0, At, B0); PG8_BAR; PG8_SCHED;
            PG8_LDB(B1, 1, 1); PG8_STAGE(PG8_SB(1, 0), b3, voffB);
            PG8_BAR; PG8_WAIT_L(0); PG8_MMA(0, 1, At, B1); PG8_BAR;
            PG8_LDA(At, 1, 1); PG8_STAGE(PG8_SA(1, 0), a3, voffA);
            PG8_BAR; PG8_WAIT_L(0); PG8_MMA(1, 0, At, B0); PG8_BAR; PG8_SCHED;
            PG8_STAGE(PG8_SB(1, 1), b3 + hstep, voffB);
            PG8_WAIT_V(6); PG8_BAR; PG8_MMA(1, 1, At, B1); PG8_BAR;
        }
        PG8_STAMP();
        if constexpr (!Epi::AFTER_DRAIN) { E(acc, cur, wr, wc, fr, fq); S.done(cur); }
        PG8_STAMP();
        if (!has_next) break;
#pragma unroll
        for (int a = 0; a < 2; ++a)
#pragma unroll
            for (int b = 0; b < 2; ++b)
#pragma unroll
                for (int m = 0; m < 4; ++m)
#pragma unroll
                    for (int n = 0; n < 2; ++n) acc[a][b][m][n] = (f32x4){0.f, 0.f, 0.f, 0.f};
        cur = nxt; cA = nA; cB = nB; ++ui;
    }
    PG8_WAIT_V(0);
    if (wr == 0) PG8_BAR;
    PG8_BAR;
    if constexpr (Epi::AFTER_DRAIN) { E.fused(acc, cur, wr, wc, fr, fq, lds, wid, lane); S.done(cur); }
    PG8_STAMP();
    if (STAMP && wid == 0) { stamps[lane] = lane < nts ? (((unsigned long long)(unsigned)ts_hi << 32) | (unsigned)ts_lo) : 0ull;
        if (lane == 62) stamps[62] = rt_entry; if (lane == 63) stamps[63] = (unsigned long long)wall_clock64(); }
#undef PG8_STAMP
#undef PG8_SA
#undef PG8_SB
#undef PG8_STAGE
#undef PG8_LDA
#undef PG8_LDB
#undef PG8_MMA
#undef PG8_WAIT_V
#undef PG8_WAIT_L
#undef PG8_BAR
#undef PG8_SCHED
}
}

struct EpiIn0 {
    static constexpr bool PERM = true, AFTER_DRAIN = false;
    bf16_t *Q0, *K0, *V0t, *G0;
    __device__ __forceinline__ void operator()(const pg8::f32x4 (&acc)[2][2][4][2], const pg8::Unit& u, int wr, int wc, int fr, int fq) const {
        const int pn = u.pn;
#pragma unroll
        for (int ai = 0; ai < 2; ++ai)
#pragma unroll
            for (int m = 0; m < 4; ++m) {
                const int t = u.pm * 256 + ai * 128 + wr * 64 + m * 16 + fr;
#pragma unroll
                for (int bj = 0; bj < 2; ++bj) {
                    const int c = bj * 128 + wc * 32 + 8 * fq;
                    pg8::f32x4 v0 = acc[ai][bj][m][0], v1 = acc[ai][bj][m][1];
                    if (pn == 5) {
                        bf16_t* d = V0t + ((size_t)((t >> 12) * 256 + c)) * 4096 + (t & 4095);
#pragma unroll
                        for (int e = 0; e < 4; ++e) { d[(size_t)e * 4096] = f2bf(v0[e]); d[(size_t)(e + 4) * 4096] = f2bf(v1[e]); }
                    } else {
                        u32x4 w = {pk2(v0[0], v0[1]), pk2(v0[2], v0[3]), pk2(v1[0], v1[1]), pk2(v1[2], v1[3])};
                        bf16_t* d = pn < 4 ? Q0 + (size_t)t * 1024 + pn * 256 + c : (pn == 4 ? K0 + (size_t)t * 256 + c : G0 + (size_t)t * 1024 + (pn - 6) * 256 + c);
                        *(u32x4*)d = w;
                    }
                }
            }
    }
};
struct EpiIn1 {
    static constexpr bool PERM = true, AFTER_DRAIN = false;
    bf16_t *QK1, *V1t, *G1;
    __device__ __forceinline__ void operator()(const pg8::f32x4 (&acc)[2][2][4][2], const pg8::Unit& u, int wr, int wc, int fr, int fq) const {
        const int pn = u.pn;
#pragma unroll
        for (int ai = 0; ai < 2; ++ai)
#pragma unroll
            for (int m = 0; m < 4; ++m) {
                const int t = u.pm * 256 + ai * 128 + wr * 64 + m * 16 + fr;
                const int sq = t >> 12, ch = (t >> 6) & 63, tok = t & 63;
#pragma unroll
                for (int bj = 0; bj < 2; ++bj) {
                    const int c = bj * 128 + wc * 32 + 8 * fq;
                    pg8::f32x4 v0 = acc[ai][bj][m][0], v1 = acc[ai][bj][m][1];
                    if (pn >= 4 && pn < 8) {
                        bf16_t* d = V1t + v1_off(sq, pn - 4, ch) + c * 64 + tok;
#pragma unroll
                        for (int e = 0; e < 4; ++e) { d[e * 64] = f2bf(v0[e]); d[(e + 4) * 64] = f2bf(v1[e]); }
                    } else if (pn < 4) {
                        const float sc = pn < 2 ? 0.08838834764831845f : 1.0f;
                        const int f = (pn & 1) * 256 + c;
                        u32x4 w = {pk2(v0[0] * sc, v0[1] * sc), pk2(v0[2] * sc, v0[3] * sc), pk2(v1[0] * sc, v1[1] * sc), pk2(v1[2] * sc, v1[3] * sc)};
                        *(u32x4*)(QK1 + qk_off(sq, f >> 7, ch) + (pn >> 1) * 8192 + tok * 128 + (f & 127)) = w;
                    } else {
                        u32x4 w = {pk2(v0[0], v0[1]), pk2(v0[2], v0[3]), pk2(v1[0], v1[1]), pk2(v1[2], v1[3])};
                        *(u32x4*)(G1 + (size_t)t * 1024 + (pn - 8) * 256 + c) = w;
                    }
                }
            }
    }
};

DI void phase_in0(const Params& p, unsigned char* smem) {
    pg8::Gemm g; g.A = (const pg8::bf16_t*)(p.ws + WS_A0); g.Bt = (const pg8::bf16_t*)(p.ws + WS_WT0IN); g.M = T_TOK; g.N = 2560; g.K = 1024;
    pg8::StaticOrder S; S.init(T_TOK, 2560, gridDim.x, blockIdx.x);
    EpiIn0 E; E.Q0 = (bf16_t*)(p.ws + WS_A1); E.G0 = (bf16_t*)(p.ws + WS_A2); E.K0 = (bf16_t*)(p.ws + WS_K0); E.V0t = (bf16_t*)(p.ws + WS_V0T);
    pg8::gemm_phase<EpiIn0, pg8::StaticOrder, false>((PG8_LAS unsigned char*)smem, g, S, E, nullptr);
}

DI void phase_attn(const Params& p, unsigned char* smem) {
    const bf16_t* Q0 = (const bf16_t*)(p.ws + WS_A1); const bf16_t* G0 = (const bf16_t*)(p.ws + WS_A2);
    const bf16_t* K0 = (const bf16_t*)(p.ws + WS_K0); const bf16_t* V0t = (const bf16_t*)(p.ws + WS_V0T);
    bf16_t* og = (bf16_t*)(p.ws + WS_A4);
    bf16_t* sK = (bf16_t*)smem;
    bf16_t* sVt = (bf16_t*)(smem + 55296);
    const int tid = opq_tid(), lane = tid & 63, wid = tid >> 6, r = lane & 31, h = lane >> 5;
    for (int u = blockIdx.x; u < NSEQ * 32 * 4; u += gridDim.x) {
        const int g = u & 3, n = (u >> 2) & 31, sq = u >> 7;
        const int kbase = (n - 1) * 128;
        __syncthreads();
        {
            const u32x4 zero4 = {0u, 0u, 0u, 0u};
            u32x4 kv[6], vv[6];
#pragma unroll
            for (int q = 0; q < 6; ++q) {
                const int c = tid + NTHR * q, row = c >> 3, cc = c & 7, kpos = kbase + row;
                const int kc = kpos < 0 ? 0 : (kpos >= SEQ ? SEQ - 1 : kpos);
                kv[q] = *(const u32x4*)(K0 + ((size_t)sq * SEQ + kc) * 256 + g * 64 + cc * 8);
            }
#pragma unroll
            for (int q = 0; q < 6; ++q) {
                const int c = tid + NTHR * q, row = c / 48, cc = c % 48, kpos = kbase + cc * 8;
                const int kc = kpos < 0 ? 0 : (kpos >= SEQ ? SEQ - 8 : kpos);
                vv[q] = *(const u32x4*)(V0t + ((size_t)(sq * 256 + g * 64 + row)) * 4096 + kc);
            }
#pragma unroll
            for (int q = 0; q < 6; ++q) {
                const int c = tid + NTHR * q, row = c >> 3, cc = c & 7, kpos = kbase + row;
                *(u32x4*)(sK + row * 72 + cc * 8) = (kpos >= 0 && kpos < SEQ) ? kv[q] : zero4;
            }
#pragma unroll
            for (int q = 0; q < 6; ++q) {
                const int c = tid + NTHR * q, row = c / 48, cc = c % 48, kpos = kbase + cc * 8;
                *(u32x4*)(sVt + row * 392 + cc * 8) = (kpos >= 0 && kpos < SEQ) ? vv[q] : zero4;
            }
        }
        __syncthreads();
        const int head = wid >> 1, hq = g * 4 + head;
        const float slope2 = exp2f(-0.5f * (float)(hq + 1)) * LOG2E;
        const float sink2 = p.sink[hq] * LOG2E;
        const int tq0 = n * 128 + (wid & 1) * 64;
        bf16x8 qf[2][4];
        f32x16 o0[2], o1[2];
        float mrun[2], lsum[2];
#pragma unroll
        for (int e = 0; e < 2; ++e) {
            const size_t trow = (size_t)sq * SEQ + tq0 + 32 * e + r;
#pragma unroll
            for (int s = 0; s < 4; ++s) qf[e][s] = *(const bf16x8*)(Q0 + trow * 1024 + hq * 64 + s * 16 + h * 8);
#pragma unroll
            for (int i = 0; i < 16; ++i) { o0[e][i] = 0.f; o1[e][i] = 0.f; }
            mrun[e] = sink2; lsum[e] = (h == 0) ? 1.0f : 0.0f;
        }
        auto tile_step = [&](auto maskc, int m) {
            constexpr bool MASKED = decltype(maskc)::value;
            const bool edge = (m == -4) || (m == 4);
            f32x16 st[2];
            int kl[2]; bool ok[2];
#pragma unroll
            for (int e = 0; e < 2; ++e) {
                const int kb = tq0 + 32 * e + 32 * m;
                ok[e] = (kb >= 0) && (kb < SEQ);
                kl[e] = kb - kbase;
#pragma unroll
                for (int i = 0; i < 16; ++i) st[e][i] = 0.f;
#pragma unroll
                for (int s = 0; s < 4; ++s) { const bf16x8 kf = *(const bf16x8*)(sK + (kl[e] + r) * 72 + s * 16 + h * 8); st[e] = MFMA32(kf, qf[e][s], st[e]); }
            }
            const float fd0 = (float)(r - 32 * m - 4 * h);
#pragma unroll
            for (int e = 0; e < 2; ++e) {
                float mx = -3.0e38f;
                const bool msk = edge || !ok[e];
#pragma unroll
                for (int i = 0; i < 16; ++i) {
                    const float fd = fabsf(fd0 - (float)((i & 3) + 8 * (i >> 2)));
                    float sc = st[e][i] * (0.125f * LOG2E) - slope2 * fd;
                    if (MASKED) { if (msk) sc = (ok[e] && fd <= 128.0f) ? sc : -3.0e38f; }
                    st[e][i] = sc; mx = fmaxf(mx, sc);
                }
                mx = fmaxf(mx, __shfl_xor(mx, 32));
                const float mnew = fmaxf(mrun[e], mx);
                const float al = __builtin_amdgcn_exp2f(mrun[e] - mnew);
                mrun[e] = mnew;
                float ps = 0.f;
#pragma unroll
                for (int i = 0; i < 16; ++i) { const float pe = __builtin_amdgcn_exp2f(st[e][i] - mnew); st[e][i] = pe; ps += pe; }
                lsum[e] = lsum[e] * al + ps;
                if (__any(al != 1.0f)) {
#pragma unroll
                    for (int i = 0; i < 16; ++i) { o0[e][i] *= al; o1[e][i] *= al; }
                }
            }
#pragma unroll
            for (int e = 0; e < 2; ++e)
#pragma unroll
                for (int s2 = 0; s2 < 2; ++s2) {
                    const bf16x8 pf = pack8(st[e], s2);
                    const bf16_t* vb = sVt + r * 392 + kl[e] + 16 * s2 + 4 * h;
                    const bf16x8 v0 = cat44(*(const s16x4*)vb, *(const s16x4*)(vb + 8));
                    const bf16x8 v1 = cat44(*(const s16x4*)(vb + 32 * 392), *(const s16x4*)(vb + 32 * 392 + 8));
                    o0[e] = MFMA32(v0, pf, o0[e]);
                    o1[e] = MFMA32(v1, pf, o1[e]);
                }
        };
        for (int m = -4; m <= 4; ++m) {
            const int kb0 = tq0 + 32 * m;
            const bool plain = (m > -4) && (m < 4) && (kb0 >= 0) && (kb0 + 32 < SEQ);
            if (plain) tile_step(std::integral_constant<bool, false>{}, m); else tile_step(std::integral_constant<bool, true>{}, m);
        }
        bf16_t* sO = (bf16_t*)(smem + 105472) + wid * 2304;
#pragma unroll
        for (int e = 0; e < 2; ++e) {
            const float inv = 1.0f / (lsum[e] + __shfl_xor(lsum[e], 32));
#pragma unroll
            for (int dt = 0; dt < 2; ++dt)
#pragma unroll
                for (int gq = 0; gq < 4; ++gq) {
                    const f32x16& oo = dt ? o1[e] : o0[e];
                    f32x4 v = {oo[4 * gq] * inv, oo[4 * gq + 1] * inv, oo[4 * gq + 2] * inv, oo[4 * gq + 3] * inv};
                    st_bf4(sO + r * 72 + dt * 32 + 8 * gq + 4 * h, v);
                }
            const size_t tb = (size_t)sq * SEQ + tq0 + 32 * e;
#pragma unroll
            for (int k = 0; k < 4; ++k) {
                const int c = lane + 64 * k, row = c >> 3, cc = c & 7;
                const u32x4 ov = *(const u32x4*)(sO + row * 72 + cc * 8);
                const u32x4 gt = *(const u32x4*)(G0 + (tb + row) * 1024 + hq * 64 + cc * 8);
                u32x4 w;
#pragma unroll
                for (int j = 0; j < 4; ++j) w[j] = pk2(bf_lo(ov[j]) * silu(bf_lo(gt[j])), bf_hi(ov[j]) * silu(bf_hi(gt[j])));
                *(u32x4*)(og + (tb + row) * 1024 + hq * 64 + cc * 8) = w;
            }
        }
    }
}

template <bool L1> DI void phase_out_ln(const Params& p, unsigned char* smem) {
    const bf16_t* Ain = (const bf16_t*)(p.ws + (L1 ? WS_A2 : WS_A4));
    const bf16_t* wt = (const bf16_t*)(p.ws + (L1 ? WS_WT1OUT : WS_WT0OUT));
    bf16_t* x1b = (bf16_t*)(p.ws + WS_A0);
    float* stats = (float*)(p.ws + (L1 ? WS_STAT1 : WS_STAT0));
    unsigned* cnt = (unsigned*)(p.ws + WS_CNT) + (L1 ? 384 : 0);
    const float* gw = L1 ? p.ln1g : p.ln0g; const float* bw = L1 ? p.ln1b : p.ln0b;
    u32x4 rp[4], rq[4];
    int pm, nt, pm2, nt2;
    bool have = gemm_unit(0, 4, pm, nt);
    for (int it = 0; have; ++it) {
        const bf16_t* A = Ain + (size_t)pm * 256 * 1024;
        const bf16_t* B = wt + (size_t)nt * 256 * 1024;
        const bool more = gemm_unit(it + 1, 4, pm2, nt2);
        const bf16_t* nA = more ? Ain + (size_t)pm2 * 256 * 1024 : A;
        const bf16_t* nB = more ? wt + (size_t)nt2 * 256 * 1024 : B;
        const int t0 = pm * 256;
        const int tid = opq_tid(), lane = tid & 63, wid = tid >> 6, wi = wid >> 2, wj = wid & 3, r = lane & 31, h = lane >> 5;
        {
            f32x16 acc[4][2];
            gemm_kloop(B, A, nB, nA, it == 0, smem, acc, rp, rq, tid);
#pragma unroll
            for (int a = 0; a < 4; ++a)
#pragma unroll
                for (int b = 0; b < 2; ++b)
#pragma unroll
                    for (int g = 0; g < 4; ++g) {
                        const int i0 = wi * 128 + a * 32 + 8 * g + 4 * h, j = wj * 64 + b * 32 + r;
                        u32x2 o = {pk2(acc[a][b][4 * g], acc[a][b][4 * g + 1]), pk2(acc[a][b][4 * g + 2], acc[a][b][4 * g + 3])};
                        *(u32x2*)(smem + j * 528 + i0 * 2) = o;
                    }
        }
        __builtin_amdgcn_sched_barrier(0);
        __syncthreads();
        __builtin_amdgcn_sched_barrier(0);
        const int col = nt * 256 + lane * 4;
        auto hrow = [&](int row) -> f32x4 {
            const int t = t0 + row;
            const u32x2 mv = *(const u32x2*)(smem + row * 528 + lane * 8);
            f32x4 xr;
            if (L1) { const u32x2 xv = *(const u32x2*)(x1b + (size_t)t * 1024 + col); xr = (f32x4){bf_lo(xv[0]), bf_hi(xv[0]), bf_lo(xv[1]), bf_hi(xv[1])}; }
            else xr = *(const f32x4*)(xrow(p, t) + col);
            return xr * DN_ALPHA + (f32x4){bf_lo(mv[0]), bf_hi(mv[0]), bf_lo(mv[1]), bf_hi(mv[1])};
        };
        {
            float v[64];
#pragma unroll
            for (int hb = 0; hb < 4; ++hb) {
                f32x4 xr[8];
#pragma unroll
                for (int q = 0; q < 8; ++q) {
                    const int t = t0 + wid + 8 * (hb * 8 + q);
                    if (L1) { const u32x2 xv = *(const u32x2*)(x1b + (size_t)t * 1024 + col); xr[q] = (f32x4){__uint_as_float(xv[0]), __uint_as_float(xv[1]), 0.f, 0.f}; }
                    else xr[q] = *(const f32x4*)(xrow(p, t) + col);
                }
                asm volatile("" : "+v"(xr[0]), "+v"(xr[1]), "+v"(xr[2]), "+v"(xr[3]), "+v"(xr[4]), "+v"(xr[5]), "+v"(xr[6]), "+v"(xr[7]));
#pragma unroll
                for (int q = 0; q < 8; ++q) {
                    const int qq = hb * 8 + q, row = wid + 8 * qq;
                    const u32x2 mv = *(const u32x2*)(smem + row * 528 + lane * 8);
                    f32x4 xv;
                    if (L1) { const unsigned u0 = __float_as_uint(xr[q][0]), u1 = __float_as_uint(xr[q][1]); xv = (f32x4){bf_lo(u0), bf_hi(u0), bf_lo(u1), bf_hi(u1)}; }
                    else xv = xr[q];
                    const f32x4 hv = xv * DN_ALPHA + (f32x4){bf_lo(mv[0]), bf_hi(mv[0]), bf_lo(mv[1]), bf_hi(mv[1])};
                    v[2 * qq] = (hv[0] + hv[1]) + (hv[2] + hv[3]);
                    v[2 * qq + 1] = (hv[0] * hv[0] + hv[1] * hv[1]) + (hv[2] * hv[2] + hv[3] * hv[3]);
                }
            }
#pragma unroll
            for (int k = 0; k < 6; ++k) {
                const int hlf = 32 >> k;
                const bool up = (lane >> k) & 1;
#pragma unroll
                for (int i = 0; i < hlf; ++i) {
                    const float keep = up ? v[hlf + i] : v[i];
                    const float send = up ? v[i] : v[hlf + i];
                    v[i] = keep + __shfl_xor(send, 1 << k);
                }
            }
            const int idx = ((lane & 1) << 5) | ((lane & 2) << 3) | ((lane & 4) << 1) | ((lane & 8) >> 1) | ((lane & 16) >> 3) | ((lane & 32) >> 5);
            const int row = wid + 8 * (idx >> 1);
            __hip_atomic_store(stats + ((size_t)(t0 + row) * 4 + nt) * 2 + (idx & 1), v[0], __ATOMIC_RELAXED, __HIP_MEMORY_SCOPE_AGENT);
        }
        asm volatile("s_waitcnt vmcnt(0)" ::: "memory");
        __syncthreads();
        if (tid == 0) {
            __hip_atomic_fetch_add(cnt + pm, 1u, __ATOMIC_RELEASE, __HIP_MEMORY_SCOPE_AGENT);
            int polls = 0;
            while (__hip_atomic_load(cnt + pm, __ATOMIC_RELAXED, __HIP_MEMORY_SCOPE_AGENT) < 4u && polls < (1 << 22)) { __builtin_amdgcn_s_sleep(2); ++polls; }
            __builtin_amdgcn_fence(__ATOMIC_ACQUIRE, "agent");
        }
        __syncthreads();
        const f32x4 gg = *(const f32x4*)(gw + col), bb = *(const f32x4*)(bw + col);
        float mu_l, rstd_l;
        {
            const float* sp = stats + (size_t)(t0 + wid + 8 * (lane & 31)) * 8;
            float s1 = 0.f, s2 = 0.f;
#pragma unroll
            for (int i = 0; i < 4; ++i) { s1 += __hip_atomic_load(sp + 2 * i, __ATOMIC_RELAXED, __HIP_MEMORY_SCOPE_AGENT); s2 += __hip_atomic_load(sp + 2 * i + 1, __ATOMIC_RELAXED, __HIP_MEMORY_SCOPE_AGENT); }
            mu_l = s1 * (1.0f / 1024.0f);
            rstd_l = rsqrtf(fmaxf(s2 * (1.0f / 1024.0f) - mu_l * mu_l, 0.f) + 1e-5f);
        }
#pragma unroll 1
        for (int hb = 0; hb < 4; ++hb) {
            f32x4 xr[8];
#pragma unroll
            for (int q = 0; q < 8; ++q) {
                const int t = t0 + wid + 8 * (hb * 8 + q);
                if (L1) { const u32x2 xv = *(const u32x2*)(x1b + (size_t)t * 1024 + col); xr[q] = (f32x4){__uint_as_float(xv[0]), __uint_as_float(xv[1]), 0.f, 0.f}; }
                else xr[q] = *(const f32x4*)(xrow(p, t) + col);
            }
            asm volatile("" : "+v"(xr[0]), "+v"(xr[1]), "+v"(xr[2]), "+v"(xr[3]), "+v"(xr[4]), "+v"(xr[5]), "+v"(xr[6]), "+v"(xr[7]));
#pragma unroll
            for (int q = 0; q < 8; ++q) {
                const int qq = hb * 8 + q, row = wid + 8 * qq, t = t0 + row;
                const float mu = __int_as_float(__builtin_amdgcn_readlane(__float_as_int(mu_l), qq));
                const float rstd = __int_as_float(__builtin_amdgcn_readlane(__float_as_int(rstd_l), qq));
                const u32x2 mv = *(const u32x2*)(smem + row * 528 + lane * 8);
                f32x4 xv;
                if (L1) { const unsigned u0 = __float_as_uint(xr[q][0]), u1 = __float_as_uint(xr[q][1]); xv = (f32x4){bf_lo(u0), bf_hi(u0), bf_lo(u1), bf_hi(u1)}; }
                else xv = xr[q];
                const f32x4 hv = xv * DN_ALPHA + (f32x4){bf_lo(mv[0]), bf_hi(mv[0]), bf_lo(mv[1]), bf_hi(mv[1])};
                const f32x4 y = (hv - mu) * rstd * gg + bb;
                if (L1) *(f32x4*)(p.out + (size_t)t * 1024 + col) = y;
                else st_bf4(x1b + (size_t)t * 1024 + col, y);
            }
        }
        __syncthreads();
        have = more; pm = pm2; nt = nt2;
    }
}

DI void phase_in1(const Params& p, unsigned char* smem) {
    pg8::Gemm g; g.A = (const pg8::bf16_t*)(p.ws + WS_A0); g.Bt = (const pg8::bf16_t*)(p.ws + WS_WT1IN); g.M = T_TOK; g.N = 3072; g.K = 1024;
    pg8::StaticOrder S; S.init(T_TOK, 3072, gridDim.x, blockIdx.x);
    EpiIn1 E; E.QK1 = (bf16_t*)(p.ws + WS_A1); E.V1t = (bf16_t*)(p.ws + WS_A2); E.G1 = (bf16_t*)(p.ws + WS_A3);
    pg8::gemm_phase<EpiIn1, pg8::StaticOrder, false>((PG8_LAS unsigned char*)smem, g, S, E, nullptr);
}

DI void phase_gates(const Params& p, unsigned char* smem) {
    const bf16_t* x1b = (const bf16_t*)(p.ws + WS_A0);
    const bf16_t* wlr = (const bf16_t*)(p.ws + WS_WT1IN) + (size_t)3072 * 1024;
    bf16_t* QK1 = (bf16_t*)(p.ws + WS_A1);
    bf16_t* QKf = (bf16_t*)(p.ws + WS_A4);
    float* part = (float*)smem;
    bf16_t* sIn = (bf16_t*)smem;
    bf16_t* sOut = (bf16_t*)(smem + 32768);
    bf16_t* lrb = (bf16_t*)(smem + 98304);
    const int tid = opq_tid(), lane = tid & 63, wid = tid >> 6, r = lane & 31, h = lane >> 5;
    const int ct = wid & 3, dir = wid >> 2;
    const float* wgp = dir ? p.wgb : p.wgf; const float* bgp = dir ? p.bgb : p.bgf;
    for (int cg = blockIdx.x; cg < T_TOK / 64; cg += gridDim.x) {
        const int tb = cg * 64, sq = cg >> 6, ch = cg & 63;
        {
            f32x16 a0, a1;
#pragma unroll
            for (int i = 0; i < 16; ++i) { a0[i] = 0.f; a1[i] = 0.f; }
            bf16x8 fbq[8], fx0[8], fx1[8];
#pragma unroll
            for (int s = 0; s < 8; ++s) {
                const int k = wid * 128 + s * 16 + h * 8;
                fbq[s] = *(const bf16x8*)(wlr + (size_t)r * 1024 + k);
                fx0[s] = *(const bf16x8*)(x1b + (size_t)(tb + r) * 1024 + k);
                fx1[s] = *(const bf16x8*)(x1b + (size_t)(tb + 32 + r) * 1024 + k);
            }
            asm volatile("" : "+v"(fx0[0]), "+v"(fx0[1]), "+v"(fx0[2]), "+v"(fx0[3]), "+v"(fx0[4]), "+v"(fx0[5]), "+v"(fx0[6]), "+v"(fx0[7]),
                              "+v"(fx1[0]), "+v"(fx1[1]), "+v"(fx1[2]), "+v"(fx1[3]), "+v"(fx1[4]), "+v"(fx1[5]), "+v"(fx1[6]), "+v"(fx1[7]));
#pragma unroll
            for (int s = 0; s < 8; ++s) { a0 = MFMA32(fx0[s], fbq[s], a0); a1 = MFMA32(fx1[s], fbq[s], a1); }
            __syncthreads();
#pragma unroll
            for (int i = 0; i < 16; ++i) {
                const int t = (i & 3) + 8 * (i >> 2) + 4 * h;
                part[wid * 2048 + t * 32 + r] = a0[i];
                part[wid * 2048 + (t + 32) * 32 + r] = a1[i];
            }
            __syncthreads();
            float s4[4];
#pragma unroll
            for (int q = 0; q < 4; ++q) { const int e = tid + NTHR * q; float s = 0.f;
#pragma unroll
                for (int w = 0; w < 8; ++w) s += part[w * 2048 + e];
                s4[q] = s; }
#pragma unroll
            for (int q = 0; q < 4; ++q) lrb[tid + NTHR * q] = f2bf(s4[q]);
            __syncthreads();
        }
#pragma unroll 1
        for (int hd = 0; hd < 4; ++hd) {
            bf16_t* gin = QK1 + qk_off(sq, hd, ch);
            bf16_t* gf = QKf + qk_off(sq, hd, ch);
            u32x4 rin[4];
#pragma unroll
            for (int q = 0; q < 4; ++q) rin[q] = *(const u32x4*)(gin + (tid + NTHR * q) * 8);
            const int col = hd * 128 + ct * 32 + r;
            bf16x8 bw;
            { float wv[8];
#pragma unroll
              for (int j = 0; j < 8; ++j) wv[j] = wgp[(8 * h + j) * 512 + col];
              u32x4 pw = {pk2(wv[0], wv[1]), pk2(wv[2], wv[3]), pk2(wv[4], wv[5]), pk2(wv[6], wv[7])}; bw = __builtin_bit_cast(bf16x8, pw); }
            const float bg = bgp[col];
            f32x16 z[2];
#pragma unroll
            for (int tt = 0; tt < 2; ++tt) {
#pragma unroll
                for (int i = 0; i < 16; ++i) z[tt][i] = 0.f;
                const bf16x8 af = *(const bf16x8*)(lrb + (tt * 32 + r) * 32 + dir * 16 + 8 * h);
                z[tt] = MFMA32(af, bw, z[tt]);
            }
            float seg[8];
#pragma unroll
            for (int tt = 0; tt < 2; ++tt)
#pragma unroll
                for (int g4 = 0; g4 < 4; ++g4) {
                    float s = 0.f;
#pragma unroll
                    for (int e = 0; e < 4; ++e) { const float zz = z[tt][4 * g4 + e] + bg;
                        const float gv = (fminf(zz, 0.f) - __logf(1.0f + __expf(-fabsf(zz)))) * (1.0f / 16.0f);
                        z[tt][4 * g4 + e] = gv; s += gv; }
                    seg[tt * 4 + g4] = s;
                }
            float off[8]; float run = 0.f;
#pragma unroll
            for (int k = 0; k < 8; ++k) { const float oth = __shfl_xor(seg[k], 32); off[k] = run + (h ? oth : 0.f); run += seg[k] + oth; }
            const float tot = run;
            if (h == 0) ((float*)(p.ws + (dir ? WS_ELB : WS_ELF)))[(size_t)cg * 512 + col] = __expf(tot);
#pragma unroll
            for (int q = 0; q < 4; ++q) *(u32x4*)(sIn + (tid + NTHR * q) * 8) = rin[q];
            __syncthreads();
#pragma unroll
            for (int tt = 0; tt < 2; ++tt)
#pragma unroll
                for (int g4 = 0; g4 < 4; ++g4) {
                    float pre = off[tt * 4 + g4];
#pragma unroll
                    for (int e = 0; e < 4; ++e) {
                        const int t = tt * 32 + 8 * g4 + 4 * h + e;
                        const float gv = z[tt][4 * g4 + e];
                        const float b = dir ? (tot - pre) : (pre + gv);
                        pre += gv;
                        const float qv = bf2f(sIn[t * 128 + ct * 32 + r]), kv = bf2f(sIn[8192 + t * 128 + ct * 32 + r]);
                        sOut[dir * 16384 + t * 128 + ct * 32 + r] = f2bf(qv * __expf(b));
                        sOut[dir * 16384 + 8192 + t * 128 + ct * 32 + r] = f2bf(kv * __expf(-b));
                    }
                }
            __syncthreads();
#pragma unroll
            for (int q = 0; q < 4; ++q) {
                *(u32x4*)(gf + (tid + NTHR * q) * 8) = *(const u32x4*)(sOut + (tid + NTHR * q) * 8);
                *(u32x4*)(gin + (tid + NTHR * q) * 8) = *(const u32x4*)(sOut + 16384 + (tid + NTHR * q) * 8);
            }
        }
    }
}

#define LDS3 __attribute__((address_space(3)))
DI s16x4 tr_read(const bf16_t* p) { return __builtin_amdgcn_ds_read_tr16_b64_v4i16((LDS3 s16x4*)p); }
DI void phase_gla(const Params& p, unsigned char* smem) {
    const bf16_t* V1t = (const bf16_t*)(p.ws + WS_A2);
    bf16_t* sQD = (bf16_t*)smem;
    bf16_t* sKI = (bf16_t*)(smem + 17408);
    bf16_t* sVt = (bf16_t*)(smem + 34816);
    float* sEL = (float*)(smem + 71680);
    bf16_t* sAtt = (bf16_t*)(smem + 104448);
    bf16_t* sOut = (bf16_t*)(smem + 112640);
    const int tid = opq_tid(), lane = tid & 63, wid = tid >> 6, r = lane & 31, h = lane >> 5;
    const int dvs = wid * 32;
    const bf16_t* trb = sKI + (8 * h + ((lane & 15) >> 2)) * 136 + 16 * ((lane >> 4) & 1) + 4 * (lane & 3);
    for (int u = blockIdx.x; u < NSEQ * 8; u += gridDim.x) {
        const int dir = u & 1, hd = (u >> 1) & 3, sq = u >> 3;
        const bf16_t* QK = (const bf16_t*)(p.ws + (dir ? WS_A1 : WS_A4));
        const float* EL = (const float*)(p.ws + (dir ? WS_ELB : WS_ELF));
        bf16_t* od = (bf16_t*)p.out + (dir ? (size_t)T_TOK * 1024 : 0);
        f32x16 S[4];
#pragma unroll
        for (int d4 = 0; d4 < 4; ++d4)
#pragma unroll
            for (int i = 0; i < 16; ++i) S[d4][i] = 0.f;
        u32x4 rqd[2], rki[2], rv[4];
        auto gload = [&](int ch) {
            const bf16_t* gq = QK + qk_off(sq, hd, ch);
            const bf16_t* gv = V1t + v1_off(sq, hd, ch);
#pragma unroll
            for (int q = 0; q < 2; ++q) { rqd[q] = *(const u32x4*)(gq + (tid + NTHR * q) * 8); rki[q] = *(const u32x4*)(gq + 8192 + (tid + NTHR * q) * 8); }
#pragma unroll
            for (int q = 0; q < 4; ++q) rv[q] = *(const u32x4*)(gv + (tid + NTHR * q) * 8);
        };
        auto swrite = [&]() {
#pragma unroll
            for (int q = 0; q < 2; ++q) { const int c2 = tid + NTHR * q, row = c2 >> 4, cc = c2 & 15;
                *(u32x4*)(sQD + row * 136 + cc * 8) = rqd[q];
                *(u32x4*)(sKI + row * 136 + cc * 8) = rki[q]; }
#pragma unroll
            for (int q = 0; q < 4; ++q) { const int c2 = tid + NTHR * q, row = c2 >> 3, cc = c2 & 7; *(u32x4*)(sVt + row * 72 + cc * 8) = rv[q]; }
        };
        gload(dir ? 63 : 0);
        __syncthreads();
#pragma unroll 2
        for (int q = 0; q < 16; ++q) { const int e = tid + NTHR * q; sEL[e] = EL[((size_t)sq * 64 + (e >> 7)) * 512 + hd * 128 + (e & 127)]; }
        swrite();
        __syncthreads();
        for (int stp = 0; stp < 64; ++stp) {
            const int ch = dir ? 63 - stp : stp;
            if (stp + 1 < 64) gload(dir ? ch - 1 : ch + 1);
            __builtin_amdgcn_sched_barrier(0);
            if (wid < 4) {
                const int a = wid >> 1, b = wid & 1;
                bf16x8 kf[8], qf[8];
#pragma unroll
                for (int s8 = 0; s8 < 8; ++s8) { kf[s8] = *(const bf16x8*)(sKI + (32 * a + r) * 136 + 16 * s8 + 8 * h); qf[s8] = *(const bf16x8*)(sQD + (32 * b + r) * 136 + 16 * s8 + 8 * h); }
                f32x16 at0, at1;
#pragma unroll
                for (int i = 0; i < 16; ++i) { at0[i] = 0.f; at1[i] = 0.f; }
#pragma unroll
                for (int s8 = 0; s8 < 8; s8 += 2) { at0 = MFMA32(kf[s8], qf[s8], at0); at1 = MFMA32(kf[s8 + 1], qf[s8 + 1], at1); }
                const int t = 32 * b + r;
#pragma unroll
                for (int i = 0; i < 16; ++i) {
                    const int s = 32 * a + (i & 3) + 8 * (i >> 2) + 4 * h;
                    const bool keep = dir ? (s > t) : (s <= t);
                    at0[i] = keep ? (at0[i] + at1[i]) : 0.f;
                }
#pragma unroll
                for (int s2 = 0; s2 < 2; ++s2) *(bf16x8*)(sAtt + ((a * 2 + b) * 2 + s2) * 512 + lane * 8) = pack8(at0, s2);
            }
            __builtin_amdgcn_sched_barrier(0);
            f32x16 o0, o1;
#pragma unroll
            for (int i = 0; i < 16; ++i) { o0[i] = 0.f; o1[i] = 0.f; }
#pragma unroll
            for (int d4 = 0; d4 < 4; ++d4)
#pragma unroll
                for (int s2 = 0; s2 < 2; ++s2) {
                    const bf16x8 ps = pack8(S[d4], s2);
                    const bf16_t* qb = sQD + r * 136 + 32 * d4 + 16 * s2 + 4 * h;
                    const bf16x8 q0 = cat44(*(const s16x4*)qb, *(const s16x4*)(qb + 8));
                    const bf16x8 q1 = cat44(*(const s16x4*)(qb + 32 * 136), *(const s16x4*)(qb + 32 * 136 + 8));
                    o0 = MFMA32(ps, q0, o0);
                    o1 = MFMA32(ps, q1, o1);
                }
            __syncthreads();
#pragma unroll
            for (int a = 0; a < 2; ++a)
#pragma unroll
                for (int s2 = 0; s2 < 2; ++s2) {
                    const bf16_t* vb = sVt + (dvs + r) * 72 + 32 * a + 16 * s2 + 4 * h;
                    const bf16x8 va = cat44(*(const s16x4*)vb, *(const s16x4*)(vb + 8));
                    const bf16x8 p0 = *(const bf16x8*)(sAtt + ((a * 2 + 0) * 2 + s2) * 512 + lane * 8);
                    const bf16x8 p1 = *(const bf16x8*)(sAtt + ((a * 2 + 1) * 2 + s2) * 512 + lane * 8);
                    o0 = MFMA32(va, p0, o0);
                    o1 = MFMA32(va, p1, o1);
                }
#pragma unroll
            for (int g = 0; g < 4; ++g) {
                f32x4 v0 = {o0[4 * g], o0[4 * g + 1], o0[4 * g + 2], o0[4 * g + 3]};
                f32x4 v1 = {o1[4 * g], o1[4 * g + 1], o1[4 * g + 2], o1[4 * g + 3]};
                st_bf4(sOut + r * 264 + dvs + 8 * g + 4 * h, v0);
                st_bf4(sOut + (32 + r) * 264 + dvs + 8 * g + 4 * h, v1);
            }
            __builtin_amdgcn_sched_barrier(0);
#pragma unroll
            for (int d4 = 0; d4 < 4; ++d4) {
#pragma unroll
                for (int s4 = 0; s4 < 4; ++s4) {
                    const bf16x8 ka = cat44(tr_read(trb + (16 * s4) * 136 + 32 * d4), tr_read(trb + (16 * s4 + 4) * 136 + 32 * d4));
                    const bf16x8 vb = *(const bf16x8*)(sVt + (dvs + r) * 72 + 16 * s4 + 8 * h);
                    S[d4] = MFMA32(ka, vb, S[d4]);
                }
            }
#pragma unroll
            for (int d4 = 0; d4 < 4; ++d4)
#pragma unroll
                for (int g = 0; g < 4; ++g) {
                    const f32x4 e4 = *(const f32x4*)(sEL + ch * 128 + 32 * d4 + 8 * g + 4 * h);
                    S[d4][4 * g] *= e4[0]; S[d4][4 * g + 1] *= e4[1]; S[d4][4 * g + 2] *= e4[2]; S[d4][4 * g + 3] *= e4[3];
                }
            __syncthreads();
            {
                const size_t tbase = (size_t)sq * SEQ + ch * 64;
#pragma unroll
                for (int q = 0; q < 4; ++q) { const int c2 = tid + NTHR * q, row = c2 >> 5, cc = c2 & 31;
                    *(u32x4*)(od + (tbase + row) * 1024 + hd * 256 + cc * 8) = *(const u32x4*)(sOut + row * 264 + cc * 8); }
            }
            if (stp + 1 < 64) swrite();
            __syncthreads();
        }
    }
}

DI void phase_combine(const Params& p) {
    const bf16_t* of = (const bf16_t*)p.out; const bf16_t* ob = of + (size_t)T_TOK * 1024;
    const bf16_t* G1 = (const bf16_t*)(p.ws + WS_A3);
    bf16_t* og = (bf16_t*)(p.ws + WS_A2);
    const int tid = opq_tid(), lane = tid & 63, wid = tid >> 6;
    f32x4 hn[4];
#pragma unroll
    for (int j = 0; j < 4; ++j) hn[j] = *(const f32x4*)(p.hnorm + lane * 16 + j * 4);
    const int rstride = gridDim.x * 8;
    for (int row0 = blockIdx.x * 8 + wid; row0 < T_TOK; row0 += 2 * rstride) {
        u32x4 a[2][2], b[2][2], gt[2][2];
#pragma unroll
        for (int k = 0; k < 2; ++k) { const int row = (row0 + k * rstride < T_TOK) ? row0 + k * rstride : row0; const size_t base = (size_t)row * 1024 + lane * 16;
#pragma unroll
            for (int q = 0; q < 2; ++q) { a[k][q] = *(const u32x4*)(of + base + q * 8); b[k][q] = *(const u32x4*)(ob + base + q * 8); gt[k][q] = *(const u32x4*)(G1 + base + q * 8); } }
        asm volatile("" : "+v"(a[0][0]), "+v"(a[0][1]), "+v"(a[1][0]), "+v"(a[1][1]), "+v"(b[0][0]), "+v"(b[0][1]), "+v"(b[1][0]), "+v"(b[1][1]), "+v"(gt[0][0]), "+v"(gt[0][1]), "+v"(gt[1][0]), "+v"(gt[1][1]));
#pragma unroll
        for (int k = 0; k < 2; ++k) {
            const int row = row0 + k * rstride;
            if (row < T_TOK) {
                const size_t base = (size_t)row * 1024 + lane * 16;
                float v[16]; float ss = 0.f;
#pragma unroll
                for (int q = 0; q < 2; ++q)
#pragma unroll
                    for (int j = 0; j < 4; ++j) { v[q * 8 + 2 * j] = bf_lo(a[k][q][j]) + bf_lo(b[k][q][j]); v[q * 8 + 2 * j + 1] = bf_hi(a[k][q][j]) + bf_hi(b[k][q][j]); }
#pragma unroll
                for (int j = 0; j < 16; ++j) ss += v[j] * v[j];
#pragma unroll
                for (int o = 1; o < 16; o <<= 1) ss += __shfl_xor(ss, o);
                const float rstd = rsqrtf(ss * (1.0f / 256.0f) + 1e-6f);
#pragma unroll
                for (int q = 0; q < 2; ++q) {
                    const f32x4 h0 = hn[2 * q], h1 = hn[2 * q + 1];
                    const u32x4 g4 = gt[k][q];
                    u32x4 o;
                    o[0] = pk2(v[q * 8 + 0] * rstd * h0[0] * silu(bf_lo(g4[0])), v[q * 8 + 1] * rstd * h0[1] * silu(bf_hi(g4[0])));
                    o[1] = pk2(v[q * 8 + 2] * rstd * h0[2] * silu(bf_lo(g4[1])), v[q * 8 + 3] * rstd * h0[3] * silu(bf_hi(g4[1])));
                    o[2] = pk2(v[q * 8 + 4] * rstd * h1[0] * silu(bf_lo(g4[2])), v[q * 8 + 5] * rstd * h1[1] * silu(bf_hi(g4[2])));
                    o[3] = pk2(v[q * 8 + 6] * rstd * h1[2] * silu(bf_lo(g4[3])), v[q * 8 + 7] * rstd * h1[3] * silu(bf_hi(g4[3])));
                    *(u32x4*)(og + base + q * 8) = o;
                }
            }
        }
    }
}

#define XB_TMO      128
#define XB_XCNT(j)  (256  + 64 * (j))
#define XB_XSUB(j)  (1280 + 64 * (j))
#define XB_XGEN(j)  (2304 + 64 * (j))
#define XB_TOP      3328
#define XB_TOPGEN   3392
#define XCD_BAR_WORDS 3456
#define XB_SPIN_CAP (1u << 18)
#define LAS __attribute__((address_space(3)))

__device__ __forceinline__ unsigned xb_ld(unsigned* p)              { return __hip_atomic_load(p, __ATOMIC_RELAXED, __HIP_MEMORY_SCOPE_AGENT); }
__device__ __forceinline__ unsigned xb_add(unsigned* p, unsigned v) { return __hip_atomic_fetch_add(p, v, __ATOMIC_RELAXED, __HIP_MEMORY_SCOPE_AGENT); }
__device__ __forceinline__ unsigned xb_xcc_id() { return (unsigned)__builtin_amdgcn_s_getreg((3 << 11) | 20) & 0xFu; }
#define XB_SPIN(cond, bar) do { unsigned _sp = 0; while (cond) { __builtin_amdgcn_s_sleep(1); \
    if ((++_sp & 255u) == 0u) { if (xb_ld(&(bar)[XB_TMO])) break; if (_sp > XB_SPIN_CAP) { atomicAdd(&(bar)[XB_TMO], 1u); break; } } } } while (0)

struct XcdBarrier {
    unsigned* bar; unsigned x;
    volatile LAS unsigned* st;
};

__device__ __forceinline__ XcdBarrier xcd_barrier_post(unsigned* bar, volatile LAS unsigned* st) {
    XcdBarrier b; b.bar = bar; b.x = xb_xcc_id(); b.st = st;
    if (threadIdx.x == 0) (void)xb_add(&bar[XB_XCNT(b.x)], 1u);
    return b;
}
__device__ __forceinline__ void xcd_barrier_complete(unsigned* bar, unsigned x, unsigned& nloc, unsigned& nx) {
    const unsigned G = gridDim.x * gridDim.y * gridDim.z;
    unsigned sum, cnt, mine, sp = 0u;
    for (;;) {
        sum = 0u; cnt = 0u; mine = 0u;
#pragma unroll
        for (unsigned j = 0; j < 16; ++j) { const unsigned c = xb_ld(&bar[XB_XCNT(j)]); sum += c; cnt += (c > 0u) ? 1u : 0u; mine = (j == x) ? c : mine; }
        if (sum == G) break;
        __builtin_amdgcn_s_sleep(1);
        if ((++sp & 255u) == 0u) { if (xb_ld(&bar[XB_TMO])) break; if (sp > XB_SPIN_CAP) { atomicAdd(&bar[XB_TMO], 1u); break; } }
    }
    nloc = mine > 0u ? mine : 1u; nx = cnt > 0u ? cnt : 1u;
}

__device__ __forceinline__ void xcd_barrier(const XcdBarrier& b) {
    asm volatile("s_waitcnt vmcnt(0)" ::: "memory");
    __syncthreads();
    if (threadIdx.x == 0) {
        unsigned* bar = b.bar;
        __builtin_amdgcn_s_waitcnt(0);
        unsigned nloc = b.st[0], nx = b.st[1];
        if (nloc == 0u) { xcd_barrier_complete(bar, b.x, nloc, nx); b.st[0] = nloc; b.st[1] = nx; }
        const unsigned old = xb_add(&bar[XB_XSUB(b.x)], 1u);
        const unsigned gen = old / nloc;
        if (old + 1u == (gen + 1u) * nloc) {
            __builtin_amdgcn_fence(__ATOMIC_RELEASE, "agent");
            asm volatile("s_waitcnt vmcnt(0)" ::: "memory");
            const unsigned og = xb_add(&bar[XB_TOP], 1u);
            const unsigned tg = og / nx;
            if (og + 1u == (tg + 1u) * nx) xb_add(&bar[XB_TOPGEN], 1u);
            else XB_SPIN(xb_ld(&bar[XB_TOPGEN]) == tg, bar);
            __builtin_amdgcn_fence(__ATOMIC_ACQUIRE, "agent");
            xb_add(&bar[XB_XGEN(b.x)], 1u);
            asm volatile("s_waitcnt vmcnt(0)" ::: "memory");
        } else {
            XB_SPIN(xb_ld(&bar[XB_XGEN(b.x)]) == gen, bar);
            __builtin_amdgcn_fence(__ATOMIC_ACQUIRE, "agent");
            asm volatile("s_waitcnt vmcnt(0)" ::: "memory");
        }
    }
    __syncthreads();
}


__global__ void __launch_bounds__(NTHR) fwd_megakernel(Params p) {
    extern __shared__ __attribute__((aligned(16))) unsigned char smem[];
    cg::grid_group grid = cg::this_grid();
    volatile LAS unsigned* xst = (volatile LAS unsigned*)(smem + 147456);
    if (threadIdx.x < 4) xst[threadIdx.x] = 0u;
    __syncthreads();
    phase_convert(p, smem);      grid.sync();
    const XcdBarrier xb = xcd_barrier_post((unsigned*)(p.ws + WS_XBAR), xst);
    phase_in0(p, smem);          xcd_barrier(xb);
    phase_attn(p, smem);         xcd_barrier(xb);
    phase_out_ln<false>(p, smem); xcd_barrier(xb);
    phase_in1(p, smem);          xcd_barrier(xb);
    phase_gates(p, smem);        xcd_barrier(xb);
    phase_gla(p, smem);          xcd_barrier(xb);
    phase_combine(p);            xcd_barrier(xb);
    phase_out_ln<true>(p, smem);
}

extern "C" void kernel_launch(void* const* d_in, const int* in_sizes, int n_in, void* d_out, int out_size, void* d_ws, size_t ws_size, hipStream_t stream) {
    static int grid_blocks = 0;
    if (!grid_blocks) {
        int dev = 0, cus = 0, per_cu = 0;
        hipGetDevice(&dev);
        hipDeviceGetAttribute(&cus, hipDeviceAttributeMultiprocessorCount, dev);
        hipFuncSetAttribute((const void*)fwd_megakernel, hipFuncAttributeMaxDynamicSharedMemorySize, LDS_BYTES);
        hipOccupancyMaxActiveBlocksPerMultiprocessor(&per_cu, (const void*)fwd_megakernel, NTHR, LDS_BYTES);
        if (per_cu < 1) { fprintf(stderr, "occupancy query says %d blocks/CU\n", per_cu); per_cu = 1; }
        grid_blocks = cus * per_cu;
        if (ws_size < WS_A5 + 16 * MiB) fprintf(stderr, "workspace too small: %zu\n", ws_size);
    }
    Params p{};
    p.xp = (const float*)d_in[0]; p.xs = (const float*)d_in[1]; p.w0in = (const float*)d_in[2]; p.sink = (const float*)d_in[3];
    p.w0out = (const float*)d_in[4]; p.ln0g = (const float*)d_in[5]; p.ln0b = (const float*)d_in[6]; p.w1in = (const float*)d_in[7];
    p.wgf = (const float*)d_in[8]; p.bgf = (const float*)d_in[9]; p.wgb = (const float*)d_in[10]; p.bgb = (const float*)d_in[11];
    p.hnorm = (const float*)d_in[12]; p.w1out = (const float*)d_in[13]; p.ln1g = (const float*)d_in[14]; p.ln1b = (const float*)d_in[15];
    p.out = (float*)d_out; p.ws = (unsigned char*)d_ws;
    void* args[] = {&p};
    hipError_t e = hipLaunchCooperativeKernel((const void*)fwd_megakernel, dim3(grid_blocks), dim3(NTHR), args, LDS_BYTES, stream);
    if (e != hipSuccess) fprintf(stderr, "cooperative launch failed: %s (grid %d)\n", hipGetErrorString(e), grid_blocks);
}
```

```cpp
#include <hip/hip_runtime.h>
#include <hip/hip_cooperative_groups.h>
#include <cstdio>
#include <type_traits>
namespace cg = cooperative_groups;

typedef unsigned short bf16_t;
typedef short bf16x8 __attribute__((ext_vector_type(8)));
typedef short s16x4 __attribute__((ext_vector_type(4)));
typedef float f32x16 __attribute__((ext_vector_type(16)));
typedef float f32x4 __attribute__((ext_vector_type(4)));
typedef float f32x2 __attribute__((ext_vector_type(2)));
typedef unsigned u32x4 __attribute__((ext_vector_type(4)));
typedef unsigned u32x2 __attribute__((ext_vector_type(2)));
typedef __bf16 bfv2 __attribute__((ext_vector_type(2)));
#define DI __device__ __forceinline__
#define MFMA32(a, b, c) __builtin_amdgcn_mfma_f32_32x32x16_bf16((a), (b), (c), 0, 0, 0)

constexpr int T_TOK = 98304, TP = 32768, SEQ = 4096, NSEQ = 24, D = 1024;
constexpr int NTHR = 512;
constexpr size_t MiB = 1048576;
constexpr size_t RB = 192 * MiB;
constexpr int LDS_BYTES = 147456 + 16;
constexpr float LOG2E = 1.4426950408889634f;
constexpr float DN_ALPHA = 1.4142135623730951f;

struct Params {
    const float *xp, *xs, *w0in, *sink, *w0out, *ln0g, *ln0b, *w1in, *wgf, *bgf, *wgb, *bgb, *hnorm, *w1out, *ln1g, *ln1b;
    float* out;
    unsigned char* ws;
};

DI unsigned pk2(float a, float b) { f32x2 v = {a, b}; bfv2 r = __builtin_convertvector(v, bfv2); return __builtin_bit_cast(unsigned, r); }
DI float bf_lo(unsigned u) { return __uint_as_float(u << 16); }
DI float bf_hi(unsigned u) { return __uint_as_float(u & 0xffff0000u); }
DI float bf2f(bf16_t v) { return __uint_as_float(((unsigned)v) << 16); }
DI bf16_t f2bf(float a) { return (bf16_t)(pk2(a, 0.f) & 0xffffu); }
DI bf16x8 pack8(const f32x16& x, int s) {
    u32x4 p = {pk2(x[8 * s], x[8 * s + 1]), pk2(x[8 * s + 2], x[8 * s + 3]), pk2(x[8 * s + 4], x[8 * s + 5]), pk2(x[8 * s + 6], x[8 * s + 7])};
    return __builtin_bit_cast(bf16x8, p);
}
DI bf16x8 cat44(s16x4 lo, s16x4 hi) { return __builtin_shufflevector(lo, hi, 0, 1, 2, 3, 4, 5, 6, 7); }
DI int opq_tid() { int t = threadIdx.x; asm volatile("" : "+v"(t)); return t; }
DI float silu(float x) { return x * __builtin_amdgcn_rcpf(1.0f + __builtin_amdgcn_exp2f(-1.4426950408889634f * x)); }
DI const float* xrow(const Params& p, int t) { return t < TP ? p.xp + (size_t)t * D : p.xs + (size_t)(t - TP) * D; }

constexpr size_t WS_WT0IN = 0, WS_WT0OUT = WS_WT0IN + 2560 * 1024 * 2, WS_WT1IN = WS_WT0OUT + 1024 * 1024 * 2, WS_WT1OUT = WS_WT1IN + 3104 * 1024 * 2;
constexpr size_t WS_A0 = 16 * MiB, WS_A1 = WS_A0 + RB, WS_A2 = WS_A1 + RB, WS_A3 = WS_A2 + RB, WS_A4 = WS_A3 + RB, WS_A5 = WS_A4 + RB;
constexpr size_t WS_K0 = WS_A3, WS_V0T = WS_A3 + 48 * MiB;
constexpr size_t WS_ELF = WS_A5, WS_ELB = WS_A5 + 1536 * 512 * 4;
constexpr size_t WS_STAT0 = WS_A5 + 6 * MiB, WS_STAT1 = WS_STAT0 + 3 * MiB, WS_CNT = WS_STAT1 + 3 * MiB, WS_XBAR = WS_CNT + 4096;

DI void phase_convert(const Params& p, unsigned char* smem) {
    bf16_t* xb = (bf16_t*)(p.ws + WS_A0);
    const int tid = opq_tid();
    const size_t n8 = (size_t)T_TOK * D / 8;
    const size_t stride = (size_t)gridDim.x * NTHR;
    size_t i = (size_t)blockIdx.x * NTHR + tid;
    for (; i + 3 * stride < n8; i += 4 * stride) {
        f32x4 a[4], b[4];
#pragma unroll
        for (int q = 0; q < 4; ++q) { const size_t e = (i + q * stride) * 8; const float* src = xrow(p, (int)(e >> 10)) + (e & 1023); a[q] = *(const f32x4*)src; b[q] = *(const f32x4*)(src + 4); }
        asm volatile("" : "+v"(a[0]), "+v"(a[1]), "+v"(a[2]), "+v"(a[3]), "+v"(b[0]), "+v"(b[1]), "+v"(b[2]), "+v"(b[3]));
#pragma unroll
        for (int q = 0; q < 4; ++q) { u32x4 o = {pk2(a[q][0], a[q][1]), pk2(a[q][2], a[q][3]), pk2(b[q][0], b[q][1]), pk2(b[q][2], b[q][3])}; *(u32x4*)(xb + (i + q * stride) * 8) = o; }
    }
    for (; i < n8; i += stride) {
        const size_t e = i * 8; const int t = (int)(e >> 10);
        const float* src = xrow(p, t) + (e & 1023);
        const f32x4 a = *(const f32x4*)src, b = *(const f32x4*)(src + 4);
        u32x4 o = {pk2(a[0], a[1]), pk2(a[2], a[3]), pk2(b[0], b[1]), pk2(b[2], b[3])};
        *(u32x4*)(xb + e) = o;
    }
    if (blockIdx.x == 0) { for (int i = tid; i < 768; i += NTHR) ((unsigned*)(p.ws + WS_CNT))[i] = 0u;
        for (int i = tid; i < 3456; i += NTHR) ((unsigned*)(p.ws + WS_XBAR))[i] = 0u; }
    float* tile = (float*)smem;
    for (int u = blockIdx.x; u < 3856; u += gridDim.x) {
        int v = u; const float* W; bf16_t* Wt; int N;
        if (v < 1280) { W = p.w0in; Wt = (bf16_t*)(p.ws + WS_WT0IN); N = 2560; }
        else if ((v -= 1280) < 512) { W = p.w0out; Wt = (bf16_t*)(p.ws + WS_WT0OUT); N = 1024; }
        else if ((v -= 512) < 1552) { W = p.w1in; Wt = (bf16_t*)(p.ws + WS_WT1IN); N = 3104; }
        else { v -= 1552; W = p.w1out; Wt = (bf16_t*)(p.ws + WS_WT1OUT); N = 1024; }
        const int nn32 = N / 32, nt = v % nn32, kt = v / nn32;
#pragma unroll
        for (int q = 0; q < 4; ++q) { const int e = tid + NTHR * q, kk = e >> 5, nn = e & 31; tile[kk * 33 + nn] = W[(size_t)(kt * 64 + kk) * N + nt * 32 + nn]; }
        __syncthreads();
#pragma unroll
        for (int q = 0; q < 2; ++q) { const int e = tid + NTHR * q, nn = e >> 5, kp = e & 31;
            *(unsigned*)(Wt + (size_t)(nt * 32 + nn) * 1024 + kt * 64 + 2 * kp) = pk2(tile[(2 * kp) * 33 + nn], tile[(2 * kp + 1) * 33 + nn]); }
        __syncthreads();
    }
}

DI void gemm_kloop(const bf16_t* __restrict__ P, const bf16_t* __restrict__ Q, const bf16_t* __restrict__ nP, const bf16_t* __restrict__ nQ, bool first,
                   unsigned char* smem, f32x16 (&acc)[4][2], u32x4 (&rp)[4], u32x4 (&rq)[4], int tid) {
    const int lane = tid & 63, wid = tid >> 6, wi = wid >> 2, wj = wid & 3, r = lane & 31, h = lane >> 5;
    const int crow = tid >> 3, ccol = (tid & 7) * 8;
#pragma unroll
    for (int a = 0; a < 4; ++a)
#pragma unroll
        for (int b = 0; b < 2; ++b)
#pragma unroll
            for (int i = 0; i < 16; ++i) acc[a][b][i] = 0.f;
    const unsigned char* Pb = (const unsigned char*)P;
    const unsigned char* Qb = (const unsigned char*)Q;
    const unsigned char* nPb = (const unsigned char*)nP;
    const unsigned char* nQb = (const unsigned char*)nQ;
    const unsigned voff = (unsigned)(crow * 1024 + ccol) * 2u;
    unsigned char* sw = smem + (crow * 72 + ccol) * 2;
    if (first) {
#pragma unroll
        for (int u = 0; u < 4; ++u) { rp[u] = *(const u32x4*)(Pb + (size_t)u * 131072 + voff); rq[u] = *(const u32x4*)(Qb + (size_t)u * 131072 + voff); }
    }
#pragma unroll
    for (int u = 0; u < 4; ++u) { *(u32x4*)(sw + u * 64 * 144) = rp[u]; *(u32x4*)(sw + 36864 + u * 64 * 144) = rq[u]; }
#pragma unroll
    for (int u = 0; u < 4; ++u) { rp[u] = *(const u32x4*)(Pb + (size_t)u * 131072 + 128 + voff); rq[u] = *(const u32x4*)(Qb + (size_t)u * 131072 + 128 + voff); }
    __syncthreads();
    const unsigned char* fpb = smem + ((wi * 128 + r) * 72 + h * 8) * 2;
    const unsigned char* fqb = smem + 36864 + ((wj * 64 + r) * 72 + h * 8) * 2;
    for (int kt = 0; kt < 16; ++kt) {
        const int cur = kt & 1;
        const unsigned char* bp = fpb + cur * 73728;
        const unsigned char* bq = fqb + cur * 73728;
        unsigned char* d = sw + (cur ^ 1) * 73728;
        const unsigned char* Pk = (kt + 2 < 16) ? Pb + (kt + 2) * 128 : nPb;
        const unsigned char* Qk = (kt + 2 < 16) ? Qb + (kt + 2) * 128 : nQb;
        const bool stage = kt + 1 < 16;
        bf16x8 fp[2][4], fq[2][2];
#pragma unroll
        for (int a = 0; a < 4; ++a) fp[0][a] = *(const bf16x8*)(bp + a * 32 * 144);
#pragma unroll
        for (int b = 0; b < 2; ++b) fq[0][b] = *(const bf16x8*)(bq + b * 32 * 144);
        __builtin_amdgcn_sched_barrier(0);
#pragma unroll
        for (int s = 0; s < 4; ++s) {
            if (s < 3) {
#pragma unroll
                for (int a = 0; a < 4; ++a) fp[(s + 1) & 1][a] = *(const bf16x8*)(bp + a * 32 * 144 + (s + 1) * 32);
#pragma unroll
                for (int b = 0; b < 2; ++b) fq[(s + 1) & 1][b] = *(const bf16x8*)(bq + b * 32 * 144 + (s + 1) * 32);
            }
            if (stage) {
                *(u32x4*)(d + s * 64 * 144) = rp[s];
                *(u32x4*)(d + 36864 + s * 64 * 144) = rq[s];
                rp[s] = *(const u32x4*)(Pk + (size_t)s * 131072 + voff);
                rq[s] = *(const u32x4*)(Qk + (size_t)s * 131072 + voff);
            }
#pragma unroll
            for (int a = 0; a < 4; ++a)
#pragma unroll
                for (int b = 0; b < 2; ++b) acc[a][b] = MFMA32(fp[s & 1][a], fq[s & 1][b], acc[a][b]);
            __builtin_amdgcn_sched_barrier(0);
        }
        __syncthreads();
    }
}

template <class TF, class ST> DI void gemm_tile_bf16(const bf16_t* __restrict__ P, const bf16_t* __restrict__ Q, const bf16_t* __restrict__ nP, const bf16_t* __restrict__ nQ, bool first,
                                                 u32x4 (&rp)[4], u32x4 (&rq)[4], unsigned char* smem, TF tf, ST st) {
    const int tid = opq_tid(), lane = tid & 63, wid = tid >> 6, wi = wid >> 2, wj = wid & 3, r = lane & 31, h = lane >> 5;
    f32x16 acc[4][2];
    gemm_kloop(P, Q, nP, nQ, first, smem, acc, rp, rq, tid);
#pragma unroll
    for (int a = 0; a < 4; ++a)
#pragma unroll
        for (int b = 0; b < 2; ++b)
#pragma unroll
            for (int g = 0; g < 4; ++g) {
                const int i0 = wi * 128 + a * 32 + 8 * g + 4 * h, j = wj * 64 + b * 32 + r;
                f32x4 v = {acc[a][b][4 * g], acc[a][b][4 * g + 1], acc[a][b][4 * g + 2], acc[a][b][4 * g + 3]};
                v = tf(v, i0, j);
                u32x2 o = {pk2(v[0], v[1]), pk2(v[2], v[3])};
                *(u32x2*)(smem + j * 528 + i0 * 2) = o;
            }
    __syncthreads();
#pragma unroll 4
    for (int q = 0; q < 16; ++q) {
        const int c = tid + NTHR * q, j = c >> 5, ch = c & 31;
        const u32x4 w = *(const u32x4*)(smem + j * 528 + ch * 16);
        st(j, ch * 8, w);
    }
    __syncthreads();
}

DI bool gemm_unit(int it, int nN, int& pm, int& nt) {
    const int G = gridDim.x;
    if ((G & 7) == 0) {
        const int xcd = blockIdx.x & 7, l = blockIdx.x >> 3, per = G >> 3;
        const int u = it * per + l;
        if (u >= 48 * nN) return false;
        pm = (u / nN) * 8 + xcd; nt = u % nN; return true;
    } else {
        const int u = it * G + blockIdx.x;
        if (u >= 384 * nN) return false;
        pm = u / nN; nt = u % nN; return true;
    }
}

DI size_t qk_off(int sq, int hd, int ch) { return ((size_t)((sq * 4 + hd) * 64 + ch)) * 16384; }
DI size_t v1_off(int sq, int hd, int ch) { return ((size_t)((sq * 4 + hd) * 64 + ch)) * 16384; }
DI void st_bf4(bf16_t* dst, f32x4 v) { u32x2 o = {pk2(v[0], v[1]), pk2(v[2], v[3])}; *(u32x2*)dst = o; }

namespace pg8 {
#define PG8_LAS __attribute__((address_space(3)))
typedef unsigned short bf16_t;
typedef short bf16x8 __attribute__((ext_vector_type(8)));
typedef float f32x4 __attribute__((ext_vector_type(4)));
typedef unsigned u32x4 __attribute__((ext_vector_type(4)));
constexpr int BM = 256, BK = 64, HALF = 128, HTB = HALF * BK * 2  , STAGE_BYTES = 8 * HTB, NXCD = 8, WGM = 8;

__host__ __device__ __forceinline__ int lds_byte(int r, int c) { const int st = (r >> 4) * 2 + (c >> 5), rr = r & 15, cc = c & 31, ob = rr * 64 + cc * 2; return st * 1024 + (ob ^ (((ob >> 9) & 1) << 5)); }
__host__ __device__ __forceinline__ void stage_rc(int b, int& R, int& C) { const int st = b / 1024, sb = b % 1024, swz = sb ^ (((sb >> 9) & 1) << 5); R = (st >> 1) * 16 + swz / 64; C = (st & 1) * 32 + (swz % 64) / 2; }
__host__ __device__ __forceinline__ int perm32(int rho) { const int n = rho >> 4, i = rho & 15; return 8 * (i >> 2) + 4 * n + (i & 3); }

struct Unit { int pm, pn; };
struct Gemm { const bf16_t* A; const bf16_t* Bt; int M, N, K; };

struct StaticOrder {
    int nM, nN, nwg, G, c;
    __host__ __device__ void init(int M, int N, int G_, int c_) { nM = M / BM; nN = N / BM; nwg = nM * nN; G = G_; c = c_; }
    __host__ __device__ bool next(int i, Unit& u) const {
        const long L = (long)i * G + c; if (L >= nwg) return false;
        int wgid = (int)L; { const int q = nwg / NXCD, r = nwg % NXCD, xcd = wgid % NXCD, off = wgid / NXCD; wgid = (xcd < r ? xcd * (q + 1) : r * (q + 1) + (xcd - r) * q) + off; }
        const int nig = WGM * nN, gid = wgid / nig, fm = gid * WGM, gsz = (nM - fm) < WGM ? (nM - fm) : WGM;
        u.pm = fm + ((wgid % nig) % gsz); u.pn = (wgid % nig) / gsz; return true;
    }
    __device__ __forceinline__ void a_ready(const Unit&) const {}
    __device__ __forceinline__ void done(const Unit&) const {}
};
struct CountedOrder : StaticOrder {
    const unsigned* ready; unsigned need; unsigned* tmo;
    __device__ __forceinline__ void a_ready(const Unit& u) const {
        if (threadIdx.x < 64) {
            const unsigned long long t0 = __builtin_amdgcn_s_memrealtime(); unsigned polls = 0;
            while ((unsigned)__builtin_amdgcn_readfirstlane(__hip_atomic_load(ready + 64 * u.pm, __ATOMIC_RELAXED, __HIP_MEMORY_SCOPE_AGENT)) < need) {
                if ((++polls & 255u) == 0u && __builtin_amdgcn_readfirstlane(__hip_atomic_load(tmo, __ATOMIC_RELAXED, __HIP_MEMORY_SCOPE_AGENT)) != 0u) break;
                if (__builtin_amdgcn_s_memrealtime() - t0 > 2000000ull) {
                    if (threadIdx.x == 0) { unsigned expect = 0u; __hip_atomic_compare_exchange_strong(tmo + 1, &expect, 0x600u | (unsigned)(u.pm & 0xff), __ATOMIC_RELAXED, __ATOMIC_RELAXED, __HIP_MEMORY_SCOPE_AGENT); __hip_atomic_store(tmo, 1u, __ATOMIC_RELAXED, __HIP_MEMORY_SCOPE_AGENT); }
                    break; }
                __builtin_amdgcn_s_sleep(2); }
            __builtin_amdgcn_fence(__ATOMIC_ACQUIRE, "agent");
            asm volatile("s_waitcnt vmcnt(0)" ::: "memory");
        }
#if !defined(BROKEN_HOOK_NO_BARRIER)
        asm volatile("" ::: "memory"); __builtin_amdgcn_s_barrier(); asm volatile("" ::: "memory");
#endif
    }
};

__device__ __forceinline__ unsigned cvt_pk_bf16(float lo, float hi) { unsigned r; asm volatile("v_cvt_pk_bf16_f32 %0, %1, %2" : "=v"(r) : "v"(lo), "v"(hi)); return r; }
typedef float f32x2 __attribute__((ext_vector_type(2)));
__device__ __forceinline__ f32x2 gelu_pk(f32x2 v) {
    const f32x2 av = __builtin_elementwise_abs(v), d = av * 0.2316418882f + 1.0f;
    f32x2 t; t.x = __builtin_amdgcn_rcpf(d.x); t.y = __builtin_amdgcn_rcpf(d.y);
    f32x2 q = t * 0.5307027145f + (-0.7265760135f); q = q * t + 0.7107068705f; q = q * t + (-0.142248368f); q = q * t + 0.127414796f; q = q * t;
    const f32x2 s = (v * v) * (-0.72134752044f);
    f32x2 e; e.x = __builtin_amdgcn_exp2f(s.x); e.y = __builtin_amdgcn_exp2f(s.y);
    const f32x2 m = v * (q * e), r = v - m;
    f32x2 o; o.x = v.x < 0.f ? m.x : r.x; o.y = v.y < 0.f ? m.y : r.y; return o;
}

struct EpiF32 {
    static constexpr bool PERM = false, AFTER_DRAIN = false;
    float* C; int ldc; const float* bias;
    __device__ __forceinline__ void operator()(const f32x4 (&acc)[2][2][4][2], const Unit& u, int wr, int wc, int fr, int fq) const {
        const int row0 = u.pm * BM + wr * 64 + fr, col0 = u.pn * BM + wc * 32 + 4 * fq;
        f32x4 bv[2][2];
#pragma unroll
        for (int bj = 0; bj < 2; ++bj)
#pragma unroll
            for (int n = 0; n < 2; ++n) bv[bj][n] = bias ? *(const f32x4*)(bias + col0 + bj * HALF + n * 16) : (f32x4){0.f, 0.f, 0.f, 0.f};
#pragma unroll
        for (int ai = 0; ai < 2; ++ai)
#pragma unroll
            for (int m = 0; m < 4; ++m) { float* rowp = C + (size_t)(row0 + ai * HALF + m * 16) * ldc + col0;
#pragma unroll
                for (int bj = 0; bj < 2; ++bj)
#pragma unroll
                    for (int n = 0; n < 2; ++n) *(f32x4*)(rowp + bj * HALF + n * 16) = acc[ai][bj][m][n] + bv[bj][n]; }
    }
};
template <int ACT  > struct EpiBf16 {
    static constexpr bool PERM = true, AFTER_DRAIN = false;
    bf16_t* O; int ldc; const float* bias; int split_cols; size_t split_stride;
    __device__ __forceinline__ void operator()(const f32x4 (&acc)[2][2][4][2], const Unit& u, int wr, int wc, int fr, int fq) const {
        const int row0 = u.pm * BM + wr * 64 + fr; int colt = u.pn * BM; bf16_t* base = O;
        if (split_cols) { const int t = colt / split_cols; base += (size_t)t * split_stride; colt -= t * split_cols; }
        const int col0 = colt + wc * 32 + 8 * fq, bcol0 = u.pn * BM + wc * 32 + 8 * fq;
        f32x4 bv[2][2];
#pragma unroll
        for (int bj = 0; bj < 2; ++bj)
#pragma unroll
            for (int n = 0; n < 2; ++n) bv[bj][n] = bias ? *(const f32x4*)(bias + bcol0 + bj * HALF + 4 * n) : (f32x4){0.f, 0.f, 0.f, 0.f};
#pragma unroll
        for (int ai = 0; ai < 2; ++ai)
#pragma unroll
            for (int m = 0; m < 4; ++m) { bf16_t* rowp = base + (size_t)(row0 + ai * HALF + m * 16) * ldc + col0;
#pragma unroll
                for (int bj = 0; bj < 2; ++bj) { f32x4 v0 = acc[ai][bj][m][0] + bv[bj][0], v1 = acc[ai][bj][m][1] + bv[bj][1];
                    if (ACT == 1) { f32x2 a = gelu_pk((f32x2){v0[0], v0[1]}), b = gelu_pk((f32x2){v0[2], v0[3]}), c = gelu_pk((f32x2){v1[0], v1[1]}), d = gelu_pk((f32x2){v1[2], v1[3]});
                        v0 = (f32x4){a.x, a.y, b.x, b.y}; v1 = (f32x4){c.x, c.y, d.x, d.y}; }
                    if (ACT == 2) {
#pragma unroll
                        for (int j = 0; j < 4; ++j) { v0[j] = 0.5f * v0[j] * (1.0f + erff(v0[j] * 0.70710678f)); v1[j] = 0.5f * v1[j] * (1.0f + erff(v1[j] * 0.70710678f)); } }
                    u32x4 w; w.x = cvt_pk_bf16(v0[0], v0[1]); w.y = cvt_pk_bf16(v0[2], v0[3]); w.z = cvt_pk_bf16(v1[0], v1[1]); w.w = cvt_pk_bf16(v1[2], v1[3]);
                    *(u32x4*)(rowp + bj * HALF) = w; } }
    }
};

struct PanelStats {
    unsigned* xbuf;
    unsigned* cnt;
    unsigned* tmo;
    int ntn; float eps;
    unsigned code;
    __device__ __forceinline__ bool run(const f32x4 (&v)[2][2][4][2], const Unit& u, int wr, int wc, int fr, int fq, PG8_LAS unsigned char* lds, int wid, int lane) const {
        typedef float f32x2v __attribute__((ext_vector_type(2)));
        PG8_LAS f32x2v* P = (PG8_LAS f32x2v*)lds;
        PG8_LAS f32x2v* S = (PG8_LAS f32x2v*)(lds + 8192);
        PG8_LAS unsigned* flag = (PG8_LAS unsigned*)(lds + 8192 + 2048);
#pragma unroll
        for (int ai = 0; ai < 2; ++ai)
#pragma unroll
            for (int m = 0; m < 4; ++m) {
                float s = 0.f;
#pragma unroll
                for (int bj = 0; bj < 2; ++bj)
#pragma unroll
                    for (int n = 0; n < 2; ++n) { const f32x4 x = v[ai][bj][m][n]; s += (x[0] + x[1]) + (x[2] + x[3]); }
                s += __shfl_xor(s, 16); s += __shfl_xor(s, 32);
                const float mw = s * (1.0f / 64.0f); float q = 0.f;
#pragma unroll
                for (int bj = 0; bj < 2; ++bj)
#pragma unroll
                    for (int n = 0; n < 2; ++n) { const f32x4 d = v[ai][bj][m][n] - mw; q += (d[0] * d[0] + d[1] * d[1]) + (d[2] * d[2] + d[3] * d[3]); }
                q += __shfl_xor(q, 16); q += __shfl_xor(q, 32);
                if (fq == 0) P[(ai * HALF + wr * 64 + m * 16 + fr) * 4 + wc] = (f32x2v){mw, q};
            }
        asm volatile("s_waitcnt lgkmcnt(0)" ::: "memory"); __builtin_amdgcn_s_barrier(); asm volatile("" ::: "memory");
#if defined(BROKEN_NO_WAIT)
        if (blockIdx.x >= 64) { const long long t0 = clock64(); while (clock64() - t0 < 60000) __builtin_amdgcn_s_sleep(8); }
#endif
        const int row = wid * 32 + (lane & 31);
        if (lane < 32) {
            const f32x2v a = P[row * 4 + 0], b = P[row * 4 + 1], c = P[row * 4 + 2], d = P[row * 4 + 3];
            const float mt = (a.x + b.x + c.x + d.x) * 0.25f;
            const float da = a.x - mt, db = b.x - mt, dc = c.x - mt, dd = d.x - mt;
            const float m2 = (a.y + b.y) + (c.y + d.y) + 64.0f * ((da * da + db * db) + (dc * dc + dd * dd));
            unsigned long long* slot = (unsigned long long*)xbuf + ((size_t)(u.pm * BM + row) * 4 + u.pn);
            __hip_atomic_store(slot, ((unsigned long long)__float_as_uint(m2) << 32) | __float_as_uint(mt), __ATOMIC_RELAXED, __HIP_MEMORY_SCOPE_AGENT);
        }
        asm volatile("s_waitcnt vmcnt(0)" ::: "memory");
        if (lane == 0) __hip_atomic_fetch_add(cnt + 64 * u.pm, 1u, __ATOMIC_RELAXED, __HIP_MEMORY_SCOPE_AGENT);
        if (wid == 0) {
            bool dead = false; const unsigned long long t0 = __builtin_amdgcn_s_memrealtime(); const unsigned want = 8u * (unsigned)ntn;
            for (;;) {
#if defined(BROKEN_NO_WAIT)
                break;
#endif
                if ((unsigned)__builtin_amdgcn_readfirstlane(__hip_atomic_load(cnt + 64 * u.pm, __ATOMIC_RELAXED, __HIP_MEMORY_SCOPE_AGENT)) >= want) break;
                if (__builtin_amdgcn_s_memrealtime() - t0 > 2000000ull) {
                    if (lane == 0) { unsigned expect = 0u; __hip_atomic_compare_exchange_strong(tmo + 1, &expect, code | (unsigned)(u.pm & 0xff), __ATOMIC_RELAXED, __ATOMIC_RELAXED, __HIP_MEMORY_SCOPE_AGENT);
                                     __hip_atomic_store(tmo, 1u, __ATOMIC_RELAXED, __HIP_MEMORY_SCOPE_AGENT); }
                    dead = true; break; }
                __builtin_amdgcn_s_sleep(2);
            }
            __builtin_amdgcn_fence(__ATOMIC_ACQUIRE, "agent");
            if (lane == 0) flag[0] = dead ? 1u : 0u;
        }
        asm volatile("s_waitcnt vmcnt(0) lgkmcnt(0)" ::: "memory"); __builtin_amdgcn_s_barrier(); asm volatile("" ::: "memory");
        const bool bad = flag[0] != 0u;
        if (lane < 32) {
            const unsigned long long* slot = (const unsigned long long*)xbuf + (size_t)(u.pm * BM + row) * 4; float mt[4], m2[4]; float ms = 0.f;
#pragma unroll
            for (int t = 0; t < 4; ++t) { if (t < ntn) { const unsigned long long w = __hip_atomic_load(slot + t, __ATOMIC_RELAXED, __HIP_MEMORY_SCOPE_AGENT); mt[t] = __uint_as_float((unsigned)w); m2[t] = __uint_as_float((unsigned)(w >> 32)); } else { mt[t] = 0.f; m2[t] = 0.f; } ms += mt[t]; }
            const float mean = ms / (float)ntn; float q = 0.f;
#pragma unroll
            for (int t = 0; t < 4; ++t) if (t < ntn) { const float dm = mt[t] - mean; q += m2[t] + 256.0f * dm * dm; }
            S[row] = (f32x2v){mean, 1.0f / sqrtf(q / (256.0f * (float)ntn) + eps)};
        }
        asm volatile("s_waitcnt lgkmcnt(0)" ::: "memory"); __builtin_amdgcn_s_barrier(); asm volatile("" ::: "memory");
        return bad;
    }
};
struct EpiLnRes {
    static constexpr bool PERM = false, AFTER_DRAIN = true;
    const float* base; float* out; int ldc; const float* bias; PanelStats st; unsigned poison;
    __device__ __forceinline__ void refuse(size_t i0, size_t stride, int M, int N) const { const float q = __builtin_nanf(""); for (size_t i = i0; i < (size_t)M * N; i += stride) out[(i / N) * ldc + i % N] = q;
        if (i0 == 0) { unsigned expect = 0u; __hip_atomic_compare_exchange_strong(st.tmo + 1, &expect, 0x7f0u, __ATOMIC_RELAXED, __ATOMIC_RELAXED, __HIP_MEMORY_SCOPE_AGENT); __hip_atomic_store(st.tmo, 1u, __ATOMIC_RELAXED, __HIP_MEMORY_SCOPE_AGENT); } }
    __device__ __forceinline__ void fused(f32x4 (&acc)[2][2][4][2], const Unit& u, int wr, int wc, int fr, int fq, PG8_LAS unsigned char* lds, int wid, int lane) const {
        typedef float f32x2v __attribute__((ext_vector_type(2)));
        const PG8_LAS f32x2v* S = (const PG8_LAS f32x2v*)(lds + 8192);
        const int col0 = u.pn * BM + wc * 32 + 4 * fq;
#pragma unroll
        for (int bj = 0; bj < 2; ++bj)
#pragma unroll
            for (int n = 0; n < 2; ++n) { const f32x4 bv = bias ? *(const f32x4*)(bias + col0 + bj * HALF + n * 16) : (f32x4){0.f, 0.f, 0.f, 0.f};
#pragma unroll
                for (int ai = 0; ai < 2; ++ai)
#pragma unroll
                    for (int m = 0; m < 4; ++m) acc[ai][bj][m][n] += bv; }
        const bool bad = st.run(acc, u, wr, wc, fr, fq, lds, wid, lane) || poison != 0u;
        const float qnan = __builtin_nanf("");
#pragma unroll
        for (int ai = 0; ai < 2; ++ai)
#pragma unroll
            for (int m = 0; m < 4; ++m) { const int r = ai * HALF + wr * 64 + m * 16 + fr; const f32x2v sr = S[r]; const size_t off = (size_t)(u.pm * BM + r) * ldc + col0;
#pragma unroll
                for (int bj = 0; bj < 2; ++bj)
#pragma unroll
                    for (int n = 0; n < 2; ++n) { const f32x4 bs = *(const f32x4*)(base + off + bj * HALF + n * 16); f32x4 o = bs + (acc[ai][bj][m][n] - sr.x) * sr.y;
                        if (bad) o = (f32x4){qnan, qnan, qnan, qnan}; *(f32x4*)(out + off + bj * HALF + n * 16) = o; }
                asm volatile("" ::: "memory"); }
    }
};
struct EpiLnResLn {
    static constexpr bool PERM = false, AFTER_DRAIN = true;
    const float* base; float* out; bf16_t* xn; int ldc; const float* bias; PanelStats st1, st2; unsigned poison;
    __device__ __forceinline__ void refuse(size_t i0, size_t stride, int M, int N) const { const float q = __builtin_nanf(""); for (size_t i = i0; i < (size_t)M * N; i += stride) { const size_t o = (i / N) * ldc + i % N; out[o] = q; xn[o] = (bf16_t)0x7fc0u; }
        if (i0 == 0) { unsigned expect = 0u; __hip_atomic_compare_exchange_strong(st1.tmo + 1, &expect, 0x7f0u, __ATOMIC_RELAXED, __ATOMIC_RELAXED, __HIP_MEMORY_SCOPE_AGENT); __hip_atomic_store(st1.tmo, 1u, __ATOMIC_RELAXED, __HIP_MEMORY_SCOPE_AGENT); } }
    __device__ __forceinline__ void fused(f32x4 (&acc)[2][2][4][2], const Unit& u, int wr, int wc, int fr, int fq, PG8_LAS unsigned char* lds, int wid, int lane) const {
        typedef float f32x2v __attribute__((ext_vector_type(2))); typedef unsigned u32x2v __attribute__((ext_vector_type(2)));
        const PG8_LAS f32x2v* S = (const PG8_LAS f32x2v*)(lds + 8192);
        const int col0 = u.pn * BM + wc * 32 + 4 * fq;
#pragma unroll
        for (int bj = 0; bj < 2; ++bj)
#pragma unroll
            for (int n = 0; n < 2; ++n) { const f32x4 bv = bias ? *(const f32x4*)(bias + col0 + bj * HALF + n * 16) : (f32x4){0.f, 0.f, 0.f, 0.f};
#pragma unroll
                for (int ai = 0; ai < 2; ++ai)
#pragma unroll
                    for (int m = 0; m < 4; ++m) acc[ai][bj][m][n] += bv; }
        bool bad = st1.run(acc, u, wr, wc, fr, fq, lds, wid, lane) || poison != 0u;
        const float qnan = __builtin_nanf("");
#pragma unroll
        for (int ai = 0; ai < 2; ++ai)
#pragma unroll
            for (int m = 0; m < 4; ++m) { const int r = ai * HALF + wr * 64 + m * 16 + fr; const f32x2v sr = S[r]; const size_t off = (size_t)(u.pm * BM + r) * ldc + col0;
#pragma unroll
                for (int bj = 0; bj < 2; ++bj)
#pragma unroll
                    for (int n = 0; n < 2; ++n) { const f32x4 bs = *(const f32x4*)(base + off + bj * HALF + n * 16); acc[ai][bj][m][n] = bs + (acc[ai][bj][m][n] - sr.x) * sr.y; }
                asm volatile("" : "+v"(acc[ai][0][m][0]), "+v"(acc[ai][0][m][1]), "+v"(acc[ai][1][m][0]), "+v"(acc[ai][1][m][1]));
                if (m & 1) asm volatile("" ::: "memory"); }
        const bool bad1 = bad;
        bad = st2.run(acc, u, wr, wc, fr, fq, lds, wid, lane) || bad;
#pragma unroll
        for (int ai = 0; ai < 2; ++ai)
#pragma unroll
            for (int m = 0; m < 4; ++m) { const int r = ai * HALF + wr * 64 + m * 16 + fr; const f32x2v sr = S[r]; const size_t off = (size_t)(u.pm * BM + r) * ldc + col0;
#pragma unroll
                for (int bj = 0; bj < 2; ++bj)
#pragma unroll
                    for (int n = 0; n < 2; ++n) { const f32x4 x1 = acc[ai][bj][m][n]; *(f32x4*)(out + off + bj * HALF + n * 16) = bad1 ? (f32x4){qnan, qnan, qnan, qnan} : x1;
                        const f32x4 o = (x1 - sr.x) * sr.y; u32x2v w; w.x = cvt_pk_bf16(o[0], o[1]); w.y = cvt_pk_bf16(o[2], o[3]);
                        if (bad) { w.x = 0x7fc07fc0u; w.y = 0x7fc07fc0u; } *(u32x2v*)(xn + off + bj * HALF + n * 16) = w; }
                asm volatile("" ::: "memory"); }
    }
};

template <class Epi, class Sched, bool STAMP = false>
__device__ __forceinline__ void gemm_phase(PG8_LAS unsigned char* lds, const Gemm g, const Sched& S, const Epi& E, unsigned long long* stamps) {
    const int tid = threadIdx.x, wid = __builtin_amdgcn_readfirstlane(tid >> 6), lane = tid & 63, wr = wid >> 2, wc = wid & 3, fr = lane & 15, fq = lane >> 4;
    const int K = g.K, nt = K / BK;
    int ts_lo = 0, ts_hi = 0, nts = 0; const unsigned long long rt_entry = STAMP ? (unsigned long long)wall_clock64() : 0ull;
#define PG8_STAMP() do { if (STAMP && wid == 0 && nts < 64) { const unsigned long long _c = (unsigned long long)clock64(); \
        ts_lo = (lane == nts) ? (int)(unsigned)_c : ts_lo; ts_hi = (lane == nts) ? (int)(unsigned)(_c >> 32) : ts_hi; ++nts; } } while (0)
    PG8_STAMP();
    unsigned voffA[2], voffB[2];
#pragma unroll
    for (int i = 0; i < 2; ++i) { int R, C; stage_rc(tid * 16 + i * 8192, R, C); const int Rb = Epi::PERM ? ((R & ~31) + perm32(R & 31)) : R;
        voffA[i] = (unsigned)(R * K + C) * 2u; voffB[i] = (unsigned)(Rb * K + C) * 2u; }
    const size_t kstep = (size_t)(BK * 2);
    const size_t hstep = (size_t)HALF * K * 2;
    const size_t tstep = 2 * hstep;
    const unsigned ldsw = (unsigned)wid * 1024u;
    const int aoff = lds_byte(wr * 64 + fr, fq * 8), boff = lds_byte(wc * 32 + fr, fq * 8);
#define PG8_SA(b, h) (((b) * 2 + (h)) * HTB)
#define PG8_SB(b, h) ((4 + (b) * 2 + (h)) * HTB)
#define PG8_STAGE(bufoff, gbase, voff) do { _Pragma("unroll") for (int _i = 0; _i < 2; ++_i) \
        __builtin_amdgcn_global_load_lds((const unsigned*)((const char*)(gbase) + (voff)[_i]), (PG8_LAS unsigned*)(lds + (bufoff) + ldsw + _i * 8192), 16, 0, 0); } while (0)
#define PG8_LDA(dst, b, h) do { _Pragma("unroll") for (int m = 0; m < 4; ++m) _Pragma("unroll") for (int k = 0; k < 2; ++k) dst[m][k] = *(const PG8_LAS bf16x8*)(lds + PG8_SA(b, h) + aoff + m * 2048 + k * 1024); } while (0)
#define PG8_LDB(dst, b, h) do { _Pragma("unroll") for (int n = 0; n < 2; ++n) _Pragma("unroll") for (int k = 0; k < 2; ++k) dst[n][k] = *(const PG8_LAS bf16x8*)(lds + PG8_SB(b, h) + boff + n * 2048 + k * 1024); } while (0)
#define PG8_MMA(ai, bj, At, Bt) do { __builtin_amdgcn_s_setprio(1); _Pragma("unroll") for (int m = 0; m < 4; ++m) _Pragma("unroll") for (int n = 0; n < 2; ++n) _Pragma("unroll") for (int k = 0; k < 2; ++k) \
        acc[ai][bj][m][n] = __builtin_amdgcn_mfma_f32_16x16x32_bf16(Bt[n][k], At[m][k], acc[ai][bj][m][n], 0, 0, 0); __builtin_amdgcn_s_setprio(0); } while (0)
#define PG8_WAIT_V(n) asm volatile("s_waitcnt vmcnt(" #n ")" ::: "memory")
#define PG8_WAIT_L(n) asm volatile("s_waitcnt lgkmcnt(" #n ")" ::: "memory")
#define PG8_BAR __builtin_amdgcn_s_barrier()
#define PG8_SCHED __builtin_amdgcn_sched_barrier(0)
    Unit cur, nxt; int ui = 0;
    if (!S.next(0, cur)) return;
    f32x4 acc[2][2][4][2];
#pragma unroll
    for (int a = 0; a < 2; ++a)
#pragma unroll
        for (int b = 0; b < 2; ++b)
#pragma unroll
            for (int m = 0; m < 4; ++m)
#pragma unroll
                for (int n = 0; n < 2; ++n) acc[a][b][m][n] = (f32x4){0.f, 0.f, 0.f, 0.f};
    bf16x8 At[4][2], B0[2][2], B1[2][2];
    const char* cA = (const char*)g.A + (size_t)cur.pm * tstep; const char* cB = (const char*)g.Bt + (size_t)cur.pn * tstep;
    S.a_ready(cur);
    PG8_STAGE(PG8_SB(0, 0), cB, voffB); PG8_STAGE(PG8_SA(0, 0), cA, voffA); PG8_STAGE(PG8_SB(0, 1), cB + hstep, voffB); PG8_STAGE(PG8_SA(0, 1), cA + hstep, voffA);
    if (wr == 1) PG8_BAR;
    PG8_WAIT_V(4); PG8_BAR;
    PG8_STAGE(PG8_SB(1, 0), cB + kstep, voffB); PG8_STAGE(PG8_SA(1, 0), cA + kstep, voffA); PG8_STAGE(PG8_SB(1, 1), cB + hstep + kstep, voffB);
    PG8_WAIT_V(6); PG8_BAR;
    PG8_STAMP();
    for (;;) {
        const bool has_next = S.next(ui + 1, nxt);
        const char* nA = has_next ? (const char*)g.A + (size_t)nxt.pm * tstep : cA; const char* nB = has_next ? (const char*)g.Bt + (size_t)nxt.pn * tstep : cB;
        for (int t = 0; t < nt; t += 2) {
            const bool last = (t == nt - 2);
            const char* a1 = cA + (size_t)(t + 1) * kstep;
            const char* a2 = last ? nA : cA + (size_t)(t + 2) * kstep; const char* b2 = last ? nB : cB + (size_t)(t + 2) * kstep;
            const char* a3 = a2 + kstep; const char* b3 = b2 + kstep;
            if (last && has_next) S.a_ready(nxt);
            PG8_LDB(B0, 0, 0); PG8_SCHED; PG8_LDA(At, 0, 0); PG8_STAGE(PG8_SA(1, 1), a1 + hstep, voffA);
            PG8_WAIT_L(8); PG8_BAR; PG8_WAIT_L(0); PG8_MMA(0, 0, At, B0); PG8_BAR; PG8_SCHED;
            PG8_LDB(B1, 0, 1); PG8_STAGE(PG8_SB(0, 0), b2, voffB);
            PG8_BAR; PG8_WAIT_L(0); PG8_MMA(0, 1, At, B1); PG8_BAR;
            PG8_LDA(At, 0, 1); PG8_STAGE(PG8_SA(0, 0), a2, voffA);
            PG8_BAR; PG8_WAIT_L(0); PG8_MMA(1, 0, At, B0); PG8_BAR; PG8_SCHED;
            PG8_STAGE(PG8_SB(0, 1), b2 + hstep, voffB);
            PG8_WAIT_V(6); PG8_BAR; PG8_MMA(1, 1, At, B1); PG8_BAR;
            PG8_LDB(B0, 1, 0); PG8_SCHED; PG8_LDA(At, 1, 0); PG8_STAGE(PG8_SA(0, 1), a2 + hstep, voffA);
            PG8_WAIT_L(8); PG8_BAR; PG8_WAIT_L(0); PG8_MMA(0, 0, At, B0); PG8_BAR; PG8_SCHED;
            PG8_LDB(B1, 1, 1); PG8_STAGE(PG8_SB(1, 0), b3, voffB);
            PG8_BAR; PG8_WAIT_L(0); PG8_MMA(0, 1, At, B1); PG8_BAR;
            PG8_LDA(At, 1, 1); PG8_STAGE(PG8_SA(1, 0), a3, voffA);
            PG8_BAR; PG8_WAIT_L(0); PG8_MMA(1, 0, At, B0); PG8_BAR; PG8_SCHED;
            PG8_STAGE(PG8_SB(1, 1), b3 + hstep, voffB);
            PG8_WAIT_V(6); PG8_BAR; PG8_MMA(1, 1, At, B1); PG8_BAR;
        }
        PG8_STAMP();
        if constexpr (!Epi::AFTER_DRAIN) { E(acc, cur, wr, wc, fr, fq); S.done(cur); }
        PG8_STAMP();
        if (!has_next) break;
#pragma unroll
        for (int a = 0; a < 2; ++a)
#pragma unroll
            for (int b = 0; b < 2; ++b)
#pragma unroll
                for (int m = 0; m < 4; ++m)
#pragma unroll
                    for (int n = 0; n < 2; ++n) acc[a][b][m][n] = (f32x4){0.f, 0.f, 0.f, 0.f};
        cur = nxt; cA = nA; cB = nB; ++ui;
    }
    PG8_WAIT_V(0);
    if (wr == 0) PG8_BAR;
    PG8_BAR;
    if constexpr (Epi::AFTER_DRAIN) { E.fused(acc, cur, wr, wc, fr, fq, lds, wid, lane); S.done(cur); }
    PG8_STAMP();
    if (STAMP && wid == 0) { stamps[lane] = lane < nts ? (((unsigned long long)(unsigned)ts_hi << 32) | (unsigned)ts_lo) : 0ull;
        if (lane == 62) stamps[62] = rt_entry; if (lane == 63) stamps[63] = (unsigned long long)wall_clock64(); }
#undef PG8_STAMP
#undef PG8_SA
#undef PG8_SB
#undef PG8_STAGE
#undef PG8_LDA
#undef PG8_LDB
#undef PG8_MMA
#undef PG8_WAIT_V
#undef PG8_WAIT_L
#undef PG8_BAR
#undef PG8_SCHED
}
}

struct EpiIn0 {
    static constexpr bool PERM = true, AFTER_DRAIN = false;
    bf16_t *Q0, *K0, *V0t, *G0;
    __device__ __forceinline__ void operator()(const pg8::f32x4 (&acc)[2][2][4][2], const pg8::Unit& u, int wr, int wc, int fr, int fq) const {
        const int pn = u.pn;
#pragma unroll
        for (int ai = 0; ai < 2; ++ai)
#pragma unroll
            for (int m = 0; m < 4; ++m) {
                const int t = u.pm * 256 + ai * 128 + wr * 64 + m * 16 + fr;
#pragma unroll
                for (int bj = 0; bj < 2; ++bj) {
                    const int c = bj * 128 + wc * 32 + 8 * fq;
                    pg8::f32x4 v0 = acc[ai][bj][m][0], v1 = acc[ai][bj][m][1];
                    if (pn == 5) {
                        bf16_t* d = V0t + ((size_t)((t >> 12) * 256 + c)) * 4096 + (t & 4095);
#pragma unroll
                        for (int e = 0; e < 4; ++e) { d[(size_t)e * 4096] = f2bf(v0[e]); d[(size_t)(e + 4) * 4096] = f2bf(v1[e]); }
                    } else {
                        u32x4 w = {pk2(v0[0], v0[1]), pk2(v0[2], v0[3]), pk2(v1[0], v1[1]), pk2(v1[2], v1[3])};
                        bf16_t* d = pn < 4 ? Q0 + (size_t)t * 1024 + pn * 256 + c : (pn == 4 ? K0 + (size_t)t * 256 + c : G0 + (size_t)t * 1024 + (pn - 6) * 256 + c);
                        *(u32x4*)d = w;
                    }
                }
            }
    }
};
struct EpiIn1 {
    static constexpr bool PERM = true, AFTER_DRAIN = false;
    bf16_t *QK1, *V1t, *G1;
    __device__ __forceinline__ void operator()(const pg8::f32x4 (&acc)[2][2][4][2], const pg8::Unit& u, int wr, int wc, int fr, int fq) const {
        const int pn = u.pn;
#pragma unroll
        for (int ai = 0; ai < 2; ++ai)
#pragma unroll
            for (int m = 0; m < 4; ++m) {
                const int t = u.pm * 256 + ai * 128 + wr * 64 + m * 16 + fr;
                const int sq = t >> 12, ch = (t >> 6) & 63, tok = t & 63;
#pragma unroll
                for (int bj = 0; bj < 2; ++bj) {
                    const int c = bj * 128 + wc * 32 + 8 * fq;
                    pg8::f32x4 v0 = acc[ai][bj][m][0], v1 = acc[ai][bj][m][1];
                    if (pn >= 4 && pn < 8) {
                        bf16_t* d = V1t + v1_off(sq, pn - 4, ch) + c * 64 + tok;
#pragma unroll
                        for (int e = 0; e < 4; ++e) { d[e * 64] = f2bf(v0[e]); d[(e + 4) * 64] = f2bf(v1[e]); }
                    } else if (pn < 4) {
                        const float sc = pn < 2 ? 0.08838834764831845f : 1.0f;
                        const int f = (pn & 1) * 256 + c;
                        u32x4 w = {pk2(v0[0] * sc, v0[1] * sc), pk2(v0[2] * sc, v0[3] * sc), pk2(v1[0] * sc, v1[1] * sc), pk2(v1[2] * sc, v1[3] * sc)};
                        *(u32x4*)(QK1 + qk_off(sq, f >> 7, ch) + (pn >> 1) * 8192 + tok * 128 + (f & 127)) = w;
                    } else {
                        u32x4 w = {pk2(v0[0], v0[1]), pk2(v0[2], v0[3]), pk2(v1[0], v1[1]), pk2(v1[2], v1[3])};
                        *(u32x4*)(G1 + (size_t)t * 1024 + (pn - 8) * 256 + c) = w;
                    }
                }
            }
    }
};

DI void phase_in0(const Params& p, unsigned char* smem) {
    pg8::Gemm g; g.A = (const pg8::bf16_t*)(p.ws + WS_A0); g.Bt = (const pg8::bf16_t*)(p.ws + WS_WT0IN); g.M = T_TOK; g.N = 2560; g.K = 1024;
    pg8::StaticOrder S; S.init(T_TOK, 2560, gridDim.x, blockIdx.x);
    EpiIn0 E; E.Q0 = (bf16_t*)(p.ws + WS_A1); E.G0 = (bf16_t*)(p.ws + WS_A2); E.K0 = (bf16_t*)(p.ws + WS_K0); E.V0t = (bf16_t*)(p.ws + WS_V0T);
    pg8::gemm_phase<EpiIn0, pg8::StaticOrder, false>((PG8_LAS unsigned char*)smem, g, S, E, nullptr);
}

DI void phase_attn(const Params& p, unsigned char* smem) {
    const bf16_t* Q0 = (const bf16_t*)(p.ws + WS_A1); const bf16_t* G0 = (const bf16_t*)(p.ws + WS_A2);
    const bf16_t* K0 = (const bf16_t*)(p.ws + WS_K0); const bf16_t* V0t = (const bf16_t*)(p.ws + WS_V0T);
    bf16_t* og = (bf16_t*)(p.ws + WS_A4);
    bf16_t* sK = (bf16_t*)smem;
    bf16_t* sVt = (bf16_t*)(smem + 55296);
    const int tid = opq_tid(), lane = tid & 63, wid = tid >> 6, r = lane & 31, h = lane >> 5;
    for (int u = blockIdx.x; u < NSEQ * 32 * 4; u += gridDim.x) {
        const int g = u & 3, n = (u >> 2) & 31, sq = u >> 7;
        const int kbase = (n - 1) * 128;
        __syncthreads();
        {
            const u32x4 zero4 = {0u, 0u, 0u, 0u};
            u32x4 kv[6], vv[6];
#pragma unroll
            for (int q = 0; q < 6; ++q) {
                const int c = tid + NTHR * q, row = c >> 3, cc = c & 7, kpos = kbase + row;
                const int kc = kpos < 0 ? 0 : (kpos >= SEQ ? SEQ - 1 : kpos);
                kv[q] = *(const u32x4*)(K0 + ((size_t)sq * SEQ + kc) * 256 + g * 64 + cc * 8);
            }
#pragma unroll
            for (int q = 0; q < 6; ++q) {
                const int c = tid + NTHR * q, row = c / 48, cc = c % 48, kpos = kbase + cc * 8;
                const int kc = kpos < 0 ? 0 : (kpos >= SEQ ? SEQ - 8 : kpos);
                vv[q] = *(const u32x4*)(V0t + ((size_t)(sq * 256 + g * 64 + row)) * 4096 + kc);
            }
#pragma unroll
            for (int q = 0; q < 6; ++q) {
                const int c = tid + NTHR * q, row = c >> 3, cc = c & 7, kpos = kbase + row;
                *(u32x4*)(sK + row * 72 + cc * 8) = (kpos >= 0 && kpos < SEQ) ? kv[q] : zero4;
            }
#pragma unroll
            for (int q = 0; q < 6; ++q) {
                const int c = tid + NTHR * q, row = c / 48, cc = c % 48, kpos = kbase + cc * 8;
                *(u32x4*)(sVt + row * 392 + cc * 8) = (kpos >= 0 && kpos < SEQ) ? vv[q] : zero4;
            }
        }
        __syncthreads();
        const int head = wid >> 1, hq = g * 4 + head;
        const float slope2 = exp2f(-0.5f * (float)(hq + 1)) * LOG2E;
        const float sink2 = p.sink[hq] * LOG2E;
        const int tq0 = n * 128 + (wid & 1) * 64;
        bf16x8 qf[2][4];
        f32x16 o0[2], o1[2];
        float mrun[2], lsum[2];
#pragma unroll
        for (int e = 0; e < 2; ++e) {
            const size_t trow = (size_t)sq * SEQ + tq0 + 32 * e + r;
#pragma unroll
            for (int s = 0; s < 4; ++s) qf[e][s] = *(const bf16x8*)(Q0 + trow * 1024 + hq * 64 + s * 16 + h * 8);
#pragma unroll
            for (int i = 0; i < 16; ++i) { o0[e][i] = 0.f; o1[e][i] = 0.f; }
            mrun[e] = sink2; lsum[e] = (h == 0) ? 1.0f : 0.0f;
        }
        auto tile_step = [&](auto maskc, int m) {
            constexpr bool MASKED = decltype(maskc)::value;
            const bool edge = (m == -4) || (m == 4);
            f32x16 st[2];
            int kl[2]; bool ok[2];
#pragma unroll
            for (int e = 0; e < 2; ++e) {
                const int kb = tq0 + 32 * e + 32 * m;
                ok[e] = (kb >= 0) && (kb < SEQ);
                kl[e] = kb - kbase;
#pragma unroll
                for (int i = 0; i < 16; ++i) st[e][i] = 0.f;
#pragma unroll
                for (int s = 0; s < 4; ++s) { const bf16x8 kf = *(const bf16x8*)(sK + (kl[e] + r) * 72 + s * 16 + h * 8); st[e] = MFMA32(kf, qf[e][s], st[e]); }
            }
            const float fd0 = (float)(r - 32 * m - 4 * h);
#pragma unroll
            for (int e = 0; e < 2; ++e) {
                float mx = -3.0e38f;
                const bool msk = edge || !ok[e];
#pragma unroll
                for (int i = 0; i < 16; ++i) {
                    const float fd = fabsf(fd0 - (float)((i & 3) + 8 * (i >> 2)));
                    float sc = st[e][i] * (0.125f * LOG2E) - slope2 * fd;
                    if (MASKED) { if (msk) sc = (ok[e] && fd <= 128.0f) ? sc : -3.0e38f; }
                    st[e][i] = sc; mx = fmaxf(mx, sc);
                }
                mx = fmaxf(mx, __shfl_xor(mx, 32));
                const float mnew = fmaxf(mrun[e], mx);
                const float al = __builtin_amdgcn_exp2f(mrun[e] - mnew);
                mrun[e] = mnew;
                float ps = 0.f;
#pragma unroll
                for (int i = 0; i < 16; ++i) { const float pe = __builtin_amdgcn_exp2f(st[e][i] - mnew); st[e][i] = pe; ps += pe; }
                lsum[e] = lsum[e] * al + ps;
                if (__any(al != 1.0f)) {
#pragma unroll
                    for (int i = 0; i < 16; ++i) { o0[e][i] *= al; o1[e][i] *= al; }
                }
            }
#pragma unroll
            for (int e = 0; e < 2; ++e)
#pragma unroll
                for (int s2 = 0; s2 < 2; ++s2) {
                    const bf16x8 pf = pack8(st[e], s2);
                    const bf16_t* vb = sVt + r * 392 + kl[e] + 16 * s2 + 4 * h;
                    const bf16x8 v0 = cat44(*(const s16x4*)vb, *(const s16x4*)(vb + 8));
                    const bf16x8 v1 = cat44(*(const s16x4*)(vb + 32 * 392), *(const s16x4*)(vb + 32 * 392 + 8));
                    o0[e] = MFMA32(v0, pf, o0[e]);
                    o1[e] = MFMA32(v1, pf, o1[e]);
                }
        };
        for (int m = -4; m <= 4; ++m) {
            const int kb0 = tq0 + 32 * m;
            const bool plain = (m > -4) && (m < 4) && (kb0 >= 0) && (kb0 + 32 < SEQ);
            if (plain) tile_step(std::integral_constant<bool, false>{}, m); else tile_step(std::integral_constant<bool, true>{}, m);
        }
        bf16_t* sO = (bf16_t*)(smem + 105472) + wid * 2304;
#pragma unroll
        for (int e = 0; e < 2; ++e) {
            const float inv = 1.0f / (lsum[e] + __shfl_xor(lsum[e], 32));
#pragma unroll
            for (int dt = 0; dt < 2; ++dt)
#pragma unroll
                for (int gq = 0; gq < 4; ++gq) {
                    const f32x16& oo = dt ? o1[e] : o0[e];
                    f32x4 v = {oo[4 * gq] * inv, oo[4 * gq + 1] * inv, oo[4 * gq + 2] * inv, oo[4 * gq + 3] * inv};
                    st_bf4(sO + r * 72 + dt * 32 + 8 * gq + 4 * h, v);
                }
            const size_t tb = (size_t)sq * SEQ + tq0 + 32 * e;
#pragma unroll
            for (int k = 0; k < 4; ++k) {
                const int c = lane + 64 * k, row = c >> 3, cc = c & 7;
                const u32x4 ov = *(const u32x4*)(sO + row * 72 + cc * 8);
                const u32x4 gt = *(const u32x4*)(G0 + (tb + row) * 1024 + hq * 64 + cc * 8);
                u32x4 w;
#pragma unroll
                for (int j = 0; j < 4; ++j) w[j] = pk2(bf_lo(ov[j]) * silu(bf_lo(gt[j])), bf_hi(ov[j]) * silu(bf_hi(gt[j])));
                *(u32x4*)(og + (tb + row) * 1024 + hq * 64 + cc * 8) = w;
            }
        }
    }
}

template <bool L1> DI void phase_out_ln(const Params& p, unsigned char* smem) {
    const bf16_t* Ain = (const bf16_t*)(p.ws + (L1 ? WS_A2 : WS_A4));
    const bf16_t* wt = (const bf16_t*)(p.ws + (L1 ? WS_WT1OUT : WS_WT0OUT));
    bf16_t* x1b = (bf16_t*)(p.ws + WS_A0);
    float* stats = (float*)(p.ws + (L1 ? WS_STAT1 : WS_STAT0));
    unsigned* cnt = (unsigned*)(p.ws + WS_CNT) + (L1 ? 384 : 0);
    const float* gw = L1 ? p.ln1g : p.ln0g; const float* bw = L1 ? p.ln1b : p.ln0b;
    u32x4 rp[4], rq[4];
    int pm, nt, pm2, nt2;
    bool have = gemm_unit(0, 4, pm, nt);
    for (int it = 0; have; ++it) {
        const bf16_t* A = Ain + (size_t)pm * 256 * 1024;
        const bf16_t* B = wt + (size_t)nt * 256 * 1024;
        const bool more = gemm_unit(it + 1, 4, pm2, nt2);
        const bf16_t* nA = more ? Ain + (size_t)pm2 * 256 * 1024 : A;
        const bf16_t* nB = more ? wt + (size_t)nt2 * 256 * 1024 : B;
        const int t0 = pm * 256;
        const int tid = opq_tid(), lane = tid & 63, wid = tid >> 6, wi = wid >> 2, wj = wid & 3, r = lane & 31, h = lane >> 5;
        {
            f32x16 acc[4][2];
            gemm_kloop(B, A, nB, nA, it == 0, smem, acc, rp, rq, tid);
#pragma unroll
            for (int a = 0; a < 4; ++a)
#pragma unroll
                for (int b = 0; b < 2; ++b)
#pragma unroll
                    for (int g = 0; g < 4; ++g) {
                        const int i0 = wi * 128 + a * 32 + 8 * g + 4 * h, j = wj * 64 + b * 32 + r;
                        u32x2 o = {pk2(acc[a][b][4 * g], acc[a][b][4 * g + 1]), pk2(acc[a][b][4 * g + 2], acc[a][b][4 * g + 3])};
                        *(u32x2*)(smem + j * 528 + i0 * 2) = o;
                    }
        }
        __builtin_amdgcn_sched_barrier(0);
        __syncthreads();
        __builtin_amdgcn_sched_barrier(0);
        const int col = nt * 256 + lane * 4;
        auto hrow = [&](int row) -> f32x4 {
            const int t = t0 + row;
            const u32x2 mv = *(const u32x2*)(smem + row * 528 + lane * 8);
            f32x4 xr;
            if (L1) { const u32x2 xv = *(const u32x2*)(x1b + (size_t)t * 1024 + col); xr = (f32x4){bf_lo(xv[0]), bf_hi(xv[0]), bf_lo(xv[1]), bf_hi(xv[1])}; }
            else xr = *(const f32x4*)(xrow(p, t) + col);
            return xr * DN_ALPHA + (f32x4){bf_lo(mv[0]), bf_hi(mv[0]), bf_lo(mv[1]), bf_hi(mv[1])};
        };
        {
            float v[64];
#pragma unroll
            for (int hb = 0; hb < 4; ++hb) {
                f32x4 xr[8];
#pragma unroll
                for (int q = 0; q < 8; ++q) {
                    const int t = t0 + wid + 8 * (hb * 8 + q);
                    if (L1) { const u32x2 xv = *(const u32x2*)(x1b + (size_t)t * 1024 + col); xr[q] = (f32x4){__uint_as_float(xv[0]), __uint_as_float(xv[1]), 0.f, 0.f}; }
                    else xr[q] = *(const f32x4*)(xrow(p, t) + col);
                }
                asm volatile("" : "+v"(xr[0]), "+v"(xr[1]), "+v"(xr[2]), "+v"(xr[3]), "+v"(xr[4]), "+v"(xr[5]), "+v"(xr[6]), "+v"(xr[7]));
#pragma unroll
                for (int q = 0; q < 8; ++q) {
                    const int qq = hb * 8 + q, row = wid + 8 * qq;
                    const u32x2 mv = *(const u32x2*)(smem + row * 528 + lane * 8);
                    f32x4 xv;
                    if (L1) { const unsigned u0 = __float_as_uint(xr[q][0]), u1 = __float_as_uint(xr[q][1]); xv = (f32x4){bf_lo(u0), bf_hi(u0), bf_lo(u1), bf_hi(u1)}; }
                    else xv = xr[q];
                    const f32x4 hv = xv * DN_ALPHA + (f32x4){bf_lo(mv[0]), bf_hi(mv[0]), bf_lo(mv[1]), bf_hi(mv[1])};
                    v[2 * qq] = (hv[0] + hv[1]) + (hv[2] + hv[3]);
                    v[2 * qq + 1] = (hv[0] * hv[0] + hv[1] * hv[1]) + (hv[2] * hv[2] + hv[3] * hv[3]);
                }
            }
#pragma unroll
            for (int k = 0; k < 6; ++k) {
                const int hlf = 32 >> k;
                const bool up = (lane >> k) & 1;
#pragma unroll
                for (int i = 0; i < hlf; ++i) {
                    const float keep = up ? v[hlf + i] : v[i];
                    const float send = up ? v[i] : v[hlf + i];
                    v[i] = keep + __shfl_xor(send, 1 << k);
                }
            }
            const int idx = ((lane & 1) << 5) | ((lane & 2) << 3) | ((lane & 4) << 1) | ((lane & 8) >> 1) | ((lane & 16) >> 3) | ((lane & 32) >> 5);
            const int row = wid + 8 * (idx >> 1);
            __hip_atomic_store(stats + ((size_t)(t0 + row) * 4 + nt) * 2 + (idx & 1), v[0], __ATOMIC_RELAXED, __HIP_MEMORY_SCOPE_AGENT);
        }
        asm volatile("s_waitcnt vmcnt(0)" ::: "memory");
        __syncthreads();
        if (tid == 0) {
            __hip_atomic_fetch_add(cnt + pm, 1u, __ATOMIC_RELEASE, __HIP_MEMORY_SCOPE_AGENT);
            int polls = 0;
            while (__hip_atomic_load(cnt + pm, __ATOMIC_RELAXED, __HIP_MEMORY_SCOPE_AGENT) < 4u && polls < (1 << 22)) { __builtin_amdgcn_s_sleep(2); ++polls; }
            __builtin_amdgcn_fence(__ATOMIC_ACQUIRE, "agent");
        }
        __syncthreads();
        const f32x4 gg = *(const f32x4*)(gw + col), bb = *(const f32x4*)(bw + col);
        float mu_l, rstd_l;
        {
            const float* sp = stats + (size_t)(t0 + wid + 8 * (lane & 31)) * 8;
            float s1 = 0.f, s2 = 0.f;
#pragma unroll
            for (int i = 0; i < 4; ++i) { s1 += __hip_atomic_load(sp + 2 * i, __ATOMIC_RELAXED, __HIP_MEMORY_SCOPE_AGENT); s2 += __hip_atomic_load(sp + 2 * i + 1, __ATOMIC_RELAXED, __HIP_MEMORY_SCOPE_AGENT); }
            mu_l = s1 * (1.0f / 1024.0f);
            rstd_l = rsqrtf(fmaxf(s2 * (1.0f / 1024.0f) - mu_l * mu_l, 0.f) + 1e-5f);
        }
#pragma unroll 1
        for (int hb = 0; hb < 4; ++hb) {
            f32x4 xr[8];
#pragma unroll
            for (int q = 0; q < 8; ++q) {
                const int t = t0 + wid + 8 * (hb * 8 + q);
                if (L1) { const u32x2 xv = *(const u32x2*)(x1b + (size_t)t * 1024 + col); xr[q] = (f32x4){__uint_as_float(xv[0]), __uint_as_float(xv[1]), 0.f, 0.f}; }
                else xr[q] = *(const f32x4*)(xrow(p, t) + col);
            }
            asm volatile("" : "+v"(xr[0]), "+v"(xr[1]), "+v"(xr[2]), "+v"(xr[3]), "+v"(xr[4]), "+v"(xr[5]), "+v"(xr[6]), "+v"(xr[7]));
#pragma unroll
            for (int q = 0; q < 8; ++q) {
                const int qq = hb * 8 + q, row = wid + 8 * qq, t = t0 + row;
                const float mu = __int_as_float(__builtin_amdgcn_readlane(__float_as_int(mu_l), qq));
                const float rstd = __int_as_float(__builtin_amdgcn_readlane(__float_as_int(rstd_l), qq));
                const u32x2 mv = *(const u32x2*)(smem + row * 528 + lane * 8);
                f32x4 xv;
                if (L1) { const unsigned u0 = __float_as_uint(xr[q][0]), u1 = __float_as_uint(xr[q][1]); xv = (f32x4){bf_lo(u0), bf_hi(u0), bf_lo(u1), bf_hi(u1)}; }
                else xv = xr[q];
                const f32x4 hv = xv * DN_ALPHA + (f32x4){bf_lo(mv[0]), bf_hi(mv[0]), bf_lo(mv[1]), bf_hi(mv[1])};
                const f32x4 y = (hv - mu) * rstd * gg + bb;
                if (L1) *(f32x4*)(p.out + (size_t)t * 1024 + col) = y;
                else st_bf4(x1b + (size_t)t * 1024 + col, y);
            }
        }
        __syncthreads();
        have = more; pm = pm2; nt = nt2;
    }
}

DI void phase_in1(const Params& p, unsigned char* smem) {
    pg8::Gemm g; g.A = (const pg8::bf16_t*)(p.ws + WS_A0); g.Bt = (const pg8::bf16_t*)(p.ws + WS_WT1IN); g.M = T_TOK; g.N = 3072; g.K = 1024;
    pg8::StaticOrder S; S.init(T_TOK, 3072, gridDim.x, blockIdx.x);
    EpiIn1 E; E.QK1 = (bf16_t*)(p.ws + WS_A1); E.V1t = (bf16_t*)(p.ws + WS_A2); E.G1 = (bf16_t*)(p.ws + WS_A3);
    pg8::gemm_phase<EpiIn1, pg8::StaticOrder, false>((PG8_LAS unsigned char*)smem, g, S, E, nullptr);
}

DI void phase_gates(const Params& p, unsigned char* smem) {
    const bf16_t* x1b = (const bf16_t*)(p.ws + WS_A0);
    const bf16_t* wlr = (const bf16_t*)(p.ws + WS_WT1IN) + (size_t)3072 * 1024;
    bf16_t* QK1 = (bf16_t*)(p.ws + WS_A1);
    bf16_t* QKf = (bf16_t*)(p.ws + WS_A4);
    float* part = (float*)smem;
    bf16_t* sIn = (bf16_t*)smem;
    bf16_t* sOut = (bf16_t*)(smem + 32768);
    bf16_t* lrb = (bf16_t*)(smem + 98304);
    const int tid = opq_tid(), lane = tid & 63, wid = tid >> 6, r = lane & 31, h = lane >> 5;
    const int ct = wid & 3, dir = wid >> 2;
    const float* wgp = dir ? p.wgb : p.wgf; const float* bgp = dir ? p.bgb : p.bgf;
    for (int cg = blockIdx.x; cg < T_TOK / 64; cg += gridDim.x) {
        const int tb = cg * 64, sq = cg >> 6, ch = cg & 63;
        {
            f32x16 a0, a1;
#pragma unroll
            for (int i = 0; i < 16; ++i) { a0[i] = 0.f; a1[i] = 0.f; }
            bf16x8 fbq[8], fx0[8], fx1[8];
#pragma unroll
            for (int s = 0; s < 8; ++s) {
                const int k = wid * 128 + s * 16 + h * 8;
                fbq[s] = *(const bf16x8*)(wlr + (size_t)r * 1024 + k);
                fx0[s] = *(const bf16x8*)(x1b + (size_t)(tb + r) * 1024 + k);
                fx1[s] = *(const bf16x8*)(x1b + (size_t)(tb + 32 + r) * 1024 + k);
            }
            asm volatile("" : "+v"(fx0[0]), "+v"(fx0[1]), "+v"(fx0[2]), "+v"(fx0[3]), "+v"(fx0[4]), "+v"(fx0[5]), "+v"(fx0[6]), "+v"(fx0[7]),
                              "+v"(fx1[0]), "+v"(fx1[1]), "+v"(fx1[2]), "+v"(fx1[3]), "+v"(fx1[4]), "+v"(fx1[5]), "+v"(fx1[6]), "+v"(fx1[7]));
#pragma unroll
            for (int s = 0; s < 8; ++s) { a0 = MFMA32(fx0[s], fbq[s], a0); a1 = MFMA32(fx1[s], fbq[s], a1); }
            __syncthreads();
#pragma unroll
            for (int i = 0; i < 16; ++i) {
                const int t = (i & 3) + 8 * (i >> 2) + 4 * h;
                part[wid * 2048 + t * 32 + r] = a0[i];
                part[wid * 2048 + (t + 32) * 32 + r] = a1[i];
            }
            __syncthreads();
            float s4[4];
#pragma unroll
            for (int q = 0; q < 4; ++q) { const int e = tid + NTHR * q; float s = 0.f;
#pragma unroll
                for (int w = 0; w < 8; ++w) s += part[w * 2048 + e];
                s4[q] = s; }
#pragma unroll
            for (int q = 0; q < 4; ++q) lrb[tid + NTHR * q] = f2bf(s4[q]);
            __syncthreads();
        }
#pragma unroll 1
        for (int hd = 0; hd < 4; ++hd) {
            bf16_t* gin = QK1 + qk_off(sq, hd, ch);
            bf16_t* gf = QKf + qk_off(sq, hd, ch);
            u32x4 rin[4];
#pragma unroll
            for (int q = 0; q < 4; ++q) rin[q] = *(const u32x4*)(gin + (tid + NTHR * q) * 8);
            const int col = hd * 128 + ct * 32 + r;
            bf16x8 bw;
            { float wv[8];
#pragma unroll
              for (int j = 0; j < 8; ++j) wv[j] = wgp[(8 * h + j) * 512 + col];
              u32x4 pw = {pk2(wv[0], wv[1]), pk2(wv[2], wv[3]), pk2(wv[4], wv[5]), pk2(wv[6], wv[7])}; bw = __builtin_bit_cast(bf16x8, pw); }
            const float bg = bgp[col];
            f32x16 z[2];
#pragma unroll
            for (int tt = 0; tt < 2; ++tt) {
#pragma unroll
                for (int i = 0; i < 16; ++i) z[tt][i] = 0.f;
                const bf16x8 af = *(const bf16x8*)(lrb + (tt * 32 + r) * 32 + dir * 16 + 8 * h);
                z[tt] = MFMA32(af, bw, z[tt]);
            }
            float seg[8];
#pragma unroll
            for (int tt = 0; tt < 2; ++tt)
#pragma unroll
                for (int g4 = 0; g4 < 4; ++g4) {
                    float s = 0.f;
#pragma unroll
                    for (int e = 0; e < 4; ++e) { const float zz = z[tt][4 * g4 + e] + bg;
                        const float gv = (fminf(zz, 0.f) - __logf(1.0f + __expf(-fabsf(zz)))) * (1.0f / 16.0f);
                        z[tt][4 * g4 + e] = gv; s += gv; }
                    seg[tt * 4 + g4] = s;
                }
            float off[8]; float run = 0.f;
#pragma unroll
            for (int k = 0; k < 8; ++k) { const float oth = __shfl_xor(seg[k], 32); off[k] = run + (h ? oth : 0.f); run += seg[k] + oth; }
            const float tot = run;
            if (h == 0) ((float*)(p.ws + (dir ? WS_ELB : WS_ELF)))[(size_t)cg * 512 + col] = __expf(tot);
#pragma unroll
            for (int q = 0; q < 4; ++q) *(u32x4*)(sIn + (tid + NTHR * q) * 8) = rin[q];
            __syncthreads();
#pragma unroll
            for (int tt = 0; tt < 2; ++tt)
#pragma unroll
                for (int g4 = 0; g4 < 4; ++g4) {
                    float pre = off[tt * 4 + g4];
#pragma unroll
                    for (int e = 0; e < 4; ++e) {
                        const int t = tt * 32 + 8 * g4 + 4 * h + e;
                        const float gv = z[tt][4 * g4 + e];
                        const float b = dir ? (tot - pre) : (pre + gv);
                        pre += gv;
                        const float qv = bf2f(sIn[t * 128 + ct * 32 + r]), kv = bf2f(sIn[8192 + t * 128 + ct * 32 + r]);
                        sOut[dir * 16384 + t * 128 + ct * 32 + r] = f2bf(qv * __expf(b));
                        sOut[dir * 16384 + 8192 + t * 128 + ct * 32 + r] = f2bf(kv * __expf(-b));
                    }
                }
            __syncthreads();
#pragma unroll
            for (int q = 0; q < 4; ++q) {
                *(u32x4*)(gf + (tid + NTHR * q) * 8) = *(const u32x4*)(sOut + (tid + NTHR * q) * 8);
                *(u32x4*)(gin + (tid + NTHR * q) * 8) = *(const u32x4*)(sOut + 16384 + (tid + NTHR * q) * 8);
            }
        }
    }
}

#define LDS3 __attribute__((address_space(3)))
DI s16x4 tr_read(const bf16_t* p) { return __builtin_amdgcn_ds_read_tr16_b64_v4i16((LDS3 s16x4*)p); }
DI void phase_gla(const Params& p, unsigned char* smem) {
    const bf16_t* V1t = (const bf16_t*)(p.ws + WS_A2);
    bf16_t* sQD = (bf16_t*)smem;
    bf16_t* sKI = (bf16_t*)(smem + 17408);
    bf16_t* sVt = (bf16_t*)(smem + 34816);
    float* sEL = (float*)(smem + 71680);
    bf16_t* sAtt = (bf16_t*)(smem + 104448);
    bf16_t* sOut = (bf16_t*)(smem + 112640);
    const int tid = opq_tid(), lane = tid & 63, wid = tid >> 6, r = lane & 31, h = lane >> 5;
    const int dvs = wid * 32;
    const bf16_t* trb = sKI + (8 * h + ((lane & 15) >> 2)) * 136 + 16 * ((lane >> 4) & 1) + 4 * (lane & 3);
    for (int u = blockIdx.x; u < NSEQ * 8; u += gridDim.x) {
        const int dir = u & 1, hd = (u >> 1) & 3, sq = u >> 3;
        const bf16_t* QK = (const bf16_t*)(p.ws + (dir ? WS_A1 : WS_A4));
        const float* EL = (const float*)(p.ws + (dir ? WS_ELB : WS_ELF));
        bf16_t* od = (bf16_t*)p.out + (dir ? (size_t)T_TOK * 1024 : 0);
        f32x16 S[4];
#pragma unroll
        for (int d4 = 0; d4 < 4; ++d4)
#pragma unroll
            for (int i = 0; i < 16; ++i) S[d4][i] = 0.f;
        u32x4 rqd[2], rki[2], rv[4];
        auto gload = [&](int ch) {
            const bf16_t* gq = QK + qk_off(sq, hd, ch);
            const bf16_t* gv = V1t + v1_off(sq, hd, ch);
#pragma unroll
            for (int q = 0; q < 2; ++q) { rqd[q] = *(const u32x4*)(gq + (tid + NTHR * q) * 8); rki[q] = *(const u32x4*)(gq + 8192 + (tid + NTHR * q) * 8); }
#pragma unroll
            for (int q = 0; q < 4; ++q) rv[q] = *(const u32x4*)(gv + (tid + NTHR * q) * 8);
        };
        auto swrite = [&]() {
#pragma unroll
            for (int q = 0; q < 2; ++q) { const int c2 = tid + NTHR * q, row = c2 >> 4, cc = c2 & 15;
                *(u32x4*)(sQD + row * 136 + cc * 8) = rqd[q];
                *(u32x4*)(sKI + row * 136 + cc * 8) = rki[q]; }
#pragma unroll
            for (int q = 0; q < 4; ++q) { const int c2 = tid + NTHR * q, row = c2 >> 3, cc = c2 & 7; *(u32x4*)(sVt + row * 72 + cc * 8) = rv[q]; }
        };
        gload(dir ? 63 : 0);
        __syncthreads();
#pragma unroll 2
        for (int q = 0; q < 16; ++q) { const int e = tid + NTHR * q; sEL[e] = EL[((size_t)sq * 64 + (e >> 7)) * 512 + hd * 128 + (e & 127)]; }
        swrite();
        __syncthreads();
        for (int stp = 0; stp < 64; ++stp) {
            const int ch = dir ? 63 - stp : stp;
            if (stp + 1 < 64) gload(dir ? ch - 1 : ch + 1);
            __builtin_amdgcn_sched_barrier(0);
            if (wid < 4) {
                const int a = wid >> 1, b = wid & 1;
                bf16x8 kf[8], qf[8];
#pragma unroll
                for (int s8 = 0; s8 < 8; ++s8) { kf[s8] = *(const bf16x8*)(sKI + (32 * a + r) * 136 + 16 * s8 + 8 * h); qf[s8] = *(const bf16x8*)(sQD + (32 * b + r) * 136 + 16 * s8 + 8 * h); }
                f32x16 at0, at1;
#pragma unroll
                for (int i = 0; i < 16; ++i) { at0[i] = 0.f; at1[i] = 0.f; }
#pragma unroll
                for (int s8 = 0; s8 < 8; s8 += 2) { at0 = MFMA32(kf[s8], qf[s8], at0); at1 = MFMA32(kf[s8 + 1], qf[s8 + 1], at1); }
                const int t = 32 * b + r;
#pragma unroll
                for (int i = 0; i < 16; ++i) {
                    const int s = 32 * a + (i & 3) + 8 * (i >> 2) + 4 * h;
                    const bool keep = dir ? (s > t) : (s <= t);
                    at0[i] = keep ? (at0[i] + at1[i]) : 0.f;
                }
#pragma unroll
                for (int s2 = 0; s2 < 2; ++s2) *(bf16x8*)(sAtt + ((a * 2 + b) * 2 + s2) * 512 + lane * 8) = pack8(at0, s2);
            }
            __builtin_amdgcn_sched_barrier(0);
            f32x16 o0, o1;
#pragma unroll
            for (int i = 0; i < 16; ++i) { o0[i] = 0.f; o1[i] = 0.f; }
#pragma unroll
            for (int d4 = 0; d4 < 4; ++d4)
#pragma unroll
                for (int s2 = 0; s2 < 2; ++s2) {
                    const bf16x8 ps = pack8(S[d4], s2);
                    const bf16_t* qb = sQD + r * 136 + 32 * d4 + 16 * s2 + 4 * h;
                    const bf16x8 q0 = cat44(*(const s16x4*)qb, *(const s16x4*)(qb + 8));
                    const bf16x8 q1 = cat44(*(const s16x4*)(qb + 32 * 136), *(const s16x4*)(qb + 32 * 136 + 8));
                    o0 = MFMA32(ps, q0, o0);
                    o1 = MFMA32(ps, q1, o1);
                }
            __syncthreads();
#pragma unroll
            for (int a = 0; a < 2; ++a)
#pragma unroll
                for (int s2 = 0; s2 < 2; ++s2) {
                    const bf16_t* vb = sVt + (dvs + r) * 72 + 32 * a + 16 * s2 + 4 * h;
                    const bf16x8 va = cat44(*(const s16x4*)vb, *(const s16x4*)(vb + 8));
                    const bf16x8 p0 = *(const bf16x8*)(sAtt + ((a * 2 + 0) * 2 + s2) * 512 + lane * 8);
                    const bf16x8 p1 = *(const bf16x8*)(sAtt + ((a * 2 + 1) * 2 + s2) * 512 + lane * 8);
                    o0 = MFMA32(va, p0, o0);
                    o1 = MFMA32(va, p1, o1);
                }
#pragma unroll
            for (int g = 0; g < 4; ++g) {
                f32x4 v0 = {o0[4 * g], o0[4 * g + 1], o0[4 * g + 2], o0[4 * g + 3]};
                f32x4 v1 = {o1[4 * g], o1[4 * g + 1], o1[4 * g + 2], o1[4 * g + 3]};
                st_bf4(sOut + r * 264 + dvs + 8 * g + 4 * h, v0);
                st_bf4(sOut + (32 + r) * 264 + dvs + 8 * g + 4 * h, v1);
            }
            __builtin_amdgcn_sched_barrier(0);
#pragma unroll
            for (int d4 = 0; d4 < 4; ++d4) {
#pragma unroll
                for (int s4 = 0; s4 < 4; ++s4) {
                    const bf16x8 ka = cat44(tr_read(trb + (16 * s4) * 136 + 32 * d4), tr_read(trb + (16 * s4 + 4) * 136 + 32 * d4));
                    const bf16x8 vb = *(const bf16x8*)(sVt + (dvs + r) * 72 + 16 * s4 + 8 * h);
                    S[d4] = MFMA32(ka, vb, S[d4]);
                }
            }
#pragma unroll
            for (int d4 = 0; d4 < 4; ++d4)
#pragma unroll
                for (int g = 0; g < 4; ++g) {
                    const f32x4 e4 = *(const f32x4*)(sEL + ch * 128 + 32 * d4 + 8 * g + 4 * h);
                    S[d4][4 * g] *= e4[0]; S[d4][4 * g + 1] *= e4[1]; S[d4][4 * g + 2] *= e4[2]; S[d4][4 * g + 3] *= e4[3];
                }
            __syncthreads();
            {
                const size_t tbase = (size_t)sq * SEQ + ch * 64;
#pragma unroll
                for (int q = 0; q < 4; ++q) { const int c2 = tid + NTHR * q, row = c2 >> 5, cc = c2 & 31;
                    *(u32x4*)(od + (tbase + row) * 1024 + hd * 256 + cc * 8) = *(const u32x4*)(sOut + row * 264 + cc * 8); }
            }
            if (stp + 1 < 64) swrite();
            __syncthreads();
        }
    }
}

DI void phase_combine(const Params& p) {
    const bf16_t* of = (const bf16_t*)p.out; const bf16_t* ob = of + (size_t)T_TOK * 1024;
    const bf16_t* G1 = (const bf16_t*)(p.ws + WS_A3);
    bf16_t* og = (bf16_t*)(p.ws + WS_A2);
    const int tid = opq_tid(), lane = tid & 63, wid = tid >> 6;
    f32x4 hn[4];
#pragma unroll
    for (int j = 0; j < 4; ++j) hn[j] = *(const f32x4*)(p.hnorm + lane * 16 + j * 4);
    const int rstride = gridDim.x * 8;
    for (int row0 = blockIdx.x * 8 + wid; row0 < T_TOK; row0 += 3 * rstride) {
        u32x4 a[3][2], b[3][2], gt[3][2];
#pragma unroll
        for (int k = 0; k < 3; ++k) { const int row = (row0 + k * rstride < T_TOK) ? row0 + k * rstride : row0; const size_t base = (size_t)row * 1024 + lane * 16;
#pragma unroll
            for (int q = 0; q < 2; ++q) { a[k][q] = *(const u32x4*)(of + base + q * 8); b[k][q] = *(const u32x4*)(ob + base + q * 8); gt[k][q] = *(const u32x4*)(G1 + base + q * 8); } }
        asm volatile("" : "+v"(a[0][0]), "+v"(a[0][1]), "+v"(a[1][0]), "+v"(a[1][1]), "+v"(a[2][0]), "+v"(a[2][1]), "+v"(b[0][0]), "+v"(b[0][1]), "+v"(b[1][0]), "+v"(b[1][1]), "+v"(b[2][0]), "+v"(b[2][1]), "+v"(gt[0][0]), "+v"(gt[0][1]), "+v"(gt[1][0]), "+v"(gt[1][1]), "+v"(gt[2][0]), "+v"(gt[2][1]));
#pragma unroll
        for (int k = 0; k < 3; ++k) {
            const int row = row0 + k * rstride;
            if (row < T_TOK) {
                const size_t base = (size_t)row * 1024 + lane * 16;
                float v[16]; float ss = 0.f;
#pragma unroll
                for (int q = 0; q < 2; ++q)
#pragma unroll
                    for (int j = 0; j < 4; ++j) { v[q * 8 + 2 * j] = bf_lo(a[k][q][j]) + bf_lo(b[k][q][j]); v[q * 8 + 2 * j + 1] = bf_hi(a[k][q][j]) + bf_hi(b[k][q][j]); }
#pragma unroll
                for (int j = 0; j < 16; ++j) ss += v[j] * v[j];
#pragma unroll
                for (int o = 1; o < 16; o <<= 1) ss += __shfl_xor(ss, o);
                const float rstd = rsqrtf(ss * (1.0f / 256.0f) + 1e-6f);
#pragma unroll
                for (int q = 0; q < 2; ++q) {
                    const f32x4 h0 = hn[2 * q], h1 = hn[2 * q + 1];
                    const u32x4 g4 = gt[k][q];
                    u32x4 o;
                    o[0] = pk2(v[q * 8 + 0] * rstd * h0[0] * silu(bf_lo(g4[0])), v[q * 8 + 1] * rstd * h0[1] * silu(bf_hi(g4[0])));
                    o[1] = pk2(v[q * 8 + 2] * rstd * h0[2] * silu(bf_lo(g4[1])), v[q * 8 + 3] * rstd * h0[3] * silu(bf_hi(g4[1])));
                    o[2] = pk2(v[q * 8 + 4] * rstd * h1[0] * silu(bf_lo(g4[2])), v[q * 8 + 5] * rstd * h1[1] * silu(bf_hi(g4[2])));
                    o[3] = pk2(v[q * 8 + 6] * rstd * h1[2] * silu(bf_lo(g4[3])), v[q * 8 + 7] * rstd * h1[3] * silu(bf_hi(g4[3])));
                    *(u32x4*)(og + base + q * 8) = o;
                }
            }
        }
    }
}

#define XB_TMO      128
#define XB_XCNT(j)  (256  + 64 * (j))
#define XB_XSUB(j)  (1280 + 64 * (j))
#define XB_XGEN(j)  (2304 + 64 * (j))
#define XB_TOP      3328
#define XB_TOPGEN   3392
#define XCD_BAR_WORDS 3456
#define XB_SPIN_CAP (1u << 18)
#define LAS __attribute__((address_space(3)))

__device__ __forceinline__ unsigned xb_ld(unsigned* p)              { return __hip_atomic_load(p, __ATOMIC_RELAXED, __HIP_MEMORY_SCOPE_AGENT); }
__device__ __forceinline__ unsigned xb_add(unsigned* p, unsigned v) { return __hip_atomic_fetch_add(p, v, __ATOMIC_RELAXED, __HIP_MEMORY_SCOPE_AGENT); }
__device__ __forceinline__ unsigned xb_xcc_id() { return (unsigned)__builtin_amdgcn_s_getreg((3 << 11) | 20) & 0xFu; }
#define XB_SPIN(cond, bar) do { unsigned _sp = 0; while (cond) { __builtin_amdgcn_s_sleep(1); \
    if ((++_sp & 255u) == 0u) { if (xb_ld(&(bar)[XB_TMO])) break; if (_sp > XB_SPIN_CAP) { atomicAdd(&(bar)[XB_TMO], 1u); break; } } } } while (0)

struct XcdBarrier {
    unsigned* bar; unsigned x;
    volatile LAS unsigned* st;
};

__device__ __forceinline__ XcdBarrier xcd_barrier_post(unsigned* bar, volatile LAS unsigned* st) {
    XcdBarrier b; b.bar = bar; b.x = xb_xcc_id(); b.st = st;
    if (threadIdx.x == 0) (void)xb_add(&bar[XB_XCNT(b.x)], 1u);
    return b;
}
__device__ __forceinline__ void xcd_barrier_complete(unsigned* bar, unsigned x, unsigned& nloc, unsigned& nx) {
    const unsigned G = gridDim.x * gridDim.y * gridDim.z;
    unsigned sum, cnt, mine, sp = 0u;
    for (;;) {
        sum = 0u; cnt = 0u; mine = 0u;
#pragma unroll
        for (unsigned j = 0; j < 16; ++j) { const unsigned c = xb_ld(&bar[XB_XCNT(j)]); sum += c; cnt += (c > 0u) ? 1u : 0u; mine = (j == x) ? c : mine; }
        if (sum == G) break;
        __builtin_amdgcn_s_sleep(1);
        if ((++sp & 255u) == 0u) { if (xb_ld(&bar[XB_TMO])) break; if (sp > XB_SPIN_CAP) { atomicAdd(&bar[XB_TMO], 1u); break; } }
    }
    nloc = mine > 0u ? mine : 1u; nx = cnt > 0u ? cnt : 1u;
}

__device__ __forceinline__ void xcd_barrier(const XcdBarrier& b) {
    asm volatile("s_waitcnt vmcnt(0)" ::: "memory");
    __syncthreads();
    if (threadIdx.x == 0) {
        unsigned* bar = b.bar;
        __builtin_amdgcn_s_waitcnt(0);
        unsigned nloc = b.st[0], nx = b.st[1];
        if (nloc == 0u) { xcd_barrier_complete(bar, b.x, nloc, nx); b.st[0] = nloc; b.st[1] = nx; }
        const unsigned old = xb_add(&bar[XB_XSUB(b.x)], 1u);
        const unsigned gen = old / nloc;
        if (old + 1u == (gen + 1u) * nloc) {
            __builtin_amdgcn_fence(__ATOMIC_RELEASE, "agent");
            asm volatile("s_waitcnt vmcnt(0)" ::: "memory");
            const unsigned og = xb_add(&bar[XB_TOP], 1u);
            const unsigned tg = og / nx;
            if (og + 1u == (tg + 1u) * nx) xb_add(&bar[XB_TOPGEN], 1u);
            else XB_SPIN(xb_ld(&bar[XB_TOPGEN]) == tg, bar);
            __builtin_amdgcn_fence(__ATOMIC_ACQUIRE, "agent");
            xb_add(&bar[XB_XGEN(b.x)], 1u);
            asm volatile("s_waitcnt vmcnt(0)" ::: "memory");
        } else {
            XB_SPIN(xb_ld(&bar[XB_XGEN(b.x)]) == gen, bar);
            __builtin_amdgcn_fence(__ATOMIC_ACQUIRE, "agent");
            asm volatile("s_waitcnt vmcnt(0)" ::: "memory");
        }
    }
    __syncthreads();
}


__global__ void __launch_bounds__(NTHR) fwd_megakernel(Params p) {
    extern __shared__ __attribute__((aligned(16))) unsigned char smem[];
    cg::grid_group grid = cg::this_grid();
    volatile LAS unsigned* xst = (volatile LAS unsigned*)(smem + 147456);
    if (threadIdx.x < 4) xst[threadIdx.x] = 0u;
    __syncthreads();
    phase_convert(p, smem);      grid.sync();
    const XcdBarrier xb = xcd_barrier_post((unsigned*)(p.ws + WS_XBAR), xst);
    phase_in0(p, smem);          xcd_barrier(xb);
    phase_attn(p, smem);         xcd_barrier(xb);
    phase_out_ln<false>(p, smem); xcd_barrier(xb);
    phase_in1(p, smem);          xcd_barrier(xb);
    phase_gates(p, smem);        xcd_barrier(xb);
    phase_gla(p, smem);          xcd_barrier(xb);
    phase_combine(p);            xcd_barrier(xb);
    phase_out_ln<true>(p, smem);
}

extern "C" void kernel_launch(void* const* d_in, const int* in_sizes, int n_in, void* d_out, int out_size, void* d_ws, size_t ws_size, hipStream_t stream) {
    static int grid_blocks = 0;
    if (!grid_blocks) {
        int dev = 0, cus = 0, per_cu = 0;
        hipGetDevice(&dev);
        hipDeviceGetAttribute(&cus, hipDeviceAttributeMultiprocessorCount, dev);
        hipFuncSetAttribute((const void*)fwd_megakernel, hipFuncAttributeMaxDynamicSharedMemorySize, LDS_BYTES);
        hipOccupancyMaxActiveBlocksPerMultiprocessor(&per_cu, (const void*)fwd_megakernel, NTHR, LDS_BYTES);
        if (per_cu < 1) { fprintf(stderr, "occupancy query says %d blocks/CU\n", per_cu); per_cu = 1; }
        grid_blocks = cus * per_cu;
        if (ws_size < WS_A5 + 16 * MiB) fprintf(stderr, "workspace too small: %zu\n", ws_size);
    }
    Params p{};
    p.xp = (const float*)d_in[0]; p.xs = (const float*)d_in[1]; p.w0in = (const float*)d_in[2]; p.sink = (const float*)d_in[3];
    p.w0out = (const float*)d_in[4]; p.ln0g = (const float*)d_in[5]; p.ln0b = (const float*)d_in[6]; p.w1in = (const float*)d_in[7];
    p.wgf = (const float*)d_in[8]; p.bgf = (const float*)d_in[9]; p.wgb = (const float*)d_in[10]; p.bgb = (const float*)d_in[11];
    p.hnorm = (const float*)d_in[12]; p.w1out = (const float*)d_in[13]; p.ln1g = (const float*)d_in[14]; p.ln1b = (const float*)d_in[15];
    p.out = (float*)d_out; p.ws = (unsigned char*)d_ws;
    void* args[] = {&p};
    hipError_t e = hipLaunchCooperativeKernel((const void*)fwd_megakernel, dim3(grid_blocks), dim3(NTHR), args, LDS_BYTES, stream);
    if (e != hipSuccess) fprintf(stderr, "cooperative launch failed: %s (grid %d)\n", hipGetErrorString(e), grid_blocks);
}
```
